# Optimizing an MI355X kernel written in HIP

```python
import math
import jax
import jax.numpy as jnp
from jax import lax
import numpy as np

D_MODEL = 1024
BATCH = 8
SEQ = 4096
DEPTH = 2

CHUNK = 64
CONV_W = 4
GLA_H = 6
GLA_DK = 32
GLA_DV = 64
GLA_RANK = 16
GLA_GATE_NORM = 16.0
LRU_W = 256
LRU_BLOCKS = 4
LRU_BW = LRU_W // LRU_BLOCKS
LRU_C = 8.0
DN_H = 6
DN_DK = 64
DN_DV = 64
D_FF = 2816
N_EXPERTS = 8
TOP_K = 2
D_FF_EXPERT = 3584
N_DENSE = (DEPTH + 1) // 2
N_MOE = DEPTH // 2
EPS = 1e-6

GLA_QK = GLA_H * GLA_DK
GLA_V = GLA_H * GLA_DV
DN_QKV = 2 * DN_H * DN_DK + DN_H * DN_DV
DN_V = DN_H * DN_DV
IN_SPLITS = (GLA_QK, GLA_QK, GLA_V, GLA_V, GLA_RANK, LRU_W, LRU_W, DN_QKV, DN_V, DN_H, DN_H)
D_IN = sum(IN_SPLITS)
D_MIX = GLA_V + LRU_W + DN_V

kernel_name = "hybrid_gla_rglru_gdn_moe_adaln"


def rms_norm(x, w):
    xf = x.astype(jnp.float32)
    y = xf * lax.rsqrt(jnp.mean(xf * xf, axis=-1, keepdims=True) + EPS)
    return (y * w.astype(jnp.float32)).astype(x.dtype)


def l2_norm(x):
    xf = x.astype(jnp.float32)
    return (xf * lax.rsqrt(jnp.sum(xf * xf, axis=-1, keepdims=True) + EPS)).astype(x.dtype)


def split_cols(t, sizes):
    idx = np.cumsum(np.array(sizes))[:-1].tolist()
    return jnp.split(t, idx, axis=-1)


def causal_depthwise_conv(x, w):
    k, ch = w.shape
    return lax.conv_general_dilated(
        x, w[:, None, :].astype(x.dtype), window_strides=(1,), padding=[(k - 1, 0)],
        dimension_numbers=("NWC", "WIO", "NWC"), feature_group_count=ch)


def to_chunks(t):
    b, s = t.shape[:2]
    t = t.reshape((b, s // CHUNK, CHUNK) + t.shape[2:])
    return jnp.swapaxes(jnp.swapaxes(t, 0, 1), 2, 3)


def from_chunks(t):
    t = jnp.swapaxes(jnp.swapaxes(t, 2, 3), 0, 1)
    b, n, c, h, d = t.shape
    return t.reshape(b, n * c, h, d)


def gla_chunked(q, k, v, log_a):
    dtype = v.dtype
    b_, s_, h_, dk = q.shape
    dv = v.shape[-1]
    q, k, v, log_a = (to_chunks(t.astype(jnp.float32)) for t in (q, k, v, log_a))
    bcum = jnp.cumsum(log_a, axis=-2)
    b_last = bcum[..., -1:, :]
    q_dec = q * jnp.exp(bcum)
    k_dec = k * jnp.exp(-bcum)
    k_end = k * jnp.exp(b_last - bcum)
    causal = jnp.tril(jnp.ones((CHUNK, CHUNK), dtype=bool))
    scores = jnp.where(causal, jnp.einsum("nbhck,nbhsk->nbhcs", q_dec, k_dec), 0.0)
    o_intra = jnp.einsum("nbhcs,nbhsv->nbhcv", scores, v)
    chunk_kv = jnp.einsum("nbhck,nbhcv->nbhkv", k_end, v)
    chunk_decay = jnp.exp(b_last[..., 0, :])

    def step(state, inp):
        kv, dec = inp
        return state * dec[..., None] + kv, state

    init = jnp.zeros((b_, h_, dk, dv), jnp.float32)
    _, states = lax.scan(step, init, (chunk_kv, chunk_decay))
    o = o_intra + jnp.einsum("nbhck,nbhkv->nbhcv", q_dec, states)
    return from_chunks(o).astype(dtype)


def gated_delta_chunked(q, k, v, g, beta):
    dtype = v.dtype
    b_, s_, h_, dk = q.shape
    dv = v.shape[-1]
    q, k, v, g, beta = (to_chunks(t.astype(jnp.float32)) for t in (q, k, v, g, beta))
    gc = jnp.cumsum(g, axis=-1)
    incl = jnp.tril(jnp.ones((CHUNK, CHUNK), dtype=bool))
    strict = jnp.tril(jnp.ones((CHUNK, CHUNK), dtype=bool), k=-1)
    diff = gc[..., :, None] - gc[..., None, :]
    decay = jnp.exp(jnp.where(incl, diff, -jnp.inf))
    k_beta = k * beta[..., None]
    v_beta = v * beta[..., None]
    kk = jnp.einsum("nbhck,nbhsk->nbhcs", k_beta, k)
    a_mat = jnp.where(strict, kk * decay, 0.0) + jnp.eye(CHUNK, dtype=jnp.float32)
    u = lax.linalg.triangular_solve(a_mat, v_beta, left_side=True, lower=True, unit_diagonal=True)
    w = lax.linalg.triangular_solve(a_mat, k_beta * jnp.exp(gc)[..., None],
                                    left_side=True, lower=True, unit_diagonal=True)
    qk = jnp.where(incl, jnp.einsum("nbhck,nbhsk->nbhcs", q, k) * decay, 0.0)
    q_dec = q * jnp.exp(gc)[..., None]
    g_last = gc[..., -1:]
    k_end = k * jnp.exp(g_last - gc)[..., None]
    chunk_decay = jnp.exp(g_last)

    def step(state, inp):
        u_n, w_n, q_n, qk_n, k_n, dec_n = inp
        v_new = u_n - jnp.einsum("bhck,bhkv->bhcv", w_n, state)
        o_n = (jnp.einsum("bhck,bhkv->bhcv", q_n, state)
               + jnp.einsum("bhcs,bhsv->bhcv", qk_n, v_new))
        state = state * dec_n[..., None] + jnp.einsum("bhck,bhcv->bhkv", k_n, v_new)
        return state, o_n

    init = jnp.zeros((b_, h_, dk, dv), jnp.float32)
    _, o = lax.scan(step, init, (u, w, q_dec, qk, k_end, chunk_decay))
    return from_chunks(o).astype(dtype)


def _lin_combine(left, right):
    a_l, u_l = left
    a_r, u_r = right
    return a_l * a_r, a_r * u_l + u_r


def rg_lru(x, w_a, b_a, w_x, b_x, lam):
    dtype = x.dtype
    b_, s_, _ = x.shape
    xf = x.astype(jnp.float32)
    xb = xf.reshape(b_, s_, LRU_BLOCKS, LRU_BW)
    r = jax.nn.sigmoid(jnp.einsum("bsnj,njk->bsnk", xb, w_a.astype(jnp.float32)).reshape(b_, s_, LRU_W) + b_a)
    i = jax.nn.sigmoid(jnp.einsum("bsnj,njk->bsnk", xb, w_x.astype(jnp.float32)).reshape(b_, s_, LRU_W) + b_x)
    log_a = -LRU_C * r * jax.nn.softplus(-lam.astype(jnp.float32))
    a = jnp.exp(log_a)
    u = jnp.sqrt(-jnp.expm1(2.0 * log_a)) * (i * xf)
    _, h = lax.associative_scan(_lin_combine, (a, u), axis=1)
    return h.astype(dtype)


def hybrid_mixer(h, w_in, gla_w_lr2, gla_b_lr2, gla_norm_w, lru_conv_w, lru_conv_b,
                 lru_w_a, lru_b_a, lru_w_x, lru_b_x, lru_lambda,
                 dn_conv_w, dn_a_log, dn_dt_bias, dn_norm_w, w_out):
    b_, s_, _ = h.shape
    proj = h @ w_in
    (gq, gk, gv, gz, glr, lx, lgate, dqkv, dz, dbeta, da) = split_cols(proj, IN_SPLITS)

    gq = gq.reshape(b_, s_, GLA_H, GLA_DK) * (GLA_DK ** -0.5)
    gk = gk.reshape(b_, s_, GLA_H, GLA_DK)
    gv = gv.reshape(b_, s_, GLA_H, GLA_DV)
    glog = jax.nn.log_sigmoid((glr @ gla_w_lr2 + gla_b_lr2).astype(jnp.float32)) / GLA_GATE_NORM
    o_gla = gla_chunked(gq, gk, gv, glog.reshape(b_, s_, GLA_H, GLA_DK))
    o_gla = rms_norm(o_gla, gla_norm_w) * jax.nn.silu(gz.reshape(b_, s_, GLA_H, GLA_DV))

    xr = causal_depthwise_conv(lx, lru_conv_w) + lru_conv_b
    o_lru = rg_lru(xr, lru_w_a, lru_b_a, lru_w_x, lru_b_x, lru_lambda) * jax.nn.gelu(lgate)

    dqkv = jax.nn.silu(causal_depthwise_conv(dqkv, dn_conv_w))
    dq, dk_, dv = split_cols(dqkv, (DN_H * DN_DK, DN_H * DN_DK, DN_V))
    dq = l2_norm(dq.reshape(b_, s_, DN_H, DN_DK)) * (DN_DK ** -0.5)
    dk_ = l2_norm(dk_.reshape(b_, s_, DN_H, DN_DK))
    dv = dv.reshape(b_, s_, DN_H, DN_DV)
    beta = jax.nn.sigmoid(dbeta)
    g = -jnp.exp(dn_a_log.astype(jnp.float32)) * jax.nn.softplus((da + dn_dt_bias).astype(jnp.float32))
    o_dn = gated_delta_chunked(dq, dk_, dv, g, beta)
    o_dn = rms_norm(o_dn, dn_norm_w) * jax.nn.silu(dz.reshape(b_, s_, DN_H, DN_DV))

    merged = jnp.concatenate([o_gla.reshape(b_, s_, GLA_V), o_lru, o_dn.reshape(b_, s_, DN_V)], axis=-1)
    return merged @ w_out


def swiglu(t, w_gate, w_up, w_down):
    return (jax.nn.silu(t @ w_gate) * (t @ w_up)) @ w_down


def moe_swiglu(h, router_w, w_gate, w_up, w_down):
    b_, s_, d = h.shape
    t = h.reshape(b_ * s_, d)
    logits = (t @ router_w).astype(jnp.float32)
    top_vals, top_idx = lax.top_k(logits, TOP_K)
    weights = jax.nn.softmax(top_vals, axis=-1)
    gates = jnp.sum(jax.nn.one_hot(top_idx, N_EXPERTS, dtype=jnp.float32) * weights[..., None], axis=1)
    y = jnp.zeros_like(t)
    for e in range(N_EXPERTS):
        y = y + gates[:, e:e + 1].astype(t.dtype) * swiglu(t, w_gate[e], w_up[e], w_down[e])
    return y.reshape(b_, s_, d)


def setup_inputs(seed: int = 0) -> dict:
    key = jax.random.key(seed)
    ks = jax.random.split(key, 40)
    f32 = jnp.float32

    def nrm(k, shape, scale):
        return jax.random.normal(k, shape, f32) * scale

    a0 = jax.random.uniform(ks[12], (DEPTH, LRU_W), f32, minval=0.9, maxval=0.999)
    dt = jnp.exp(jax.random.uniform(ks[15], (DEPTH, DN_H), f32, minval=math.log(1e-3), maxval=math.log(1e-1)))
    return {
        "x": nrm(ks[0], (BATCH, SEQ, D_MODEL), 1.0),
        "c": nrm(ks[1], (BATCH, D_MODEL), 1.0),
        "w_in": nrm(ks[2], (DEPTH, D_MODEL, D_IN), D_MODEL ** -0.5),
        "gla_w_lr2": nrm(ks[3], (DEPTH, GLA_RANK, GLA_QK), GLA_RANK ** -0.5),
        "gla_b_lr2": nrm(ks[4], (DEPTH, GLA_QK), 0.1),
        "gla_norm_w": 1.0 + nrm(ks[5], (DEPTH, GLA_DV), 0.02),
        "lru_conv_w": nrm(ks[6], (DEPTH, CONV_W, LRU_W), CONV_W ** -0.5),
        "lru_conv_b": nrm(ks[7], (DEPTH, LRU_W), 0.02),
        "lru_w_a": nrm(ks[8], (DEPTH, LRU_BLOCKS, LRU_BW, LRU_BW), LRU_BW ** -0.5),
        "lru_b_a": nrm(ks[9], (DEPTH, LRU_W), 0.1),
        "lru_w_x": nrm(ks[10], (DEPTH, LRU_BLOCKS, LRU_BW, LRU_BW), LRU_BW ** -0.5),
        "lru_b_x": nrm(ks[11], (DEPTH, LRU_W), 0.1),
        "lru_lambda": jnp.log(a0) - jnp.log1p(-a0),
        "dn_conv_w": nrm(ks[13], (DEPTH, CONV_W, DN_QKV), CONV_W ** -0.5),
        "dn_a_log": jnp.log(jax.random.uniform(ks[14], (DEPTH, DN_H), f32, minval=1.0, maxval=16.0)),
        "dn_dt_bias": dt + jnp.log(-jnp.expm1(-dt)),
        "dn_norm_w": 1.0 + nrm(ks[16], (DEPTH, DN_DV), 0.02),
        "w_out": nrm(ks[17], (DEPTH, D_MIX, D_MODEL), D_MIX ** -0.5),
        "norm1_w": 1.0 + nrm(ks[18], (DEPTH, D_MODEL), 0.02),
        "norm2_w": 1.0 + nrm(ks[19], (DEPTH, D_MODEL), 0.02),
        "ada_w": nrm(ks[20], (DEPTH, D_MODEL, 6 * D_MODEL), 0.5 * D_MODEL ** -0.5),
        "ada_b": nrm(ks[21], (DEPTH, 6 * D_MODEL), 0.02),
        "ffn_w_gate": nrm(ks[22], (N_DENSE, D_MODEL, D_FF), D_MODEL ** -0.5),
        "ffn_w_up": nrm(ks[23], (N_DENSE, D_MODEL, D_FF), D_MODEL ** -0.5),
        "ffn_w_down": nrm(ks[24], (N_DENSE, D_FF, D_MODEL), D_FF ** -0.5),
        "router_w": nrm(ks[25], (N_MOE, D_MODEL, N_EXPERTS), D_MODEL ** -0.5),
        "moe_w_gate": nrm(ks[26], (N_MOE, N_EXPERTS, D_MODEL, D_FF_EXPERT), D_MODEL ** -0.5),
        "moe_w_up": nrm(ks[27], (N_MOE, N_EXPERTS, D_MODEL, D_FF_EXPERT), D_MODEL ** -0.5),
        "moe_w_down": nrm(ks[28], (N_MOE, N_EXPERTS, D_FF_EXPERT, D_MODEL), D_FF_EXPERT ** -0.5),
        "final_norm_w": 1.0 + nrm(ks[29], (D_MODEL,), 0.02),
    }


def reference(x, c, w_in, gla_w_lr2, gla_b_lr2, gla_norm_w, lru_conv_w, lru_conv_b,
              lru_w_a, lru_b_a, lru_w_x, lru_b_x, lru_lambda, dn_conv_w, dn_a_log, dn_dt_bias,
              dn_norm_w, w_out, norm1_w, norm2_w, ada_w, ada_b, ffn_w_gate, ffn_w_up, ffn_w_down,
              router_w, moe_w_gate, moe_w_up, moe_w_down, final_norm_w):
    c_act = jax.nn.silu(c)
    for i in range(DEPTH):
        mod = c_act @ ada_w[i] + ada_b[i]
        sh1, sc1, g1, sh2, sc2, g2 = (m[:, None, :] for m in jnp.split(mod, 6, axis=-1))

        h = rms_norm(x, norm1_w[i]) * (1.0 + sc1) + sh1
        mix = hybrid_mixer(h, w_in[i], gla_w_lr2[i], gla_b_lr2[i], gla_norm_w[i],
                           lru_conv_w[i], lru_conv_b[i], lru_w_a[i], lru_b_a[i], lru_w_x[i],
                           lru_b_x[i], lru_lambda[i], dn_conv_w[i], dn_a_log[i], dn_dt_bias[i],
                           dn_norm_w[i], w_out[i])
        x = x + g1 * mix

        h = rms_norm(x, norm2_w[i]) * (1.0 + sc2) + sh2
        j = i // 2
        if i % 2 == 0:
            ff = swiglu(h, ffn_w_gate[j], ffn_w_up[j], ffn_w_down[j])
        else:
            ff = moe_swiglu(h, router_w[j], moe_w_gate[j], moe_w_up[j], moe_w_down[j])
        x = x + g2 * ff
    return rms_norm(x, final_norm_w)
```

```cpp
#include <hip/hip_runtime.h>
#include <cstdio>
#include <cstdint>

#ifndef MK_ONE_LAUNCH
#define MK_ONE_LAUNCH 0
#endif

namespace pg8 {
#define PG8_LAS __attribute__((address_space(3)))
typedef unsigned short bf16_t;
typedef short bf16x8 __attribute__((ext_vector_type(8)));
typedef float f32x4 __attribute__((ext_vector_type(4)));
typedef unsigned u32x4 __attribute__((ext_vector_type(4)));
constexpr int BM = 256, BK = 64, HALF = 128, HTB = HALF * BK * 2  , STAGE_BYTES = 8 * HTB, NXCD = 8, WGM = 8;

__host__ __device__ __forceinline__ int lds_byte(int r, int c) { const int st = (r >> 4) * 2 + (c >> 5), rr = r & 15, cc = c & 31, ob = rr * 64 + cc * 2; return st * 1024 + (ob ^ (((ob >> 9) & 1) << 5)); }
__host__ __device__ __forceinline__ void stage_rc(int b, int& R, int& C) { const int st = b / 1024, sb = b % 1024, swz = sb ^ (((sb >> 9) & 1) << 5); R = (st >> 1) * 16 + swz / 64; C = (st & 1) * 32 + (swz % 64) / 2; }
__host__ __device__ __forceinline__ int perm32(int rho) { const int n = rho >> 4, i = rho & 15; return 8 * (i >> 2) + 4 * n + (i & 3); }

struct Unit { int pm, pn; };
struct Gemm { const bf16_t* A; const bf16_t* Bt; int M, N, K; };

struct StaticOrder {
    static constexpr bool GATHER = false;
    int nM, nN, nwg, G, c;
    __host__ __device__ void init(int M, int N, int G_, int c_) { nM = M / BM; nN = N / BM; nwg = nM * nN; G = G_; c = c_; }
    __host__ __device__ bool next(int i, Unit& u) const {
        const long L = (long)i * G + c; if (L >= nwg) return false;
        int wgid = (int)L; { const int q = nwg / NXCD, r = nwg % NXCD, xcd = wgid % NXCD, off = wgid / NXCD; wgid = (xcd < r ? xcd * (q + 1) : r * (q + 1) + (xcd - r) * q) + off; }
        const int nig = WGM * nN, gid = wgid / nig, fm = gid * WGM, gsz = (nM - fm) < WGM ? (nM - fm) : WGM;
        u.pm = fm + ((wgid % nig) % gsz); u.pn = (wgid % nig) / gsz; return true;
    }
    __device__ __forceinline__ const char* b_base(const Gemm& g, const Unit& u, size_t tstep) const { return (const char*)g.Bt + (size_t)u.pn * tstep; }
    __device__ __forceinline__ int row_of(const Unit&, int r) const { return r; }
};

__device__ __forceinline__ unsigned cvt_pk_bf16(float lo, float hi) { unsigned r; asm volatile("v_cvt_pk_bf16_f32 %0, %1, %2" : "=v"(r) : "v"(lo), "v"(hi)); return r; }

template <class Epi, class Sched, bool ALIGN_EPI>
__device__ __forceinline__ void gemm_phase(PG8_LAS unsigned char* lds, const Gemm g, const Sched& S, const Epi& E) {
    constexpr bool GA = Sched::GATHER;
    int tid_ = threadIdx.x; asm volatile("" : "+v"(tid_));
    const int tid = tid_, wid = __builtin_amdgcn_readfirstlane(tid >> 6), lane = tid & 63, wr = wid >> 2, wc = wid & 3, fr = lane & 15, fq = lane >> 4;
    const int K = g.K, nt = K / BK;
    unsigned voffA[2], voffB[2]; int RA[2], CA[2];
#pragma unroll
    for (int i = 0; i < 2; ++i) { int R, C; stage_rc(tid * 16 + i * 8192, R, C); const int Rb = Epi::PERM ? ((R & ~31) + perm32(R & 31)) : R; RA[i] = R; CA[i] = C;
        voffA[i] = (unsigned)(R * K + C) * 2u; voffB[i] = (unsigned)(Rb * K + C) * 2u; }
    unsigned vAc[2][2], vAn[2][2];
    const size_t kstep = (size_t)(BK * 2);
    const size_t hstep = (size_t)HALF * K * 2;
    const size_t tstep = 2 * hstep;
    const unsigned ldsw = (unsigned)wid * 1024u;
    const int aoff = lds_byte(wr * 64 + fr, fq * 8), boff = lds_byte(wc * 32 + fr, fq * 8);
#define PG8_SA(b, h) (((b) * 2 + (h)) * HTB)
#define PG8_SB(b, h) ((4 + (b) * 2 + (h)) * HTB)
#define PG8_STAGE(bufoff, gbase, voff) do { _Pragma("unroll") for (int _i = 0; _i < 2; ++_i) \
        __builtin_amdgcn_global_load_lds((const unsigned*)((const char*)(gbase) + (voff)[_i]), (PG8_LAS unsigned*)(lds + (bufoff) + ldsw + _i * 8192), 16, 0, 0); } while (0)
#define PG8_STA(bufoff, kb, h, nx) do { if constexpr (GA) { _Pragma("unroll") for (int _i = 0; _i < 2; ++_i) \
        __builtin_amdgcn_global_load_lds((const unsigned*)((const char*)(kb) + ((nx) ? vAn[h][_i] : vAc[h][_i])), (PG8_LAS unsigned*)(lds + (bufoff) + ldsw + _i * 8192), 16, 0, 0); } \
        else { PG8_STAGE(bufoff, (kb) + (h) * hstep, voffA); } } while (0)
#define PG8_LDA(dst, b, h) do { _Pragma("unroll") for (int m = 0; m < 4; ++m) _Pragma("unroll") for (int k = 0; k < 2; ++k) dst[m][k] = *(const PG8_LAS bf16x8*)(lds + PG8_SA(b, h) + aoff + m * 2048 + k * 1024); } while (0)
#define PG8_LDB(dst, b, h) do { _Pragma("unroll") for (int n = 0; n < 2; ++n) _Pragma("unroll") for (int k = 0; k < 2; ++k) dst[n][k] = *(const PG8_LAS bf16x8*)(lds + PG8_SB(b, h) + boff + n * 2048 + k * 1024); } while (0)
#define PG8_MMA(ai, bj, At, Bt) do { __builtin_amdgcn_s_setprio(1); _Pragma("unroll") for (int m = 0; m < 4; ++m) _Pragma("unroll") for (int n = 0; n < 2; ++n) _Pragma("unroll") for (int k = 0; k < 2; ++k) \
        acc[ai][bj][m][n] = __builtin_amdgcn_mfma_f32_16x16x32_bf16(Bt[n][k], At[m][k], acc[ai][bj][m][n], 0, 0, 0); __builtin_amdgcn_s_setprio(0); } while (0)
#define PG8_WAIT_V(n) asm volatile("s_waitcnt vmcnt(" #n ")" ::: "memory")
#define PG8_WAIT_L(n) asm volatile("s_waitcnt lgkmcnt(" #n ")" ::: "memory")
#define PG8_BAR __builtin_amdgcn_s_barrier()
#define PG8_SCHED __builtin_amdgcn_sched_barrier(0)
    Unit cur, nxt; int ui = 0;
    if (!S.next(0, cur)) return;
    f32x4 acc[2][2][4][2];
#pragma unroll
    for (int a = 0; a < 2; ++a)
#pragma unroll
        for (int b = 0; b < 2; ++b)
#pragma unroll
            for (int m = 0; m < 4; ++m)
#pragma unroll
                for (int n = 0; n < 2; ++n) acc[a][b][m][n] = (f32x4){0.f, 0.f, 0.f, 0.f};
    bf16x8 At[4][2], B0[2][2], B1[2][2];
    const char* cA = GA ? (const char*)g.A : (const char*)g.A + (size_t)cur.pm * tstep; const char* cB = S.b_base(g, cur, tstep);
    if constexpr (GA) {
#pragma unroll
        for (int h = 0; h < 2; ++h)
#pragma unroll
            for (int i = 0; i < 2; ++i) { vAc[h][i] = (unsigned)(S.row_of(cur, h * HALF + RA[i]) * K + CA[i]) * 2u; vAn[h][i] = vAc[h][i]; }
    }
    PG8_STAGE(PG8_SB(0, 0), cB, voffB); PG8_STAGE(PG8_SB(0, 1), cB + hstep, voffB); PG8_STA(PG8_SA(0, 0), cA, 0, false); PG8_STA(PG8_SA(0, 1), cA, 1, false);
    if (wr == 1) PG8_BAR;
    PG8_WAIT_V(2); PG8_BAR;
    PG8_STAGE(PG8_SB(1, 0), cB + kstep, voffB); PG8_STA(PG8_SA(1, 0), cA + kstep, 0, false); PG8_STAGE(PG8_SB(1, 1), cB + hstep + kstep, voffB);
    PG8_WAIT_V(6); PG8_BAR;
    for (;;) {
        const bool has_next = S.next(ui + 1, nxt);
        const char* nA = GA ? cA : (has_next ? (const char*)g.A + (size_t)nxt.pm * tstep : cA); const char* nB = has_next ? S.b_base(g, nxt, tstep) : cB;
        for (int t = 0; t < nt; t += 2) {
            const bool last = (t == nt - 2);
            const char* a1 = cA + (size_t)(t + 1) * kstep;
            const char* a2 = last ? nA : cA + (size_t)(t + 2) * kstep; const char* b2 = last ? nB : cB + (size_t)(t + 2) * kstep;
            const char* a3 = a2 + kstep; const char* b3 = b2 + kstep;
            if constexpr (GA) { if (last && has_next) {
#pragma unroll
                for (int h = 0; h < 2; ++h)
#pragma unroll
                    for (int i = 0; i < 2; ++i) vAn[h][i] = (unsigned)(S.row_of(nxt, h * HALF + RA[i]) * K + CA[i]) * 2u; } }
            PG8_LDB(B0, 0, 0); PG8_LDB(B1, 0, 1); PG8_SCHED; PG8_LDA(At, 0, 0); PG8_STA(PG8_SA(1, 1), a1, 1, false);
            PG8_WAIT_V(8); PG8_WAIT_L(0); PG8_BAR; PG8_MMA(0, 0, At, B0); PG8_MMA(0, 1, At, B1); PG8_BAR; PG8_SCHED;
            PG8_LDA(At, 0, 1); PG8_STAGE(PG8_SB(0, 0), b2, voffB); PG8_STAGE(PG8_SB(0, 1), b2 + hstep, voffB); PG8_STA(PG8_SA(0, 0), a2, 0, last);
            PG8_WAIT_V(8); PG8_WAIT_L(0); PG8_BAR; PG8_MMA(1, 0, At, B0); PG8_MMA(1, 1, At, B1); PG8_BAR; PG8_SCHED;
            PG8_LDB(B0, 1, 0); PG8_LDB(B1, 1, 1); PG8_SCHED; PG8_LDA(At, 1, 0); PG8_STA(PG8_SA(0, 1), a2, 1, last);
            PG8_WAIT_V(8); PG8_WAIT_L(0); PG8_BAR; PG8_MMA(0, 0, At, B0); PG8_MMA(0, 1, At, B1); PG8_BAR; PG8_SCHED;
            PG8_LDA(At, 1, 1); PG8_STAGE(PG8_SB(1, 0), b3, voffB); PG8_STAGE(PG8_SB(1, 1), b3 + hstep, voffB); PG8_STA(PG8_SA(1, 0), a3, 0, last);
            PG8_WAIT_V(8); PG8_WAIT_L(0); PG8_BAR; PG8_MMA(1, 0, At, B0); PG8_MMA(1, 1, At, B1); PG8_BAR; PG8_SCHED;
        }
        if constexpr (ALIGN_EPI) { if (wr == 0) PG8_BAR; }
        E(acc, cur, wr, wc, fr, fq);
        if (!has_next) break;
#pragma unroll
        for (int a = 0; a < 2; ++a)
#pragma unroll
            for (int b = 0; b < 2; ++b)
#pragma unroll
                for (int m = 0; m < 4; ++m)
#pragma unroll
                    for (int n = 0; n < 2; ++n) acc[a][b][m][n] = (f32x4){0.f, 0.f, 0.f, 0.f};
        cur = nxt; cA = nA; cB = nB; ++ui;
        if constexpr (GA) {
#pragma unroll
            for (int h = 0; h < 2; ++h)
#pragma unroll
                for (int i = 0; i < 2; ++i) vAc[h][i] = vAn[h][i];
        }
        if constexpr (ALIGN_EPI) { if (wr == 1) PG8_BAR; }
    }
    PG8_WAIT_V(0);
    if constexpr (!ALIGN_EPI) { if (wr == 0) PG8_BAR; }
    PG8_BAR;
#undef PG8_SA
#undef PG8_SB
#undef PG8_STAGE
#undef PG8_STA
#undef PG8_LDA
#undef PG8_LDB
#undef PG8_MMA
#undef PG8_WAIT_V
#undef PG8_WAIT_L
#undef PG8_BAR
#undef PG8_SCHED
}
}
#define GAS __attribute__((address_space(1)))
#define LAS __attribute__((address_space(3)))
typedef unsigned short bf16;
typedef unsigned v4u __attribute__((ext_vector_type(4)));
typedef float f32x4 __attribute__((ext_vector_type(4)));
typedef short bf16x8 __attribute__((ext_vector_type(8)));
typedef GAS unsigned gu32;
typedef GAS unsigned long long gu64;
#define RLX_AGENT __ATOMIC_RELAXED, __HIP_MEMORY_SCOPE_AGENT
#define LDS_WAIT() asm volatile("s_waitcnt lgkmcnt(0)" ::: "memory")
#define VM_WAIT() asm volatile("s_waitcnt vmcnt(0)" ::: "memory")
__device__ __forceinline__ unsigned long long rt() { return __builtin_amdgcn_s_memrealtime(); }
__device__ __forceinline__ unsigned f2bf(float f) { unsigned u = __builtin_bit_cast(unsigned, f); return (u + 0x7fffu + ((u >> 16) & 1u)) >> 16; }
__device__ __forceinline__ unsigned pk2(float lo, float hi) { return f2bf(lo) | (f2bf(hi) << 16); }
#define XB_TMO      128
#define XB_XCNT(j)  (256  + 64 * (j))
#define XB_XSUB(j)  (1280 + 64 * (j))
#define XB_XGEN(j)  (2304 + 64 * (j))
#define XB_TOP      3328
#define XB_TOPGEN   3392
#define XCD_BAR_WORDS 3456
#define XB_SPIN_CAP (1u << 18)

__device__ __forceinline__ unsigned xb_ld(unsigned* p)              { return __hip_atomic_load(p, __ATOMIC_RELAXED, __HIP_MEMORY_SCOPE_AGENT); }
__device__ __forceinline__ unsigned xb_add(unsigned* p, unsigned v) { return __hip_atomic_fetch_add(p, v, __ATOMIC_RELAXED, __HIP_MEMORY_SCOPE_AGENT); }
__device__ __forceinline__ unsigned xb_xcc_id() { return (unsigned)__builtin_amdgcn_s_getreg((3 << 11) | 20) & 0xFu; }
#define XB_SPIN(cond, bar) do { unsigned _sp = 0; while (cond) { __builtin_amdgcn_s_sleep(1); \
    if ((++_sp & 255u) == 0u) { if (xb_ld(&(bar)[XB_TMO])) break; if (_sp > XB_SPIN_CAP) { atomicAdd(&(bar)[XB_TMO], 1u); break; } } } } while (0)

struct XcdBarrier {
    unsigned* bar; unsigned x;
    volatile LAS unsigned* st;
};

__device__ __forceinline__ XcdBarrier xcd_barrier_post(unsigned* bar, volatile LAS unsigned* st) {
    XcdBarrier b; b.bar = bar; b.x = xb_xcc_id(); b.st = st;
    if (threadIdx.x == 0) (void)xb_add(&bar[XB_XCNT(b.x)], 1u);
    return b;
}
__device__ __forceinline__ void xcd_barrier_complete(unsigned* bar, unsigned x, unsigned& nloc, unsigned& nx) {
    const unsigned G = gridDim.x * gridDim.y * gridDim.z;
    unsigned sum, cnt, mine, sp = 0u;
    for (;;) {
        sum = 0u; cnt = 0u; mine = 0u;
#pragma unroll
        for (unsigned j = 0; j < 16; ++j) { const unsigned c = xb_ld(&bar[XB_XCNT(j)]); sum += c; cnt += (c > 0u) ? 1u : 0u; mine = (j == x) ? c : mine; }
        if (sum == G) break;
        __builtin_amdgcn_s_sleep(1);
        if ((++sp & 255u) == 0u) { if (xb_ld(&bar[XB_TMO])) break; if (sp > XB_SPIN_CAP) { atomicAdd(&bar[XB_TMO], 1u); break; } }
    }
    nloc = mine > 0u ? mine : 1u; nx = cnt > 0u ? cnt : 1u;
}

__device__ __forceinline__ void xcd_barrier(const XcdBarrier& b) {
    asm volatile("s_waitcnt vmcnt(0)" ::: "memory");
    __syncthreads();
    if (threadIdx.x == 0) {
        unsigned* bar = b.bar;
        __builtin_amdgcn_s_waitcnt(0);
        unsigned nloc = b.st[0], nx = b.st[1];
        if (nloc == 0u) { xcd_barrier_complete(bar, b.x, nloc, nx); b.st[0] = nloc; b.st[1] = nx; }
        const unsigned old = xb_add(&bar[XB_XSUB(b.x)], 1u);
        const unsigned gen = old / nloc;
        if (old + 1u == (gen + 1u) * nloc) {
            __builtin_amdgcn_fence(__ATOMIC_RELEASE, "agent");
            asm volatile("s_waitcnt vmcnt(0)" ::: "memory");
            const unsigned og = xb_add(&bar[XB_TOP], 1u);
            const unsigned tg = og / nx;
            if (og + 1u == (tg + 1u) * nx) xb_add(&bar[XB_TOPGEN], 1u);
            else XB_SPIN(xb_ld(&bar[XB_TOPGEN]) == tg, bar);
            __builtin_amdgcn_fence(__ATOMIC_ACQUIRE, "agent");
            xb_add(&bar[XB_XGEN(b.x)], 1u);
            asm volatile("s_waitcnt vmcnt(0)" ::: "memory");
        } else {
            XB_SPIN(xb_ld(&bar[XB_XGEN(b.x)]) == gen, bar);
            __builtin_amdgcn_fence(__ATOMIC_ACQUIRE, "agent");
            asm volatile("s_waitcnt vmcnt(0)" ::: "memory");
        }
    }
    __syncthreads();
}

constexpr int D = 1024, NBATCH = 8, SEQ = 4096, T = NBATCH * SEQ, DIN = 3228, DINP = 3328, DFF = 2816, NEXP = 8, DFFE = 3584, NCHUNK = 64;
constexpr int C_GQ = 0, C_GK = 192, C_GV = 384, C_GZ = 768, C_GLR = 1152, C_LX = 1168, C_LG = 1424, C_DQ = 1680, C_DK = 2064, C_DV = 2448, C_DZ = 2832, C_DB = 3216, C_DA = 3222;
constexpr int MODW = 6 * D;
constexpr float EPS = 1e-6f;
constexpr int NWAVES = 8, NTHR = 512;
constexpr int MOE_ROWS = T + NEXP * 256;
constexpr int MOE_TILES = MOE_ROWS / 256;
constexpr int TILE_TAB = 160;

constexpr size_t MiB = 1u << 20;
constexpr size_t WS_CTL = 0, CTL_ZERO_BYTES = 1 * MiB;
constexpr size_t WS_MOD = 1 * MiB;
constexpr size_t WS_ROUTE_E = 2 * MiB;
constexpr size_t WS_ROUTE_W = 3 * MiB;
constexpr size_t WS_WCNT = 4 * MiB;
constexpr size_t WS_LIST = 5 * MiB;
constexpr size_t WS_ROWW = 6 * MiB;
constexpr size_t WS_TILES = 7 * MiB;
constexpr size_t WS_DNDEC = 7 * MiB + 65536;
constexpr size_t WS_WIN = 8 * MiB;
constexpr size_t WS_WOUT = 21 * MiB;
constexpr size_t WS_WGU = 25 * MiB;
constexpr size_t WS_WDN = 36 * MiB;
constexpr size_t WS_H = 42 * MiB;
constexpr size_t WS_PROJ = 106 * MiB;
constexpr size_t WS_DN = 344 * MiB;
constexpr size_t WS_MOEGU = 344 * MiB;
constexpr size_t WS_MOEDN = 456 * MiB;
constexpr size_t WS_END = 512 * MiB;
static_assert(WS_PROJ + (size_t)MOE_ROWS * DFFE * 2 <= WS_DN && WS_DN + (size_t)3072 * 5 * 8192 <= WS_END && WS_MOEGU + (size_t)8 * 7168 * 1024 * 2 <= WS_MOEDN && WS_MOEDN + (size_t)8 * 1024 * 3584 * 2 <= WS_END, "d_ws map");
static_assert(WS_H + (size_t)T * D * 2 <= WS_PROJ && WS_WDN + (size_t)1024 * 2816 * 2 <= WS_H, "d_ws map");
constexpr int CW_TMO = 0, CW_CODE = 1, CW_BAR = 4096;

constexpr int RING_BYTES = 131072;
constexpr int MISC_OFF = RING_BYTES + 320;
constexpr int PTR_OFF = RING_BYTES + 512;
constexpr int TAB_OFF = RING_BYTES + 1024;
constexpr int LDS_BYTES = 147456;

#define DI __device__ __forceinline__
typedef float f32x2 __attribute__((ext_vector_type(2)));
typedef unsigned u32x2 __attribute__((ext_vector_type(2)));

DI float bf2f(unsigned b) { return __uint_as_float(b << 16); }
DI void unpack8(const v4u w, float (&f)[8]) {
    f[0] = __uint_as_float(w.x << 16); f[1] = __uint_as_float(w.x & 0xffff0000u); f[2] = __uint_as_float(w.y << 16); f[3] = __uint_as_float(w.y & 0xffff0000u);
    f[4] = __uint_as_float(w.z << 16); f[5] = __uint_as_float(w.z & 0xffff0000u); f[6] = __uint_as_float(w.w << 16); f[7] = __uint_as_float(w.w & 0xffff0000u); }
DI void unpack4(const u32x2 w, float (&f)[4]) { f[0] = __uint_as_float(w.x << 16); f[1] = __uint_as_float(w.x & 0xffff0000u); f[2] = __uint_as_float(w.y << 16); f[3] = __uint_as_float(w.y & 0xffff0000u); }
DI v4u pack8(const float (&f)[8]) { v4u w; w.x = pk2(f[0], f[1]); w.y = pk2(f[2], f[3]); w.z = pk2(f[4], f[5]); w.w = pk2(f[6], f[7]); return w; }
DI u32x2 pack4(float a, float b, float c, float d) { u32x2 w; w.x = pk2(a, b); w.y = pk2(c, d); return w; }
DI float sigm(float x) { return 1.0f / (1.0f + __expf(-x)); }
DI float silu(float x) { return x / (1.0f + __expf(-x)); }
DI float softplus(float x) { return x > 20.0f ? x : log1pf(__expf(x)); }
DI float gelu_tanh(float x) { const float u = 0.7978845608028654f * (x + 0.044715f * x * x * x); return 0.5f * x * (1.0f + tanhf(u)); }
DI float wave_sum(float v) {
#pragma unroll
    for (int o = 1; o < 64; o <<= 1) v += __shfl_xor(v, o);
    return v;
}
template <int K> DI f32x4 mm16(const LAS bf16* A, int lda, const LAS bf16* Bt, int ldb, f32x4 acc, int lane) {
    const int r = lane & 15, q = lane >> 4;
#pragma unroll
    for (int k0 = 0; k0 < K; k0 += 32) {
        const bf16x8 a = *(const LAS bf16x8*)(A + r * lda + k0 + q * 8);
        const bf16x8 b = *(const LAS bf16x8*)(Bt + r * ldb + k0 + q * 8);
        acc = __builtin_amdgcn_mfma_f32_16x16x32_bf16(a, b, acc, 0, 0, 0);
    }
    return acc;
}
#define SYNC() __syncthreads()

namespace pg8 {
struct EpiStoreBf16 {
    static constexpr bool PERM = true;
    bf16_t* O; int ldc;
    DI void operator()(const f32x4 (&acc)[2][2][4][2], const Unit& u, int wr, int wc, int fr, int fq) const {
        const int row0 = u.pm * BM + wr * 64 + fr, col0 = u.pn * BM + wc * 32 + 8 * fq;
#pragma unroll
        for (int ai = 0; ai < 2; ++ai)
#pragma unroll
            for (int m = 0; m < 4; ++m) { bf16_t* rowp = O + (size_t)(row0 + ai * HALF + m * 16) * ldc + col0;
#pragma unroll
                for (int bj = 0; bj < 2; ++bj) { const f32x4 v0 = acc[ai][bj][m][0], v1 = acc[ai][bj][m][1];
                    u32x4 w; w.x = cvt_pk_bf16(v0[0], v0[1]); w.y = cvt_pk_bf16(v0[2], v0[3]); w.z = cvt_pk_bf16(v1[0], v1[1]); w.w = cvt_pk_bf16(v1[2], v1[3]);
                    *(u32x4*)(rowp + bj * HALF) = w; } }
    }
};
struct EpiRes {
    static constexpr bool PERM = false;
    const float* base; float* out; const float* gate; int ldc;
    DI void operator()(const f32x4 (&acc)[2][2][4][2], const Unit& u, int wr, int wc, int fr, int fq) const {
        const int row0 = u.pm * BM + wr * 64 + fr, col0 = u.pn * BM + wc * 32 + 4 * fq;
        const float* gp = gate + (size_t)((u.pm * BM) / SEQ) * MODW + col0;
        f32x4 gv[2][2];
#pragma unroll
        for (int bj = 0; bj < 2; ++bj)
#pragma unroll
            for (int n = 0; n < 2; ++n) gv[bj][n] = *(const f32x4*)(gp + bj * HALF + n * 16);
#pragma unroll
        for (int ai = 0; ai < 2; ++ai)
#pragma unroll
            for (int m = 0; m < 4; ++m) { const size_t off = (size_t)(row0 + ai * HALF + m * 16) * ldc + col0;
#pragma unroll
                for (int bj = 0; bj < 2; ++bj)
#pragma unroll
                    for (int n = 0; n < 2; ++n) { const f32x4 bs = *(const f32x4*)(base + off + bj * HALF + n * 16); *(f32x4*)(out + off + bj * HALF + n * 16) = bs + gv[bj][n] * acc[ai][bj][m][n]; }
                asm volatile("" ::: "memory"); }
    }
};
struct EpiSwiglu {
    static constexpr bool PERM = true;
    bf16_t* O; int ldc;
    DI void operator()(const f32x4 (&acc)[2][2][4][2], const Unit& u, int wr, int wc, int fr, int fq) const {
        const int row0 = u.pm * BM + wr * 64 + fr, col0 = u.pn * HALF + wc * 32 + 8 * fq;
#pragma unroll
        for (int ai = 0; ai < 2; ++ai)
#pragma unroll
            for (int m = 0; m < 4; ++m) { bf16_t* rowp = O + (size_t)(row0 + ai * HALF + m * 16) * ldc + col0;
                float v[8];
#pragma unroll
                for (int n = 0; n < 2; ++n)
#pragma unroll
                    for (int j = 0; j < 4; ++j) { const float g = acc[ai][0][m][n][j], up = acc[ai][1][m][n][j];
                        v[n * 4 + j] = g * __builtin_amdgcn_rcpf(1.0f + __builtin_amdgcn_exp2f(-1.4426950408889634f * g)) * up; }
                u32x4 w; w.x = cvt_pk_bf16(v[0], v[1]); w.y = cvt_pk_bf16(v[2], v[3]); w.z = cvt_pk_bf16(v[4], v[5]); w.w = cvt_pk_bf16(v[6], v[7]);
                *(u32x4*)rowp = w; }
    }
};
struct EpiMoeDown {
    static constexpr bool PERM = false;
    float* out; const float* gate; const int* list; const float* roww;
    DI void operator()(const f32x4 (&acc)[2][2][4][2], const Unit& u, int wr, int wc, int fr, int fq) const {
        const int row0 = u.pm * BM + wr * 64 + fr, col0 = u.pn * BM + wc * 32 + 4 * fq;
#pragma unroll
        for (int ai = 0; ai < 2; ++ai)
#pragma unroll
            for (int m = 0; m < 4; ++m) { const int r = row0 + ai * HALF + m * 16; const int tok = list[r]; const float rw = roww[r];
                if (tok >= 0) { float* op = out + (size_t)tok * D + col0; const float* gp = gate + (size_t)(tok / SEQ) * MODW + col0;
#pragma unroll
                    for (int bj = 0; bj < 2; ++bj)
#pragma unroll
                        for (int n = 0; n < 2; ++n) { const f32x4 gv = *(const f32x4*)(gp + bj * HALF + n * 16); const f32x4 bs = *(const f32x4*)(op + bj * HALF + n * 16);
                            *(f32x4*)(op + bj * HALF + n * 16) = bs + (gv * rw) * acc[ai][bj][m][n]; } }
                asm volatile("" ::: "memory"); }
    }
};
template <bool GATHER_> struct MoeOrder {
    static constexpr bool GATHER = GATHER_;
    int nM, nN, nwg, G, c; const LAS int* tile_e; const int* list; size_t eB;
    DI void init(int nM_, int N, int G_, int c_) { nM = nM_; nN = N / BM; nwg = nM * nN; G = G_; c = c_; }
    DI bool next(int i, Unit& u) const {
        const long L = (long)i * G + c; if (L >= nwg) return false;
        int wgid = (int)L; { const int q = nwg / NXCD, r = nwg % NXCD, xcd = wgid % NXCD, off = wgid / NXCD; wgid = (xcd < r ? xcd * (q + 1) : r * (q + 1) + (xcd - r) * q) + off; }
        const int nig = WGM * nN, gid = wgid / nig, fm = gid * WGM, gsz = (nM - fm) < WGM ? (nM - fm) : WGM;
        u.pm = fm + ((wgid % nig) % gsz); u.pn = (wgid % nig) / gsz; return true;
    }
    DI const char* b_base(const Gemm& g, const Unit& u, size_t tstep) const { return (const char*)g.Bt + (size_t)tile_e[u.pm] * eB + (size_t)u.pn * tstep; }
    DI int row_of(const Unit& u, int r) const { const int tok = list[u.pm * BM + r]; return tok < 0 ? 0 : tok; }
};
}

struct Ctx { LAS unsigned char* lds; int tid, lane, wave, vcu, G, gw, NGW; };

DI void xpose_item(const float* W, int K, int N, bf16* WT, int drow0, LAS float* scr, int k0, int n0, int lane) {
    const int kr = lane >> 3, c4 = (lane & 7) * 4;
#pragma unroll
    for (int i = 0; i < 8; ++i) { const int kk = i * 8 + kr; f32x4 v = (f32x4){0.f, 0.f, 0.f, 0.f};
        if (n0 + c4 < N) v = *(const f32x4*)(W + (size_t)(k0 + kk) * N + n0 + c4);
        scr[kk * 33 + c4 + 0] = v.x; scr[kk * 33 + c4 + 1] = v.y; scr[kk * 33 + c4 + 2] = v.z; scr[kk * 33 + c4 + 3] = v.w; }
    LDS_WAIT(); asm volatile("" ::: "memory");
    const int c = lane & 7;
#pragma unroll
    for (int j = 0; j < 4; ++j) { const int n = (lane >> 3) + 8 * j; const LAS float* s = scr + (8 * c) * 33 + n;
        v4u o; o.x = pk2(s[0 * 33], s[1 * 33]); o.y = pk2(s[2 * 33], s[3 * 33]); o.z = pk2(s[4 * 33], s[5 * 33]); o.w = pk2(s[6 * 33], s[7 * 33]);
        *(v4u*)(WT + (size_t)(drow0 + n) * K + k0 + 8 * c) = o; }
    LDS_WAIT(); asm volatile("" ::: "memory");
}
DI bool xp_try(int& r, const float* W, int K, int N, int Npad, bf16* WT, int mode, LAS float* scr, int lane) {
    const int nblk = Npad / 32, items = (K / 64) * nblk;
    if (r >= items) { r -= items; return false; }
    const int kb = r / nblk, n0 = (r % nblk) * 32;
    const int drow0 = mode == 0 ? n0 : ((n0 >> 7) * 256 + (n0 & 127) + (mode == 2 ? 128 : 0));
    xpose_item(W, K, N, WT, drow0, scr, kb * 64, n0, lane); return true;
}
struct In { const float* p[30]; };
struct PtrTab { const LAS unsigned long long* t;
    DI const float* operator[](int k) const { const unsigned long long v = t[k]; const unsigned lo = __builtin_amdgcn_readfirstlane((unsigned)v), hi = __builtin_amdgcn_readfirstlane((unsigned)(v >> 32));
        return (const float*)(((unsigned long long)hi << 32) | lo); } };
struct InT { PtrTab p; };
DI void prologue_phase(const Ctx& X, const InT& I, unsigned char* ws) {
    for (int it = X.vcu; it < 2 * (MODW / 64); it += X.G) {
        const int L = it / (MODW / 64), n = (it % (MODW / 64)) * 64 + X.lane;
        const float* aw = I.p[20] + (size_t)L * D * MODW + n; const float* cc = I.p[1];
        float acc[8];
#pragma unroll
        for (int b = 0; b < 8; ++b) acc[b] = 0.f;
        const int kb = X.wave * 128;
#pragma unroll 4
        for (int k = kb; k < kb + 128; ++k) { const float w = aw[(size_t)k * MODW];
#pragma unroll
            for (int b = 0; b < 8; ++b) acc[b] += silu(cc[b * D + k]) * w; }
        LAS float* red = (LAS float*)(X.lds + 81920);
#pragma unroll
        for (int b = 0; b < 8; ++b) red[(X.wave * 8 + b) * 64 + X.lane] = acc[b];
        SYNC();
        float s = I.p[21][(size_t)L * MODW + n];
#pragma unroll
        for (int w = 0; w < 8; ++w) s += red[(w * 8 + X.wave) * 64 + X.lane];
        ((float*)(ws + WS_MOD))[((size_t)L * 8 + X.wave) * MODW + n] = s;
        SYNC();
    }
    LAS float* scr = (LAS float*)(X.lds + X.wave * 8704);
    constexpr int I_IN = 16 * (DINP / 32), I_OUT = 16 * 32, I_G = 16 * (DFF / 32), I_D = (DFF / 64) * 32;
    constexpr int NITEMS = 2 * I_IN + 2 * I_OUT + 2 * I_G + I_D;
    for (int it = X.gw; it < NITEMS; it += X.NGW) {
        int r = it;
        if (xp_try(r, I.p[2], D, DIN, DINP, (bf16*)(ws + WS_WIN), 0, scr, X.lane)) continue;
        if (xp_try(r, I.p[2] + (size_t)D * DIN, D, DIN, DINP, (bf16*)(ws + WS_WIN) + (size_t)DINP * D, 0, scr, X.lane)) continue;
        if (xp_try(r, I.p[17], D, D, D, (bf16*)(ws + WS_WOUT), 0, scr, X.lane)) continue;
        if (xp_try(r, I.p[17] + (size_t)D * D, D, D, D, (bf16*)(ws + WS_WOUT) + (size_t)D * D, 0, scr, X.lane)) continue;
        if (xp_try(r, I.p[22], D, DFF, DFF, (bf16*)(ws + WS_WGU), 1, scr, X.lane)) continue;
        if (xp_try(r, I.p[23], D, DFF, DFF, (bf16*)(ws + WS_WGU), 2, scr, X.lane)) continue;
        xp_try(r, I.p[24], DFF, D, D, (bf16*)(ws + WS_WDN), 0, scr, X.lane);
    }
}
DI void moe_convert(const Ctx& X, const InT& I, unsigned char* ws) {
    LAS float* scr = (LAS float*)(X.lds + 40960 + X.wave * 8704);
    constexpr int PER = 1792, NITEMS = 3 * NEXP * PER;
    for (int it = X.gw; it < NITEMS; it += X.NGW) {
        const int mat = it / PER; int r = it % PER; const int e = mat / 3, which = mat % 3;
        if (which == 0) xp_try(r, I.p[26] + (size_t)e * D * DFFE, D, DFFE, DFFE, (bf16*)(ws + WS_MOEGU) + (size_t)e * 2 * DFFE * D, 1, scr, X.lane);
        else if (which == 1) xp_try(r, I.p[27] + (size_t)e * D * DFFE, D, DFFE, DFFE, (bf16*)(ws + WS_MOEGU) + (size_t)e * 2 * DFFE * D, 2, scr, X.lane);
        else xp_try(r, I.p[28] + (size_t)e * DFFE * D, DFFE, D, D, (bf16*)(ws + WS_MOEDN) + (size_t)e * D * DFFE, 0, scr, X.lane);
    }
}

template <bool ROUTER> DI void norm_phase(const Ctx& X, const float* xin, const float* nw, const float* modL, int sh_off, int sc_off, bf16* hout, const float* router_w, unsigned char* ws) {
    LAS float* rw = (LAS float*)X.lds;
    if (ROUTER) { for (int i = X.tid; i < D * NEXP / 4; i += NTHR) ((LAS f32x4*)rw)[i] = ((const f32x4*)router_w)[i]; SYNC(); }
    for (int rb = X.gw; rb < T / 16; rb += X.NGW) {
        const int m0 = rb * 16, b = m0 / SEQ;
        f32x4 a[4], s[4];
#pragma unroll
        for (int j = 0; j < 4; ++j) { const int col = 4 * X.lane + 256 * j; const f32x4 w = *(const f32x4*)(nw + col), sc = *(const f32x4*)(modL + (size_t)b * MODW + sc_off + col);
            a[j] = w * (1.0f + sc); s[j] = *(const f32x4*)(modL + (size_t)b * MODW + sh_off + col); }
        unsigned long long cnt0 = 0ull, cnt1 = 0ull;
        for (int jr = 0; jr < 16; ++jr) {
            const int m = m0 + jr; const f32x4* xr = (const f32x4*)(xin + (size_t)m * D) + X.lane;
            f32x4 v[4]; float ss = 0.f;
#pragma unroll
            for (int j = 0; j < 4; ++j) { v[j] = xr[64 * j]; ss += (v[j].x * v[j].x + v[j].y * v[j].y) + (v[j].z * v[j].z + v[j].w * v[j].w); }
            const float rstd = 1.0f / sqrtf(wave_sum(ss) * (1.0f / D) + EPS);
            unsigned long long* o8 = (unsigned long long*)(hout + (size_t)m * D) + X.lane;
#pragma unroll
            for (int j = 0; j < 4; ++j) { v[j] = v[j] * rstd * a[j] + s[j]; o8[64 * j] = (unsigned long long)pk2(v[j].x, v[j].y) | ((unsigned long long)pk2(v[j].z, v[j].w) << 32); }
            if (ROUTER) {
                float lg[8];
#pragma unroll
                for (int e = 0; e < 8; ++e) lg[e] = 0.f;
#pragma unroll
                for (int j = 0; j < 4; ++j)
#pragma unroll
                    for (int i = 0; i < 4; ++i) { const int col = 4 * X.lane + 256 * j + i; const f32x4 w0 = *(const LAS f32x4*)(rw + col * 8), w1 = *(const LAS f32x4*)(rw + col * 8 + 4); const float hv = v[j][i];
                        lg[0] += hv * w0.x; lg[1] += hv * w0.y; lg[2] += hv * w0.z; lg[3] += hv * w0.w; lg[4] += hv * w1.x; lg[5] += hv * w1.y; lg[6] += hv * w1.z; lg[7] += hv * w1.w; }
#pragma unroll
                for (int e = 0; e < 8; ++e) lg[e] = wave_sum(lg[e]);
                int e0 = 0; float v0 = lg[0];
#pragma unroll
                for (int e = 1; e < 8; ++e) if (lg[e] > v0) { v0 = lg[e]; e0 = e; }
                int e1 = -1; float v1 = -3.0e38f;
#pragma unroll
                for (int e = 0; e < 8; ++e) if (e != e0 && lg[e] > v1) { v1 = lg[e]; e1 = e; }
                const float w1 = 1.0f / (1.0f + __expf(v0 - v1)), w0 = 1.0f - w1;
                cnt0 += 1ull << (8 * e0); cnt1 += 1ull << (8 * e1);
                if (X.lane == 0) { ((int*)(ws + WS_ROUTE_E))[m] = e0 | (e1 << 8); ((f32x2*)(ws + WS_ROUTE_W))[m] = (f32x2){w0, w1}; }
            }
        }
        if (ROUTER && X.lane == 0) { ((unsigned long long*)(ws + WS_WCNT))[rb * 2] = cnt0; ((unsigned long long*)(ws + WS_WCNT))[rb * 2 + 1] = cnt1; }
    }
}
DI void final_norm_phase(const Ctx& X, const float* xin, const float* nw, float* out) {
    f32x4 a[4];
#pragma unroll
    for (int j = 0; j < 4; ++j) a[j] = *(const f32x4*)(nw + 4 * X.lane + 256 * j);
    for (int m = X.gw; m < T; m += X.NGW) {
        const f32x4* xr = (const f32x4*)(xin + (size_t)m * D) + X.lane; f32x4 v[4]; float ss = 0.f;
#pragma unroll
        for (int j = 0; j < 4; ++j) { v[j] = xr[64 * j]; ss += (v[j].x * v[j].x + v[j].y * v[j].y) + (v[j].z * v[j].z + v[j].w * v[j].w); }
        const float rstd = 1.0f / sqrtf(wave_sum(ss) * (1.0f / D) + EPS);
        f32x4* o = (f32x4*)(out + (size_t)m * D) + X.lane;
#pragma unroll
        for (int j = 0; j < 4; ++j) o[64 * j] = v[j] * rstd * a[j];
    }
}

DI void moe_list_phase(const Ctx& X, unsigned char* ws) {
    const unsigned long long* wc = (const unsigned long long*)(ws + WS_WCNT);
    int* list = (int*)(ws + WS_LIST); float* roww = (float*)(ws + WS_ROWW); int* tiles = (int*)(ws + WS_TILES);
    for (int rb = X.gw; rb < T / 16; rb += X.NGW) {
        int tot[2][8], pre[2][8];
#pragma unroll
        for (int s = 0; s < 2; ++s)
#pragma unroll
            for (int e = 0; e < 8; ++e) { tot[s][e] = 0; pre[s][e] = 0; }
        for (int r2 = X.lane; r2 < T / 16; r2 += 64) {
            const unsigned long long c0 = wc[r2 * 2], c1 = wc[r2 * 2 + 1]; const bool lt = r2 < rb;
#pragma unroll
            for (int e = 0; e < 8; ++e) { const int a0 = (int)((c0 >> (8 * e)) & 0xffull), a1 = (int)((c1 >> (8 * e)) & 0xffull);
                tot[0][e] += a0; tot[1][e] += a1; pre[0][e] += lt ? a0 : 0; pre[1][e] += lt ? a1 : 0; }
        }
#pragma unroll
        for (int s = 0; s < 2; ++s)
#pragma unroll
            for (int e = 0; e < 8; ++e) {
#pragma unroll
                for (int o = 1; o < 64; o <<= 1) { tot[s][e] += __shfl_xor(tot[s][e], o); pre[s][e] += __shfl_xor(pre[s][e], o); } }
        int base[2][8], nt[2];
#pragma unroll
        for (int s = 0; s < 2; ++s) { int acc = 0;
#pragma unroll
            for (int e = 0; e < 8; ++e) { base[s][e] = acc; acc += (tot[s][e] + 255) & ~255; } nt[s] = acc / 256; }
        const int j = X.lane & 15, m = rb * 16 + j;
        const int ee = ((const int*)(ws + WS_ROUTE_E))[m]; const f32x2 ww = ((const f32x2*)(ws + WS_ROUTE_W))[m];
#pragma unroll
        for (int s = 0; s < 2; ++s) {
            const int es = s == 0 ? (ee & 0xff) : ((ee >> 8) & 0xff);
            int pos = 0;
#pragma unroll
            for (int e = 0; e < 8; ++e) pos = (es == e) ? base[s][e] + pre[s][e] : pos;
            int rank = 0;
#pragma unroll
            for (int jj = 0; jj < 16; ++jj) { const int eo = __shfl(es, jj); rank += (jj < j && eo == es) ? 1 : 0; }
            if (X.lane < 16) { list[s * MOE_ROWS + pos + rank] = m; roww[s * MOE_ROWS + pos + rank] = s == 0 ? ww.x : ww.y; }
        }
        if (rb == 0) {
#pragma unroll
            for (int s = 0; s < 2; ++s) {
#pragma unroll
                for (int e = 0; e < 8; ++e) { const int lo = base[s][e] + tot[s][e], hi = base[s][e] + ((tot[s][e] + 255) & ~255);
                    for (int r = lo + X.lane; r < hi; r += 64) { list[s * MOE_ROWS + r] = -1; roww[s * MOE_ROWS + r] = 0.f; }
                    for (int t = base[s][e] / 256 + X.lane; t < hi / 256; t += 64) tiles[s * TILE_TAB + t] = e; }
                if (X.lane == 0) tiles[s * TILE_TAB + TILE_TAB - 1] = nt[s];
            }
        }
    }
}

DI void dn_prep_phase(const Ctx& X, const bf16* proj, const float* convw, const float* a_log, const float* dt_bias, unsigned char* ws) {
    LAS float* qf = (LAS float*)(X.lds + 0); LAS float* kf = (LAS float*)(X.lds + 16640); LAS float* vf = (LAS float*)(X.lds + 33280);
    LAS float* Lm = (LAS float*)(X.lds + 49920);
    LAS bf16* Qb = (LAS bf16*)(X.lds + 67328); LAS bf16* Kb = (LAS bf16*)(X.lds + 76544); LAS bf16* KBb = (LAS bf16*)(X.lds + 85760);
    LAS float* xs = (LAS float*)(X.lds + 96256);
    LAS float* gcv = (LAS float*)(X.lds + 94976); LAS float* betav = gcv + 64; LAS float* egv = gcv + 128; LAS float* ekv = gcv + 192; LAS float* gv = gcv + 256;
    const int tid = X.tid, lane = X.lane;
    for (int i = tid; i < 64 * 128; i += NTHR) xs[i] = 0.f;
    for (int u = X.vcu; u < NBATCH * 6 * NCHUNK; u += X.G) {
        const int b = u / (6 * NCHUNK), h = (u / NCHUNK) % 6, n = u % NCHUNK;
        const size_t row0 = (size_t)b * SEQ + (size_t)n * 64;
        bf16* ub = (bf16*)(ws + WS_DN) + (size_t)u * 5 * 4096;
        for (int it = tid; it < 64 * 24; it += NTHR) {
            const int t = it / 24, g8 = it % 24, which = g8 >> 3, d0 = (g8 & 7) * 8;
            const int col = (which == 0 ? C_DQ : (which == 1 ? C_DK : C_DV)) + h * 64 + d0, cch = which * 384 + h * 64 + d0;
            float y[8];
#pragma unroll
            for (int i = 0; i < 8; ++i) y[i] = 0.f;
#pragma unroll
            for (int j = 0; j < 4; ++j) { const int tt = n * 64 + t - 3 + j;
                if (tt >= 0) { const v4u xv = *(const v4u*)(proj + ((size_t)b * SEQ + tt) * DINP + col); float xf[8]; unpack8(xv, xf);
                    const f32x4 w0 = *(const f32x4*)(convw + j * 1152 + cch), w1 = *(const f32x4*)(convw + j * 1152 + cch + 4);
                    y[0] += w0.x * xf[0]; y[1] += w0.y * xf[1]; y[2] += w0.z * xf[2]; y[3] += w0.w * xf[3]; y[4] += w1.x * xf[4]; y[5] += w1.y * xf[5]; y[6] += w1.z * xf[6]; y[7] += w1.w * xf[7]; } }
            LAS float* dst = (which == 0 ? qf : (which == 1 ? kf : vf)) + t * 65 + d0;
#pragma unroll
            for (int i = 0; i < 8; ++i) dst[i] = silu(y[i]);
        }
        if (tid < 64) { const size_t r = (row0 + tid) * DINP; betav[tid] = sigm(bf2f(proj[r + C_DB + h])); gv[tid] = -__expf(a_log[h]) * softplus(bf2f(proj[r + C_DA + h]) + dt_bias[h]); }
        SYNC();
        { const int rr = tid >> 2, p = tid & 3, t = rr & 63, isK = rr >> 6; LAS float* buf = (isK ? kf : qf) + t * 65 + p * 16;
            float xv[16]; float ss = 0.f;
#pragma unroll
            for (int i = 0; i < 16; ++i) { xv[i] = buf[i]; ss += xv[i] * xv[i]; }
            ss += __shfl_xor(ss, 1); ss += __shfl_xor(ss, 2);
            const float sc = (1.0f / sqrtf(ss + EPS)) * (isK ? 1.0f : 0.125f), bt = betav[t];
#pragma unroll
            for (int i = 0; i < 16; ++i) { xv[i] *= sc; buf[i] = xv[i]; }
            LAS bf16* o1 = (isK ? Kb : Qb) + t * 72 + p * 16;
#pragma unroll
            for (int i = 0; i < 16; i += 4) *(LAS u32x2*)(o1 + i) = pack4(xv[i], xv[i + 1], xv[i + 2], xv[i + 3]);
            if (isK) { LAS bf16* o2 = KBb + t * 72 + p * 16;
#pragma unroll
                for (int i = 0; i < 16; i += 4) *(LAS u32x2*)(o2 + i) = pack4(xv[i] * bt, xv[i + 1] * bt, xv[i + 2] * bt, xv[i + 3] * bt); }
        }
        if (X.wave == 0) { float v = gv[lane];
#pragma unroll
            for (int o = 1; o < 64; o <<= 1) { const float up = __shfl_up(v, o); if (lane >= o) v += up; }
            const float gl = __shfl(v, 63);
            gcv[lane] = v; egv[lane] = __expf(v); ekv[lane] = __expf(gl - v);
            if (lane == 63) ((float*)(ws + WS_DNDEC))[u] = __expf(gl); }
        SYNC();
        { const int tr = X.wave >> 1, r = lane & 15, q = lane >> 4;
#pragma unroll
            for (int e = 0; e < 2; ++e) { const int tc = (X.wave & 1) * 2 + e;
                const f32x4 z = (f32x4){0.f, 0.f, 0.f, 0.f};
                const f32x4 akk = mm16<64>(KBb + 16 * tr * 72, 72, Kb + 16 * tc * 72, 72, z, lane);
                const f32x4 aqk = mm16<64>(Qb + 16 * tr * 72, 72, Kb + 16 * tc * 72, 72, z, lane);
                const int j = 16 * tc + r; const float gj = gcv[j];
#pragma unroll
                for (int ii = 0; ii < 4; ++ii) { const int i = 16 * tr + q * 4 + ii; const float dec = __expf(fminf(gcv[i] - gj, 0.f));
                    Lm[i * 68 + j] = (j < i) ? akk[ii] * dec : 0.f;
                    ub[4 * 4096 + i * 64 + j] = (bf16)f2bf((j <= i) ? aqk[ii] * dec : 0.f); } } }
        SYNC();
        if (tid < 128) {
            const int c = tid & 63; const bool isW = tid >= 64;
            for (int i = 0; i < 64; ++i) {
                float s0 = isW ? kf[i * 65 + c] * betav[i] * egv[i] : vf[i * 65 + c] * betav[i], s1 = 0.f, s2 = 0.f, s3 = 0.f;
                for (int j = 0; j < i; j += 4) { const f32x4 l = *(const LAS f32x4*)(Lm + i * 68 + j);
                    s0 -= l.x * xs[(j + 0) * 128 + tid]; s1 -= l.y * xs[(j + 1) * 128 + tid]; s2 -= l.z * xs[(j + 2) * 128 + tid]; s3 -= l.w * xs[(j + 3) * 128 + tid]; }
                xs[i * 128 + tid] = (s0 + s1) + (s2 + s3);
            }
            if (!isW) {
#pragma unroll
                for (int t8 = 0; t8 < 8; ++t8) { float f[8];
#pragma unroll
                    for (int i = 0; i < 8; ++i) f[i] = xs[(8 * t8 + i) * 128 + tid];
                    *(v4u*)(ub + 1 * 4096 + c * 64 + 8 * t8) = pack8(f); }
            } else {
                for (int t = 0; t < 64; ++t) ub[t * 64 + c] = (bf16)f2bf(xs[t * 128 + tid]);
            }
        } else {
            for (int it = tid - 128; it < 1024; it += NTHR - 128) {
                float f[8];
                if (it < 512) { const int d = it >> 3, t0 = (it & 7) * 8;
#pragma unroll
                    for (int i = 0; i < 8; ++i) f[i] = kf[(t0 + i) * 65 + d] * ekv[t0 + i];
                    *(v4u*)(ub + 2 * 4096 + d * 64 + t0) = pack8(f);
                } else { const int i2 = it - 512, t = i2 >> 3, d0 = (i2 & 7) * 8; const float e = egv[t];
#pragma unroll
                    for (int i = 0; i < 8; ++i) f[i] = qf[t * 65 + d0 + i] * e;
                    *(v4u*)(ub + 3 * 4096 + t * 64 + d0) = pack8(f); }
            }
        }
        SYNC();
    }
}

DI void dn_chain(const Ctx& X, int bh, const bf16* proj, const float* normw, const unsigned char* ws, bf16* merged) {
    LAS bf16* Wl = (LAS bf16*)(X.lds + 0); LAS bf16* Utl = (LAS bf16*)(X.lds + 9216); LAS bf16* KEl = (LAS bf16*)(X.lds + 18432); LAS bf16* QDl = (LAS bf16*)(X.lds + 27648); LAS bf16* QKl = (LAS bf16*)(X.lds + 36864);
    LAS bf16* St0 = (LAS bf16*)(X.lds + 46080); LAS bf16* Vtl = (LAS bf16*)(X.lds + 64512); LAS float* Of = (LAS float*)(X.lds + 73728);
    const int tid = X.tid, lane = X.lane, b = bh / 6, h = bh % 6;
    const int prow = tid >> 3, pseg = (tid & 7) * 8;
    const int tr = X.wave >> 1, r = lane & 15, q = lane >> 4;
    const bf16* ubase = (const bf16*)(ws + WS_DN) + (size_t)bh * NCHUNK * 5 * 4096;
    const float* decp = (const float*)(ws + WS_DNDEC) + bh * NCHUNK;
    float nwv[8];
#pragma unroll
    for (int i = 0; i < 8; ++i) nwv[i] = normw[pseg + i];
    for (int i = tid; i < 2 * 64 * 72 / 2; i += NTHR) ((LAS unsigned*)St0)[i] = 0u;
    v4u pf[5];
#pragma unroll
    for (int k = 0; k < 5; ++k) pf[k] = *(const v4u*)(ubase + k * 4096 + prow * 64 + pseg);
#pragma unroll
    for (int k = 0; k < 5; ++k) *(LAS v4u*)(Wl + k * 4608 + prow * 72 + pseg) = pf[k];
    f32x4 sreg[2];
    sreg[0] = (f32x4){0.f, 0.f, 0.f, 0.f}; sreg[1] = sreg[0];
    SYNC();
    int cur = 0;
    for (int n = 0; n < NCHUNK; ++n) {
        const size_t row = (size_t)b * SEQ + (size_t)n * 64 + prow;
        const v4u dzv = *(const v4u*)(proj + row * DINP + C_DZ + h * 64 + pseg);
        const float dec = decp[n];
        if (n + 1 < NCHUNK) {
#pragma unroll
            for (int k = 0; k < 5; ++k) pf[k] = *(const v4u*)(ubase + (size_t)(n + 1) * 5 * 4096 + k * 4096 + prow * 64 + pseg); }
        LAS bf16* Sc = St0 + cur * 4608; LAS bf16* Sn = St0 + (cur ^ 1) * 4608;
        const f32x4 z = (f32x4){0.f, 0.f, 0.f, 0.f};
#pragma unroll
        for (int e = 0; e < 2; ++e) { const int tc = (X.wave & 1) * 2 + e;
            const f32x4 a = mm16<64>(Wl + 16 * tr * 72, 72, Sc + 16 * tc * 72, 72, z, lane);
            float uf[4]; unpack4(*(const LAS u32x2*)(Utl + (16 * tc + r) * 72 + 16 * tr + q * 4), uf);
            *(LAS u32x2*)(Vtl + (16 * tc + r) * 72 + 16 * tr + q * 4) = pack4(uf[0] - a[0], uf[1] - a[1], uf[2] - a[2], uf[3] - a[3]); }
        SYNC();
#pragma unroll
        for (int e = 0; e < 2; ++e) { const int tc = (X.wave & 1) * 2 + e;
            const f32x4 a = mm16<64>(KEl + 16 * tr * 72, 72, Vtl + 16 * tc * 72, 72, z, lane);
            sreg[e] = sreg[e] * dec + a;
            *(LAS u32x2*)(Sn + (16 * tc + r) * 72 + 16 * tr + q * 4) = pack4(sreg[e][0], sreg[e][1], sreg[e][2], sreg[e][3]);
            f32x4 o = mm16<64>(QDl + 16 * tr * 72, 72, Sc + 16 * tc * 72, 72, z, lane);
            o = mm16<64>(QKl + 16 * tr * 72, 72, Vtl + 16 * tc * 72, 72, o, lane);
#pragma unroll
            for (int i = 0; i < 4; ++i) Of[(16 * tr + q * 4 + i) * 68 + 16 * tc + r] = o[i]; }
        SYNC();
        { float o[8]; const f32x4 o0 = *(const LAS f32x4*)(Of + prow * 68 + pseg), o1 = *(const LAS f32x4*)(Of + prow * 68 + pseg + 4);
            o[0] = o0.x; o[1] = o0.y; o[2] = o0.z; o[3] = o0.w; o[4] = o1.x; o[5] = o1.y; o[6] = o1.z; o[7] = o1.w;
            float ss = 0.f;
#pragma unroll
            for (int i = 0; i < 8; ++i) ss += o[i] * o[i];
            ss += __shfl_xor(ss, 1); ss += __shfl_xor(ss, 2); ss += __shfl_xor(ss, 4);
            const float rstd = 1.0f / sqrtf(ss * (1.0f / 64.0f) + EPS);
            float zf[8]; unpack8(dzv, zf);
#pragma unroll
            for (int i = 0; i < 8; ++i) o[i] = o[i] * rstd * nwv[i] * silu(zf[i]);
            *(v4u*)(merged + row * D + 640 + h * 64 + pseg) = pack8(o); }
        if (n + 1 < NCHUNK) {
#pragma unroll
            for (int k = 0; k < 5; ++k) *(LAS v4u*)(Wl + k * 4608 + prow * 72 + pseg) = pf[k]; }
        SYNC();
        cur ^= 1;
    }
}

DI void gla_chain(const Ctx& X, int bh, const bf16* proj, const float* w2, const float* b2, const float* normw, bf16* merged) {
    LAS float* W2s = (LAS float*)(X.lds + 0); LAS float* b2s = (LAS float*)(X.lds + 2048);
    LAS float* la = (LAS float*)(X.lds + 2304);
    LAS float* tot = (LAS float*)(X.lds + 10752);
    LAS bf16* QDl = (LAS bf16*)(X.lds + 12800); LAS bf16* KDl = (LAS bf16*)(X.lds + 17920);
    LAS bf16* KEl = (LAS bf16*)(X.lds + 23040);
    LAS bf16* Vtl = (LAS bf16*)(X.lds + 27648); LAS bf16* Pl = (LAS bf16*)(X.lds + 36864);
    LAS bf16* St0 = (LAS bf16*)(X.lds + 46080);
    LAS float* Of = (LAS float*)(X.lds + 56320);
    const int tid = X.tid, lane = X.lane, b = bh / 6, h = bh % 6;
    const int t = tid >> 3, part = tid & 7;
    const int r = lane & 15, q = lane >> 4;
    for (int i = tid; i < 16 * 32; i += NTHR) W2s[i] = w2[(i >> 5) * 192 + h * 32 + (i & 31)];
    if (tid < 32) b2s[tid] = b2[h * 32 + tid];
    for (int i = tid; i < 2 * 64 * 40 / 2; i += NTHR) ((LAS unsigned*)St0)[i] = 0u;
    float nwv[8];
#pragma unroll
    for (int i = 0; i < 8; ++i) nwv[i] = normw[part * 8 + i];
    f32x4 sreg = (f32x4){0.f, 0.f, 0.f, 0.f};
    SYNC();
    int cur = 0;
    for (int n = 0; n < NCHUNK; ++n) {
        const size_t row = (size_t)b * SEQ + (size_t)n * 64 + t; const bf16* pr = proj + row * DINP;
        const u32x2 q4 = *(const u32x2*)(pr + C_GQ + h * 32 + part * 4), k4 = *(const u32x2*)(pr + C_GK + h * 32 + part * 4);
        const v4u v8 = *(const v4u*)(pr + C_GV + h * 64 + part * 8), z8 = *(const v4u*)(pr + C_GZ + h * 64 + part * 8);
        const v4u g0 = *(const v4u*)(pr + C_GLR), g1 = *(const v4u*)(pr + C_GLR + 8);
        LAS bf16* Sc = St0 + cur * 2560; LAS bf16* Sn = St0 + (cur ^ 1) * 2560;
        { float gl[16]; { float t0[8], t1[8]; unpack8(g0, t0); unpack8(g1, t1);
#pragma unroll
                for (int i = 0; i < 8; ++i) { gl[i] = t0[i]; gl[8 + i] = t1[i]; } }
#pragma unroll
            for (int cc = 0; cc < 4; ++cc) { const int c = part * 4 + cc; float zz = b2s[c];
#pragma unroll
                for (int rr = 0; rr < 16; ++rr) zz += gl[rr] * W2s[rr * 32 + c];
                la[t * 33 + c] = -softplus(-zz) * (1.0f / 16.0f); } }
        SYNC();
        const int cc2 = tid & 31, seg = tid >> 5;
        float l0 = la[(seg * 4 + 0) * 33 + cc2], l1 = l0 + la[(seg * 4 + 1) * 33 + cc2], l2 = l1 + la[(seg * 4 + 2) * 33 + cc2], l3 = l2 + la[(seg * 4 + 3) * 33 + cc2];
        tot[seg * 32 + cc2] = l3;
        SYNC();
        { float off = 0.f;
#pragma unroll
            for (int s = 0; s < 15; ++s) off += (s < seg) ? tot[s * 32 + cc2] : 0.f;
            la[(seg * 4 + 0) * 33 + cc2] = off + l0; la[(seg * 4 + 1) * 33 + cc2] = off + l1; la[(seg * 4 + 2) * 33 + cc2] = off + l2; la[(seg * 4 + 3) * 33 + cc2] = off + l3; }
        SYNC();
        { float qf[4], kf[4]; unpack4(q4, qf); unpack4(k4, kf); float qd[4], kd[4];
#pragma unroll
            for (int cc = 0; cc < 4; ++cc) { const int c = part * 4 + cc; const float bc = la[t * 33 + c], bl = la[63 * 33 + c];
                qd[cc] = qf[cc] * 0.17677669529663687f * __expf(bc); kd[cc] = kf[cc] * __expf(-bc);
                KEl[c * 72 + t] = (bf16)f2bf(kf[cc] * __expf(bl - bc)); }
            *(LAS u32x2*)(QDl + t * 40 + part * 4) = pack4(qd[0], qd[1], qd[2], qd[3]);
            *(LAS u32x2*)(KDl + t * 40 + part * 4) = pack4(kd[0], kd[1], kd[2], kd[3]);
            const unsigned vw[4] = {v8.x, v8.y, v8.z, v8.w};
#pragma unroll
            for (int i = 0; i < 4; ++i) { Vtl[(part * 8 + 2 * i) * 72 + t] = (bf16)(vw[i] & 0xffffu); Vtl[(part * 8 + 2 * i + 1) * 72 + t] = (bf16)(vw[i] >> 16); } }
        SYNC();
        { const f32x4 z = (f32x4){0.f, 0.f, 0.f, 0.f}; const int trs = X.wave >> 1;
#pragma unroll
            for (int e = 0; e < 2; ++e) { const int tct = (X.wave & 1) * 2 + e;
                const f32x4 a = mm16<32>(KDl + 16 * trs * 40, 40, QDl + 16 * tct * 40, 40, z, lane);
                const int tq = 16 * tct + r, s0 = 16 * trs + q * 4;
                *(LAS u32x2*)(Pl + tq * 72 + s0) = pack4(s0 <= tq ? a[0] : 0.f, s0 + 1 <= tq ? a[1] : 0.f, s0 + 2 <= tq ? a[2] : 0.f, s0 + 3 <= tq ? a[3] : 0.f); }
            const int trS = X.wave >> 2, tcS = X.wave & 3;
            const f32x4 a = mm16<64>(KEl + 16 * trS * 72, 72, Vtl + 16 * tcS * 72, 72, z, lane);
#pragma unroll
            for (int i = 0; i < 4; ++i) sreg[i] = __expf(la[63 * 33 + 16 * trS + q * 4 + i]) * sreg[i] + a[i];
            *(LAS u32x2*)(Sn + (16 * tcS + r) * 40 + 16 * trS + q * 4) = pack4(sreg[0], sreg[1], sreg[2], sreg[3]); }
        SYNC();
        { const f32x4 z = (f32x4){0.f, 0.f, 0.f, 0.f}; const int tr = X.wave >> 1;
#pragma unroll
            for (int e = 0; e < 2; ++e) { const int tc = (X.wave & 1) * 2 + e;
                f32x4 o = mm16<64>(Pl + 16 * tr * 72, 72, Vtl + 16 * tc * 72, 72, z, lane);
                o = mm16<32>(QDl + 16 * tr * 40, 40, Sc + 16 * tc * 40, 40, o, lane);
#pragma unroll
                for (int i = 0; i < 4; ++i) Of[(16 * tr + q * 4 + i) * 68 + 16 * tc + r] = o[i]; } }
        SYNC();
        { float o[8]; const f32x4 o0 = *(const LAS f32x4*)(Of + t * 68 + part * 8), o1 = *(const LAS f32x4*)(Of + t * 68 + part * 8 + 4);
            o[0] = o0.x; o[1] = o0.y; o[2] = o0.z; o[3] = o0.w; o[4] = o1.x; o[5] = o1.y; o[6] = o1.z; o[7] = o1.w;
            float ss = 0.f;
#pragma unroll
            for (int i = 0; i < 8; ++i) ss += o[i] * o[i];
            ss += __shfl_xor(ss, 1); ss += __shfl_xor(ss, 2); ss += __shfl_xor(ss, 4);
            const float rstd = 1.0f / sqrtf(ss * (1.0f / 64.0f) + EPS);
            float zf[8]; unpack8(z8, zf);
#pragma unroll
            for (int i = 0; i < 8; ++i) o[i] = o[i] * rstd * nwv[i] * silu(zf[i]);
            *(v4u*)(merged + row * D + h * 64 + part * 8) = pack8(o); }
        cur ^= 1;
    }
    SYNC();
}

DI void lru_chain(const Ctx& X, int unit, const bf16* proj, const float* convw, const float* convb, const float* wa, const float* ba, const float* wx, const float* bx, const float* lam, bf16* merged) {
    LAS bf16* WAt = (LAS bf16*)(X.lds + 0); LAS bf16* WXt = (LAS bf16*)(X.lds + 9216); LAS bf16* xrb = (LAS bf16*)(X.lds + 18432);
    LAS float* xrf = (LAS float*)(X.lds + 27648); LAS float* af = (LAS float*)(X.lds + 44288); LAS float* uf = (LAS float*)(X.lds + 60928);
    LAS float* cws = (LAS float*)(X.lds + 77568);
    const int tid = X.tid, lane = X.lane, b = unit >> 2, nb = unit & 3;
    const int t = tid >> 3, part = tid & 7, r = lane & 15, q = lane >> 4, tr = X.wave >> 1;
    for (int i = tid; i < 4096; i += NTHR) { const int j = i >> 6, k = i & 63; WAt[k * 72 + j] = (bf16)f2bf(wa[(size_t)nb * 4096 + i]); WXt[k * 72 + j] = (bf16)f2bf(wx[(size_t)nb * 4096 + i]); }
    if (tid < 320) cws[tid] = tid < 256 ? convw[(tid >> 6) * 256 + nb * 64 + (tid & 63)] : convb[nb * 64 + (tid & 63)];
    float bav[2], bxv[2], spv[2];
#pragma unroll
    for (int e = 0; e < 2; ++e) { const int ch = nb * 64 + 16 * ((X.wave & 1) * 2 + e) + r; bav[e] = ba[ch]; bxv[e] = bx[ch]; spv[e] = softplus(-lam[ch]); }
    float hreg = 0.f;
    SYNC();
    for (int n = 0; n < NCHUNK; ++n) {
        const size_t row = (size_t)b * SEQ + (size_t)n * 64 + t;
        const v4u lg8 = *(const v4u*)(proj + row * DINP + C_LG + nb * 64 + part * 8);
        { float y[8];
#pragma unroll
            for (int i = 0; i < 8; ++i) y[i] = cws[256 + part * 8 + i];
#pragma unroll
            for (int j = 0; j < 4; ++j) { const int tt = n * 64 + t - 3 + j;
                if (tt >= 0) { float xf[8]; unpack8(*(const v4u*)(proj + ((size_t)b * SEQ + tt) * DINP + C_LX + nb * 64 + part * 8), xf);
#pragma unroll
                    for (int i = 0; i < 8; ++i) y[i] += cws[j * 64 + part * 8 + i] * xf[i]; } }
#pragma unroll
            for (int i = 0; i < 8; ++i) xrf[t * 65 + part * 8 + i] = y[i];
            *(LAS v4u*)(xrb + t * 72 + part * 8) = pack8(y); }
        SYNC();
        { const f32x4 z = (f32x4){0.f, 0.f, 0.f, 0.f};
#pragma unroll
            for (int e = 0; e < 2; ++e) { const int tc = (X.wave & 1) * 2 + e, ch = 16 * tc + r;
                const f32x4 ar = mm16<64>(xrb + 16 * tr * 72, 72, WAt + 16 * tc * 72, 72, z, lane);
                const f32x4 ai = mm16<64>(xrb + 16 * tr * 72, 72, WXt + 16 * tc * 72, 72, z, lane);
#pragma unroll
                for (int i = 0; i < 4; ++i) { const int tt = 16 * tr + q * 4 + i;
                    const float rr = sigm(ar[i] + bav[e]), ig = sigm(ai[i] + bxv[e]), lga = -8.0f * rr * spv[e];
                    af[tt * 65 + ch] = __expf(lga); uf[tt * 65 + ch] = sqrtf(-expm1f(2.0f * lga)) * ig * xrf[tt * 65 + ch]; } } }
        SYNC();
        if (X.wave == 0) {
#pragma unroll 8
            for (int tt = 0; tt < 64; ++tt) { hreg = af[tt * 65 + lane] * hreg + uf[tt * 65 + lane]; uf[tt * 65 + lane] = hreg; } }
        SYNC();
        { float gf[8], o[8]; unpack8(lg8, gf);
#pragma unroll
            for (int i = 0; i < 8; ++i) o[i] = uf[t * 65 + part * 8 + i] * gelu_tanh(gf[i]);
            *(v4u*)(merged + row * D + 384 + nb * 64 + part * 8) = pack8(o); }
    }
    SYNC();
}

constexpr int N_PHASES = 21;
struct Args { In in; float* out; unsigned char* ws; int ph_lo, ph_hi; };
__global__ void __launch_bounds__(NTHR, 2) hybrid_fwd(Args args) {
    extern __shared__ __attribute__((aligned(16))) unsigned char lds_raw[];
    Ctx X;
#define MKCTX() do { int t_ = threadIdx.x; asm volatile("" : "+v"(t_)); X.lds = (LAS unsigned char*)lds_raw; X.tid = t_; X.lane = t_ & 63; X.wave = __builtin_amdgcn_readfirstlane(t_ >> 6); \
        X.G = gridDim.x; { const int bx = blockIdx.x; X.vcu = (X.G % 8 == 0) ? (bx % 8) * (X.G / 8) + bx / 8 : bx; } X.gw = X.vcu * NWAVES + X.wave; X.NGW = X.G * NWAVES; } while (0)
    MKCTX();
    unsigned char* ws = args.ws;
    InT I; I.p.t = (const LAS unsigned long long*)(X.lds + PTR_OFF);
    gu32* ctl = (gu32*)(ws + WS_CTL);
    volatile LAS unsigned* MISC = (volatile LAS unsigned*)(X.lds + MISC_OFF);
    for (int u = X.tid; u < (LDS_BYTES - RING_BYTES) / 4; u += NTHR) ((LAS unsigned*)(X.lds + RING_BYTES))[u] = 0u;
#pragma unroll
    for (int k = 0; k < 30; ++k) if (X.tid == k) ((LAS unsigned long long*)(X.lds + PTR_OFF))[k] = (unsigned long long)args.in.p[k];
    __syncthreads();
#if MK_ONE_LAUNCH
    XcdBarrier bar = xcd_barrier_post((unsigned*)(ctl + CW_BAR), MISC + 8);
#define GRID_BAR() xcd_barrier(bar)
#else
#define GRID_BAR() do {} while (0)
#endif
    const int lo = args.ph_lo, hi = args.ph_hi;
#define IN(k) (lo <= (k) && (k) < hi)
#define SEAM(k) do { if (IN(k) && IN((k) + 1)) GRID_BAR(); } while (0)
    const float* x_in = I.p[0]; float* xres = args.out;
    float* MOD = (float*)(ws + WS_MOD);
    bf16* Hb = (bf16*)(ws + WS_H); bf16* PROJ = (bf16*)(ws + WS_PROJ);
    LAS unsigned char* ring = X.lds;

    if (IN(0)) { MKCTX(); prologue_phase(X, I, ws); } SEAM(0);
    if (IN(1)) { MKCTX(); norm_phase<false>(X, x_in, I.p[18], MOD, 0, D, Hb, nullptr, ws); } SEAM(1);

    for (int L = 0; L < 2; ++L) {
        const int pb = 2 + 8 * L;
        const float* modL = MOD + (size_t)L * 8 * MODW;
        if (IN(pb)) { MKCTX();
            pg8::Gemm g{Hb, (const bf16*)(ws + WS_WIN) + (size_t)L * DINP * D, T, DINP, D}; pg8::StaticOrder S; S.init(T, DINP, X.G, (int)blockIdx.x);
            pg8::EpiStoreBf16 E{PROJ, DINP};
            pg8::gemm_phase<pg8::EpiStoreBf16, pg8::StaticOrder, true>(ring, g, S, E);
        } SEAM(pb);
        if (IN(pb + 1)) { MKCTX(); dn_prep_phase(X, PROJ, I.p[13] + (size_t)L * 4 * 1152, I.p[14] + L * 6, I.p[15] + L * 6, ws); } SEAM(pb + 1);
        if (IN(pb + 2)) { MKCTX();
            for (int ru = (int)blockIdx.x; ru < 128; ru += X.G) {
                if (ru < 48) dn_chain(X, ru, PROJ, I.p[16] + L * 64, ws, Hb);
                else if (ru < 80) lru_chain(X, ru - 48, PROJ, I.p[6] + (size_t)L * 4 * 256, I.p[7] + L * 256, I.p[8] + (size_t)L * 4 * 4096, I.p[9] + L * 256, I.p[10] + (size_t)L * 4 * 4096, I.p[11] + L * 256, I.p[12] + L * 256, Hb);
                else gla_chain(X, ru - 80, PROJ, I.p[3] + (size_t)L * 16 * 192, I.p[4] + L * 192, I.p[5] + L * 64, Hb);
            }
        } SEAM(pb + 2);
        if (IN(pb + 3)) { MKCTX();
            pg8::Gemm g{Hb, (const bf16*)(ws + WS_WOUT) + (size_t)L * D * D, T, D, D}; pg8::StaticOrder S; S.init(T, D, X.G, (int)blockIdx.x);
            pg8::EpiRes E{L == 0 ? x_in : (const float*)xres, xres, modL + 2 * D, D};
            pg8::gemm_phase<pg8::EpiRes, pg8::StaticOrder, true>(ring, g, S, E);
        } SEAM(pb + 3);
        if (L == 0) {
            if (IN(6)) { MKCTX(); norm_phase<false>(X, xres, I.p[19], modL, 3 * D, 4 * D, Hb, nullptr, ws); } SEAM(6);
            if (IN(7)) { MKCTX();
                pg8::Gemm g{Hb, (const bf16*)(ws + WS_WGU), T, 2 * DFF, D}; pg8::StaticOrder S; S.init(T, 2 * DFF, X.G, (int)blockIdx.x);
                pg8::EpiSwiglu E{PROJ, DFF};
                pg8::gemm_phase<pg8::EpiSwiglu, pg8::StaticOrder, true>(ring, g, S, E);
            } SEAM(7);
            if (IN(8)) { MKCTX();
                pg8::Gemm g{PROJ, (const bf16*)(ws + WS_WDN), T, D, DFF}; pg8::StaticOrder S; S.init(T, D, X.G, (int)blockIdx.x);
                pg8::EpiRes E{xres, xres, modL + 5 * D, D};
                pg8::gemm_phase<pg8::EpiRes, pg8::StaticOrder, true>(ring, g, S, E);
            } SEAM(8);
            if (IN(9)) { MKCTX(); norm_phase<false>(X, xres, I.p[18] + D, MOD + (size_t)8 * MODW, 0, D, Hb, nullptr, ws); } SEAM(9);
        }
    }
    if (IN(14)) { MKCTX(); norm_phase<true>(X, xres, I.p[19] + D, MOD + (size_t)8 * MODW, 3 * D, 4 * D, Hb, I.p[25], ws); moe_convert(X, I, ws); } SEAM(14);
    if (IN(15)) { MKCTX(); moe_list_phase(X, ws); } SEAM(15);
    for (int s = 0; s < 2; ++s) {
        LAS int* tab = (LAS int*)(X.lds + TAB_OFF);
        if (IN(16 + 2 * s) || IN(17 + 2 * s)) { __syncthreads(); if (X.tid < TILE_TAB) tab[X.tid] = ((const int*)(ws + WS_TILES))[s * TILE_TAB + X.tid]; __syncthreads(); }
        const int nM = __builtin_amdgcn_readfirstlane(tab[TILE_TAB - 1]);
        const int* list = (const int*)(ws + WS_LIST) + (size_t)s * MOE_ROWS; const float* roww = (const float*)(ws + WS_ROWW) + (size_t)s * MOE_ROWS;
        if (IN(16 + 2 * s)) { MKCTX();
            pg8::Gemm g{Hb, (const bf16*)(ws + WS_MOEGU), MOE_ROWS, 2 * DFFE, D}; pg8::MoeOrder<true> S; S.init(nM, 2 * DFFE, X.G, (int)blockIdx.x);
            S.tile_e = tab; S.list = list; S.eB = (size_t)2 * DFFE * D * 2;
            pg8::EpiSwiglu E{PROJ, DFFE};
            pg8::gemm_phase<pg8::EpiSwiglu, pg8::MoeOrder<true>, true>(ring, g, S, E);
        } SEAM(16 + 2 * s);
        if (IN(17 + 2 * s)) { MKCTX();
            pg8::Gemm g{PROJ, (const bf16*)(ws + WS_MOEDN), MOE_ROWS, D, DFFE}; pg8::MoeOrder<false> S; S.init(nM, D, X.G, (int)blockIdx.x);
            S.tile_e = tab; S.list = list; S.eB = (size_t)D * DFFE * 2;
            pg8::EpiMoeDown E{xres, MOD + (size_t)8 * MODW + 5 * D, list, roww};
            pg8::gemm_phase<pg8::EpiMoeDown, pg8::MoeOrder<false>, true>(ring, g, S, E);
        } SEAM(17 + 2 * s);
    }
    if (IN(20)) { MKCTX(); final_norm_phase(X, xres, I.p[29], xres); }
#undef IN
#undef SEAM
}

extern "C" void kernel_launch(void* const* d_in, const int* in_sizes, int n_in, void* d_out, int out_size, void* d_ws, size_t ws_size, hipStream_t stream) {
    static int grid = 0;
    if (grid == 0) {
        if (n_in != 30 || in_sizes[0] != T * D || out_size != T * D || ws_size < WS_END) { fprintf(stderr, "kernel_launch: unexpected shapes (n_in %d, in0 %d, out %d, ws %zu); nothing launched\n", n_in, n_in > 0 ? in_sizes[0] : -1, out_size, ws_size); grid = -1; return; }
        int dev = 0, cus = 0;
        if (hipGetDevice(&dev) != hipSuccess || hipDeviceGetAttribute(&cus, hipDeviceAttributeMultiprocessorCount, dev) != hipSuccess) { fprintf(stderr, "kernel_launch: device query failed\n"); grid = -1; return; }
        if (hipFuncSetAttribute((const void*)hybrid_fwd, hipFuncAttributeMaxDynamicSharedMemorySize, LDS_BYTES) != hipSuccess) { fprintf(stderr, "kernel_launch: hipFuncSetAttribute failed\n"); grid = -1; return; }
        int per_cu = 0;
        if (hipOccupancyMaxActiveBlocksPerMultiprocessor(&per_cu, (const void*)hybrid_fwd, NTHR, LDS_BYTES) != hipSuccess || per_cu < 1) fprintf(stderr, "kernel_launch: note: occupancy query reports %d workgroups per CU\n", per_cu);
        (void)hipGetLastError();
        grid = cus;
    }
    if (grid < 0) return;
    if (hipMemsetAsync((char*)d_ws + WS_CTL, 0, CTL_ZERO_BYTES, stream) != hipSuccess) { fprintf(stderr, "kernel_launch: memset failed\n"); return; }
    Args a{};
    for (int i = 0; i < 30; ++i) a.in.p[i] = (const float*)d_in[i];
    a.out = (float*)d_out; a.ws = (unsigned char*)d_ws;
#if MK_ONE_LAUNCH
    a.ph_lo = 0; a.ph_hi = N_PHASES;
    hipLaunchKernelGGL(hybrid_fwd, dim3(grid), dim3(NTHR), LDS_BYTES, stream, a);
#else
    for (int k = 0; k < N_PHASES; ++k) { a.ph_lo = k; a.ph_hi = k + 1; hipLaunchKernelGGL(hybrid_fwd, dim3(grid), dim3(NTHR), LDS_BYTES, stream, a); }
#endif
    const hipError_t le = hipPeekAtLastError();
    if (le != hipSuccess) fprintf(stderr, "kernel_launch: launch failed: %s\n", hipGetErrorName(le));
}
```

```cpp
#include <hip/hip_runtime.h>
#include <cstdio>
#include <cstdint>

#ifndef MK_ONE_LAUNCH
#define MK_ONE_LAUNCH 1
#endif

namespace pg8 {
#define PG8_LAS __attribute__((address_space(3)))
typedef unsigned short bf16_t;
typedef short bf16x8 __attribute__((ext_vector_type(8)));
typedef float f32x4 __attribute__((ext_vector_type(4)));
typedef unsigned u32x4 __attribute__((ext_vector_type(4)));
typedef int i32x4 __attribute__((ext_vector_type(4)));
constexpr int BM = 256, BK = 64, HALF = 128, HTB = HALF * BK * 2  , STAGE_BYTES = 8 * HTB, NXCD = 8, WGM = 8;

__host__ __device__ __forceinline__ int lds_byte(int r, int c) { const int st = (r >> 4) * 2 + (c >> 5), rr = r & 15, cc = c & 31, ob = rr * 64 + cc * 2; return st * 1024 + (ob ^ (((ob >> 9) & 1) << 5)); }
__host__ __device__ __forceinline__ void stage_rc(int b, int& R, int& C) { const int st = b / 1024, sb = b % 1024, swz = sb ^ (((sb >> 9) & 1) << 5); R = (st >> 1) * 16 + swz / 64; C = (st & 1) * 32 + (swz % 64) / 2; }
__host__ __device__ __forceinline__ int perm32(int rho) { const int n = rho >> 4, i = rho & 15; return 8 * (i >> 2) + 4 * n + (i & 3); }

struct Unit { int pm, pn, ks, sub; };
struct Gemm { const bf16_t* A; const bf16_t* Bt; int M, N, K; int ld = 0; int scA = 127, scB = 127; };

struct StaticOrder {
    static constexpr bool GATHER = false;
    int nM, nN, nwg, G, c;
    __host__ __device__ void init(int M, int N, int G_, int c_) { nM = M / BM; nN = N / BM; nwg = nM * nN; G = G_; c = c_; }
    __host__ __device__ bool next(int i, Unit& u) const {
        const long L = (long)i * G + c; if (L >= nwg) return false;
        int wgid = (int)L; { const int q = nwg / NXCD, r = nwg % NXCD, xcd = wgid % NXCD, off = wgid / NXCD; wgid = (xcd < r ? xcd * (q + 1) : r * (q + 1) + (xcd - r) * q) + off; }
        const int nig = WGM * nN, gid = wgid / nig, fm = gid * WGM, gsz = (nM - fm) < WGM ? (nM - fm) : WGM;
        u.pm = fm + ((wgid % nig) % gsz); u.pn = (wgid % nig) / gsz; u.ks = 0; u.sub = 0; return true;
    }
    __device__ __forceinline__ const char* b_base(const Gemm& g, const Unit& u, size_t tstep) const { return (const char*)g.Bt + (size_t)u.pn * tstep; }
    __device__ __forceinline__ int row_of(const Unit&, int r) const { return r; }
    __device__ __forceinline__ bool rowtab_ok() const { return false; }
    __device__ __forceinline__ const int* rows_ptr(const Unit&) const { return nullptr; }
    PG8_LAS int* rowtab;
};

typedef float cv_f32x2_t __attribute__((ext_vector_type(2)));
typedef __bf16 cv_bf16x2_t __attribute__((ext_vector_type(2)));
__device__ __forceinline__ unsigned cvt_pk_bf16(float lo, float hi) { const cv_f32x2_t v = {lo, hi}; const cv_bf16x2_t b = __builtin_convertvector(v, cv_bf16x2_t); return __builtin_bit_cast(unsigned, b); }

template <class Epi, class Sched, bool ALIGN_EPI>
__device__ __forceinline__ void gemm_phase(PG8_LAS unsigned char* lds, const Gemm g, const Sched& S, const Epi& E, const int wid_in) {
    constexpr bool GA = Sched::GATHER;
    int lane_; asm volatile("v_mbcnt_lo_u32_b32 %0, -1, 0\n\tv_mbcnt_hi_u32_b32 %0, -1, %0" : "=v"(lane_));
    int wid_ = wid_in; asm volatile("" : "+s"(wid_));
    const int wid = wid_, lane = lane_, tid = wid * 64 + lane, wr = wid >> 2, wc = wid & 3, fr = lane & 15, fq = lane >> 4;
    const int K = g.ld ? g.ld : g.K, nt = g.K / BK;
    unsigned voffA, voffB;
    { int R, C; stage_rc(tid * 16, R, C); const int Rb = Epi::PERM ? ((R & ~31) + perm32(R & 31)) : R; voffA = (unsigned)(R * K + C) * 2u; voffB = (unsigned)(Rb * K + C) * 2u; }
    const size_t rstep = (size_t)64 * K * 2;
    const int scA = g.scA, scB = g.scB;
    unsigned vAc[2][2];
#define PG8_GATHER_ROWS(U) do { _Pragma("unroll") for (int _h = 0; _h < 2; ++_h) _Pragma("unroll") for (int _i = 0; _i < 2; ++_i) { int _R, _C; stage_rc(tid * 16 + _i * 8192, _R, _C); \
        vAc[_h][_i] = (unsigned)(S.row_of(U, _h * HALF + _R) * K + _C) * 2u; } } while (0)
    const size_t kstep = (size_t)(BK * 2);
    const size_t hstep = (size_t)HALF * K * 2;
    const size_t tstep = 2 * hstep;
    const unsigned ldsw = (unsigned)wid * 1024u;
    const int aoff = lds_byte(wr * 64 + fr, fq * 8), boff = lds_byte(wc * 32 + fr, fq * 8);
#define PG8_SA(b, h) (((b) * 2 + (h)) * HTB)
#define PG8_SB(b, h) ((4 + (b) * 2 + (h)) * HTB)
#define PG8_STAGE(bufoff, gbase, voff) do { _Pragma("unroll") for (int _i = 0; _i < 2; ++_i) \
        __builtin_amdgcn_global_load_lds((const unsigned*)((const char*)(gbase) + _i * rstep + (voff)), (PG8_LAS unsigned*)(lds + (bufoff) + ldsw + _i * 8192), 16, 0, 0); } while (0)
#define PG8_STA(bufoff, kb, h, nx) do { if constexpr (GA) { _Pragma("unroll") for (int _i = 0; _i < 2; ++_i) \
        __builtin_amdgcn_global_load_lds((const unsigned*)((const char*)(kb) + vAc[h][_i]), (PG8_LAS unsigned*)(lds + (bufoff) + ldsw + _i * 8192), 16, 0, 0); } \
        else { PG8_STAGE(bufoff, (kb) + (h) * hstep, voffA); } } while (0)
#define PG8_LDA(dst, b, h) do { _Pragma("unroll") for (int m = 0; m < 4; ++m) _Pragma("unroll") for (int k = 0; k < 2; ++k) dst[m][k] = *(const PG8_LAS bf16x8*)(lds + PG8_SA(b, h) + aoff + m * 2048 + k * 1024); } while (0)
#define PG8_LDB(dst, b, h) do { _Pragma("unroll") for (int n = 0; n < 2; ++n) _Pragma("unroll") for (int k = 0; k < 2; ++k) dst[n][k] = *(const PG8_LAS bf16x8*)(lds + PG8_SB(b, h) + boff + n * 2048 + k * 1024); } while (0)
#define PG8_CAT8(lo, hi) __builtin_shufflevector(__builtin_bit_cast(i32x4, lo), __builtin_bit_cast(i32x4, hi), 0, 1, 2, 3, 4, 5, 6, 7)
#define PG8_MMA(ai, bj, At, Bt, Z) do { __builtin_amdgcn_s_setprio(1); _Pragma("unroll") for (int m = 0; m < 4; ++m) _Pragma("unroll") for (int n = 0; n < 2; ++n) { \
        if constexpr (Epi::F8) acc[ai][bj][m][n] = __builtin_amdgcn_mfma_scale_f32_16x16x128_f8f6f4(PG8_CAT8(Bt[n][0], Bt[n][1]), PG8_CAT8(At[m][0], At[m][1]), (Z) ? (f32x4){0.f, 0.f, 0.f, 0.f} : acc[ai][bj][m][n], 0, 0, 0, scB, 0, scA); \
        else { _Pragma("unroll") for (int k = 0; k < 2; ++k) acc[ai][bj][m][n] = __builtin_amdgcn_mfma_f32_16x16x32_bf16(Bt[n][k], At[m][k], ((Z) && k == 0) ? (f32x4){0.f, 0.f, 0.f, 0.f} : acc[ai][bj][m][n], 0, 0, 0); } } __builtin_amdgcn_s_setprio(0); } while (0)
#define PG8_WAIT_V(n) asm volatile("s_waitcnt vmcnt(" #n ")" ::: "memory")
#define PG8_WAIT_L(n) asm volatile("s_waitcnt lgkmcnt(" #n ")" ::: "memory")
#define PG8_BAR __builtin_amdgcn_s_barrier()
#define PG8_SCHED __builtin_amdgcn_sched_barrier(0)
#define PG8_KITER(T_, Z_) do { \
            const bool last = ((T_) == nt - 2); \
            const char* a1 = cA + (size_t)((T_) + 1) * kstep; \
            const char* a2 = last ? nA : cA + (size_t)((T_) + 2) * kstep; const char* b2 = last ? nB : cB + (size_t)((T_) + 2) * kstep; \
            const char* a3 = a2 + kstep; const char* b3 = b2 + kstep; \
            PG8_LDB(B0, 0, 0); PG8_LDB(B1, 0, 1); PG8_SCHED; PG8_LDA(At, 0, 0); PG8_STA(PG8_SA(1, 1), a1, 1, false); \
            if constexpr (GA) { if (last && has_next) { \
            if (S.rowtab_ok()) { \
            _Pragma("unroll") \
            for (int _h = 0; _h < 2; ++_h) \
            _Pragma("unroll") \
            for (int _i = 0; _i < 2; ++_i) { int _R, _C; stage_rc(tid * 16 + _i * 8192, _R, _C); const int tok_ = ((volatile PG8_LAS int*)S.rowtab)[_h * HALF + _R]; \
            vAc[_h][_i] = (unsigned)((tok_ < 0 ? 0 : tok_) * K + _C) * 2u; } \
            } else PG8_GATHER_ROWS(nxt); } } \
            PG8_WAIT_V(8); PG8_WAIT_L(0); PG8_BAR; PG8_MMA(0, 0, At, B0, Z_); PG8_MMA(0, 1, At, B1, Z_); PG8_BAR; PG8_SCHED; \
            PG8_LDA(At, 0, 1); PG8_STAGE(PG8_SB(0, 0), b2, voffB); PG8_STAGE(PG8_SB(0, 1), b2 + hstep, voffB); PG8_STA(PG8_SA(0, 0), a2, 0, last); \
            PG8_WAIT_V(8); PG8_WAIT_L(0); PG8_BAR; PG8_MMA(1, 0, At, B0, Z_); PG8_MMA(1, 1, At, B1, Z_); PG8_BAR; PG8_SCHED; \
            PG8_LDB(B0, 1, 0); PG8_LDB(B1, 1, 1); PG8_SCHED; PG8_LDA(At, 1, 0); PG8_STA(PG8_SA(0, 1), a2, 1, last); \
            PG8_WAIT_V(8); PG8_WAIT_L(0); PG8_BAR; PG8_MMA(0, 0, At, B0, false); PG8_MMA(0, 1, At, B1, false); PG8_BAR; PG8_SCHED; \
            PG8_LDA(At, 1, 1); PG8_STAGE(PG8_SB(1, 0), b3, voffB); PG8_STAGE(PG8_SB(1, 1), b3 + hstep, voffB); PG8_STA(PG8_SA(1, 0), a3, 0, last); \
            PG8_WAIT_V(8); PG8_WAIT_L(0); PG8_BAR; PG8_MMA(1, 0, At, B0, false); PG8_MMA(1, 1, At, B1, false); PG8_BAR; PG8_SCHED; \
        } while (0)
    Unit cur, nxt; int ui = 0;
    if (!S.next(0, cur)) return;
    constexpr bool PEEL = !Epi::F8;
    f32x4 acc[2][2][4][2];
#define PG8_ZERO_ACC() do { _Pragma("unroll") for (int a = 0; a < 2; ++a) _Pragma("unroll") for (int b = 0; b < 2; ++b) _Pragma("unroll") for (int m = 0; m < 4; ++m) _Pragma("unroll") for (int n = 0; n < 2; ++n) acc[a][b][m][n] = (f32x4){0.f, 0.f, 0.f, 0.f}; } while (0)
    if constexpr (!PEEL) PG8_ZERO_ACC();
    bf16x8 At[4][2], B0[2][2], B1[2][2];
    const char* cA = (GA ? (const char*)g.A : (const char*)g.A + (size_t)cur.pm * tstep) + (size_t)cur.ks * 2; const char* cB = S.b_base(g, cur, tstep) + (size_t)cur.ks * 2;
    if constexpr (GA) PG8_GATHER_ROWS(cur);
    PG8_STAGE(PG8_SB(0, 0), cB, voffB); PG8_STAGE(PG8_SB(0, 1), cB + hstep, voffB); PG8_STA(PG8_SA(0, 0), cA, 0, false); PG8_STA(PG8_SA(0, 1), cA, 1, false);
    if (wr == 1) PG8_BAR;
    PG8_WAIT_V(2); PG8_BAR;
    PG8_STAGE(PG8_SB(1, 0), cB + kstep, voffB); PG8_STA(PG8_SA(1, 0), cA + kstep, 0, false); PG8_STAGE(PG8_SB(1, 1), cB + hstep + kstep, voffB);
    PG8_WAIT_V(6); PG8_BAR;
    for (;;) {
        const bool has_next = S.next(ui + 1, nxt);
        if constexpr (GA) { if (has_next && S.rowtab_ok() && wid == 0)
            __builtin_amdgcn_global_load_lds((const unsigned*)(S.rows_ptr(nxt) + lane * 4), (PG8_LAS unsigned*)S.rowtab, 16, 0, 0); }
        const char* nA = has_next ? (GA ? (const char*)g.A : (const char*)g.A + (size_t)nxt.pm * tstep) + (size_t)nxt.ks * 2 : cA; const char* nB = has_next ? S.b_base(g, nxt, tstep) + (size_t)nxt.ks * 2 : cB;
        if constexpr (PEEL) { PG8_KITER(0, true); for (int t = 2; t < nt; t += 2) PG8_KITER(t, false); }
        else { for (int t = 0; t < nt; t += 2) PG8_KITER(t, false); }
        if constexpr (ALIGN_EPI) { if (wr == 0) PG8_BAR; }
        { int le_; asm volatile("v_mbcnt_lo_u32_b32 %0, -1, 0\n\tv_mbcnt_hi_u32_b32 %0, -1, %0" : "=v"(le_));
          E(acc, cur, wr, wc, le_ & 15, le_ >> 4); }
        if (!has_next) break;
        if constexpr (!PEEL) PG8_ZERO_ACC();
        cur = nxt; cA = nA; cB = nB; ++ui;
        if constexpr (ALIGN_EPI) { if (wr == 1) PG8_BAR; }
    }
    PG8_WAIT_V(0);
    if constexpr (!ALIGN_EPI) { if (wr == 0) PG8_BAR; }
    PG8_BAR;
#undef PG8_SA
#undef PG8_SB
#undef PG8_STAGE
#undef PG8_STA
#undef PG8_GATHER_ROWS
#undef PG8_LDA
#undef PG8_LDB
#undef PG8_MMA
#undef PG8_KITER
#undef PG8_ZERO_ACC
#undef PG8_CAT8
#undef PG8_WAIT_V
#undef PG8_WAIT_L
#undef PG8_BAR
#undef PG8_SCHED
}
}
#define GAS __attribute__((address_space(1)))
#define LAS __attribute__((address_space(3)))
typedef unsigned short bf16;
typedef unsigned v4u __attribute__((ext_vector_type(4)));
typedef float f32x4 __attribute__((ext_vector_type(4)));
typedef short bf16x8 __attribute__((ext_vector_type(8)));
typedef GAS unsigned gu32;
typedef GAS unsigned long long gu64;
#define RLX_AGENT __ATOMIC_RELAXED, __HIP_MEMORY_SCOPE_AGENT
#define LDS_WAIT() asm volatile("s_waitcnt lgkmcnt(0)" ::: "memory")
#define VM_WAIT() asm volatile("s_waitcnt vmcnt(0)" ::: "memory")
__device__ __forceinline__ unsigned long long rt() { return __builtin_amdgcn_s_memrealtime(); }
__device__ __forceinline__ unsigned f2bf(float f) { return (unsigned)__builtin_bit_cast(unsigned short, (__bf16)f); }
typedef float pk_f32x2_t __attribute__((ext_vector_type(2)));
typedef __bf16 pk_bf16x2_t __attribute__((ext_vector_type(2)));
__device__ __forceinline__ unsigned pk2(float lo, float hi) { const pk_f32x2_t v = {lo, hi}; const pk_bf16x2_t b = __builtin_convertvector(v, pk_bf16x2_t); return __builtin_bit_cast(unsigned, b); }
#define XB_TMO      128
#define XB_XCNT(j)  (256  + 64 * (j))
#define XB_XSUB(j)  (1280 + 64 * (j))
#define XB_XGEN(j)  (2304 + 64 * (j))
#define XB_TOP      3328
#define XB_TOPGEN   3392
#define XCD_BAR_WORDS 3456
#define XB_SPIN_CAP (1u << 18)

__device__ __forceinline__ unsigned xb_ld(unsigned* p)              { return __hip_atomic_load(p, __ATOMIC_RELAXED, __HIP_MEMORY_SCOPE_AGENT); }
__device__ __forceinline__ unsigned xb_add(unsigned* p, unsigned v) { return __hip_atomic_fetch_add(p, v, __ATOMIC_RELAXED, __HIP_MEMORY_SCOPE_AGENT); }
__device__ __forceinline__ unsigned xb_xcc_id() { return (unsigned)__builtin_amdgcn_s_getreg((3 << 11) | 20) & 0xFu; }
#define XB_SPIN(cond, bar) do { unsigned _sp = 0; while (cond) { __builtin_amdgcn_s_sleep(1); \
    if ((++_sp & 255u) == 0u) { if (xb_ld(&(bar)[XB_TMO])) break; if (_sp > XB_SPIN_CAP) { atomicAdd(&(bar)[XB_TMO], 1u); break; } } } } while (0)

struct XcdBarrier {
    unsigned* bar; unsigned x;
    volatile LAS unsigned* st;
};

__device__ __forceinline__ XcdBarrier xcd_barrier_post(unsigned* bar, volatile LAS unsigned* st) {
    XcdBarrier b; b.bar = bar; b.x = xb_xcc_id(); b.st = st;
    if (threadIdx.x == 0) (void)xb_add(&bar[XB_XCNT(b.x)], 1u);
    return b;
}
__device__ __forceinline__ void xcd_barrier_complete(unsigned* bar, unsigned x, unsigned& nloc, unsigned& nx) {
    const unsigned G = gridDim.x * gridDim.y * gridDim.z;
    unsigned sum, cnt, mine, sp = 0u;
    for (;;) {
        sum = 0u; cnt = 0u; mine = 0u;
#pragma unroll
        for (unsigned j = 0; j < 16; ++j) { const unsigned c = xb_ld(&bar[XB_XCNT(j)]); sum += c; cnt += (c > 0u) ? 1u : 0u; mine = (j == x) ? c : mine; }
        if (sum == G) break;
        __builtin_amdgcn_s_sleep(1);
        if ((++sp & 255u) == 0u) { if (xb_ld(&bar[XB_TMO])) break; if (sp > XB_SPIN_CAP) { atomicAdd(&bar[XB_TMO], 1u); break; } }
    }
    nloc = mine > 0u ? mine : 1u; nx = cnt > 0u ? cnt : 1u;
}

__device__ __forceinline__ void xcd_barrier(const XcdBarrier& b) {
    asm volatile("s_waitcnt vmcnt(0)" ::: "memory");
    __syncthreads();
    if (threadIdx.x == 0) {
        unsigned* bar = b.bar;
        __builtin_amdgcn_s_waitcnt(0);
        unsigned nloc = b.st[0], nx = b.st[1];
        if (nloc == 0u) { xcd_barrier_complete(bar, b.x, nloc, nx); b.st[0] = nloc; b.st[1] = nx; }
        const unsigned old = xb_add(&bar[XB_XSUB(b.x)], 1u);
        const unsigned gen = old / nloc;
        if (old + 1u == (gen + 1u) * nloc) {
            __builtin_amdgcn_fence(__ATOMIC_RELEASE, "agent");
            asm volatile("s_waitcnt vmcnt(0)" ::: "memory");
            const unsigned og = xb_add(&bar[XB_TOP], 1u);
            const unsigned tg = og / nx;
            if (og + 1u == (tg + 1u) * nx) xb_add(&bar[XB_TOPGEN], 1u);
            else XB_SPIN(xb_ld(&bar[XB_TOPGEN]) == tg, bar);
            __builtin_amdgcn_fence(__ATOMIC_ACQUIRE, "agent");
            xb_add(&bar[XB_XGEN(b.x)], 1u);
            asm volatile("s_waitcnt vmcnt(0)" ::: "memory");
        } else {
            XB_SPIN(xb_ld(&bar[XB_XGEN(b.x)]) == gen, bar);
            __builtin_amdgcn_fence(__ATOMIC_ACQUIRE, "agent");
            asm volatile("s_waitcnt vmcnt(0)" ::: "memory");
        }
    }
    __syncthreads();
}

#ifndef INPROJ1_F8
#define INPROJ1_F8 0
#endif
#ifndef DENSE_GU_F8
#define DENSE_GU_F8 1
#endif
#ifndef DENSE_DN_F8
#define DENSE_DN_F8 0
#endif
#ifndef MOE_DOWN_F8
#define MOE_DOWN_F8 1
#endif
constexpr int D = 1024, NBATCH = 8, SEQ = 4096, T = NBATCH * SEQ, DIN = 3228, DINP = 3328, DFF = 2816, NEXP = 8, DFFE = 3584, NCHUNK = 64;
constexpr int C_GQ = 0, C_GK = 192, C_GV = 384, C_GZ = 768, C_GLR = 1152, C_LX = 1168, C_LG = 1424, C_DQ = 1680, C_DK = 2064, C_DV = 2448, C_DZ = 2832, C_DB = 3216, C_DA = 3222;
constexpr int MODW = 6 * D;
constexpr float EPS = 1e-6f;
constexpr int NWAVES = 8, NTHR = 512;
constexpr int MOE_ROWS = T + NEXP * 256;
constexpr int MOE_TILES = MOE_ROWS / 256;
constexpr int TILE_TAB = 320;

constexpr size_t MiB = 1u << 20;
constexpr size_t WS_CTL = 0, CTL_ZERO_BYTES = 1 * MiB;
constexpr size_t WS_MOD = 1 * MiB;
constexpr size_t WS_ROUTE_E = 2 * MiB;
constexpr size_t WS_ROUTE_W = 3 * MiB;
constexpr size_t WS_WCNT = 4 * MiB;
constexpr size_t WS_LIST = 5 * MiB;
constexpr size_t WS_ROWW = 6 * MiB;
constexpr size_t WS_TILES = 7 * MiB;
constexpr size_t WS_DNDEC = 7 * MiB + 65536;
constexpr size_t WS_WIN = 8 * MiB;
constexpr size_t WS_WOUT = 21 * MiB;
constexpr size_t WS_WGU = 25 * MiB;
constexpr size_t WS_WDN = 36 * MiB;
constexpr size_t WS_H = 42 * MiB;
constexpr size_t WS_PROJ = 106 * MiB;
constexpr size_t DN_BYTES = (size_t)3072 * 5 * 8192;
constexpr size_t WS_MOEGU = 344 * MiB;
constexpr size_t WS_MOEDN = 400 * MiB;
constexpr size_t WS_GLA = 464 * MiB;
constexpr size_t WS_GLADEC = 6 * MiB;
constexpr size_t WS_LRUC = 5 * MiB;
constexpr size_t WS_PART = 8 * MiB;
constexpr size_t WS_Y0 = 432 * MiB;
constexpr size_t WS_XRES = 512 * MiB;
constexpr size_t WS_END = 576 * MiB;
static_assert(WS_PROJ + (size_t)T * DINP * 2 <= WS_MOEGU && WS_PROJ + (size_t)2 * MOE_ROWS * DFFE <= WS_MOEGU && DN_BYTES <= (size_t)T * D * 4 && WS_MOEGU + (size_t)8 * 7168 * 1024 <= WS_MOEDN && WS_MOEDN + (size_t)8 * 1024 * 3584 * 2 <= WS_GLA, "d_ws map");
static_assert(MOE_DOWN_F8 && WS_MOEDN + (size_t)8 * 1024 * 3584 <= WS_Y0 && WS_Y0 + (size_t)T * D * 2 <= WS_XRES, "d_ws map");
static_assert(WS_H + (size_t)T * D * 2 <= WS_PROJ && WS_WDN + (size_t)1024 * 2816 * 2 <= WS_H, "d_ws map");
constexpr int CW_TMO = 0, CW_CODE = 1, CW_BAR = 4096, CW_MODCNT = 8192;

constexpr int RING_BYTES = 131072;
constexpr int MISC_OFF = RING_BYTES + 320;
constexpr int PTR_OFF = RING_BYTES + 512;
constexpr int TAB_OFF = RING_BYTES + 1024;
constexpr int ROWTAB_OFF = RING_BYTES + 3072;
constexpr int LDS_BYTES = 147456;

#define DI __device__ __forceinline__
typedef float f32x2 __attribute__((ext_vector_type(2)));
typedef unsigned u32x2 __attribute__((ext_vector_type(2)));

DI float bf2f(unsigned b) { return __uint_as_float(b << 16); }
DI void unpack8(const v4u w, float (&f)[8]) {
    f[0] = __uint_as_float(w.x << 16); f[1] = __uint_as_float(w.x & 0xffff0000u); f[2] = __uint_as_float(w.y << 16); f[3] = __uint_as_float(w.y & 0xffff0000u);
    f[4] = __uint_as_float(w.z << 16); f[5] = __uint_as_float(w.z & 0xffff0000u); f[6] = __uint_as_float(w.w << 16); f[7] = __uint_as_float(w.w & 0xffff0000u); }
DI void unpack4(const u32x2 w, float (&f)[4]) { f[0] = __uint_as_float(w.x << 16); f[1] = __uint_as_float(w.x & 0xffff0000u); f[2] = __uint_as_float(w.y << 16); f[3] = __uint_as_float(w.y & 0xffff0000u); }
DI v4u pack8(const float (&f)[8]) { v4u w; w.x = pk2(f[0], f[1]); w.y = pk2(f[2], f[3]); w.z = pk2(f[4], f[5]); w.w = pk2(f[6], f[7]); return w; }
DI u32x2 pack4(float a, float b, float c, float d) { u32x2 w; w.x = pk2(a, b); w.y = pk2(c, d); return w; }
DI float fexp(float x) { return __builtin_amdgcn_exp2f(x * 1.4426950408889634f); }
DI float frcp(float x) { return __builtin_amdgcn_rcpf(x); }
DI float frsq(float x) { return __builtin_amdgcn_rsqf(x); }
DI float sigm(float x) { return frcp(1.0f + fexp(-x)); }
DI float silu(float x) { return x * frcp(1.0f + fexp(-x)); }
DI float softplus(float x) { return fmaxf(x, 0.0f) + 0.6931471805599453f * __builtin_amdgcn_logf(1.0f + fexp(-fabsf(x))); }
DI float gelu_tanh(float x) { const float u = 1.5957691216057308f * (x + 0.044715f * x * x * x); return x * frcp(1.0f + fexp(-u)); }
DI int bperm_i(int srclane, int v) { return __builtin_amdgcn_ds_bpermute(srclane << 2, v); }
DI float bperm_f(int srclane, float v) { return __builtin_bit_cast(float, __builtin_amdgcn_ds_bpermute(srclane << 2, __builtin_bit_cast(int, v))); }
DI float wave_sum(float v, int lane) {
    (void)lane;
    v += __builtin_bit_cast(float, __builtin_amdgcn_update_dpp(0, __builtin_bit_cast(int, v), 0xB1, 0xF, 0xF, true));
    v += __builtin_bit_cast(float, __builtin_amdgcn_update_dpp(0, __builtin_bit_cast(int, v), 0x4E, 0xF, 0xF, true));
    v += __builtin_bit_cast(float, __builtin_amdgcn_update_dpp(0, __builtin_bit_cast(int, v), 0x141, 0xF, 0xF, true));
    v += __builtin_bit_cast(float, __builtin_amdgcn_update_dpp(0, __builtin_bit_cast(int, v), 0x140, 0xF, 0xF, true));
    const int vi = __builtin_bit_cast(int, v);
    const float r0 = __builtin_bit_cast(float, __builtin_amdgcn_readlane(vi, 0)), r1 = __builtin_bit_cast(float, __builtin_amdgcn_readlane(vi, 16));
    const float r2 = __builtin_bit_cast(float, __builtin_amdgcn_readlane(vi, 32)), r3 = __builtin_bit_cast(float, __builtin_amdgcn_readlane(vi, 48));
    return (r0 + r1) + (r2 + r3);
}
template <int K> DI f32x4 mm16(const LAS bf16* A, int lda, const LAS bf16* Bt, int ldb, f32x4 acc, int lane) {
    const int r = lane & 15, q = lane >> 4;
#pragma unroll
    for (int k0 = 0; k0 < K; k0 += 32) {
        const bf16x8 a = *(const LAS bf16x8*)(A + r * lda + k0 + q * 8);
        const bf16x8 b = *(const LAS bf16x8*)(Bt + r * ldb + k0 + q * 8);
        acc = __builtin_amdgcn_mfma_f32_16x16x32_bf16(a, b, acc, 0, 0, 0);
    }
    return acc;
}
DI float dpp_sum8(float x) {
    x += __builtin_bit_cast(float, __builtin_amdgcn_update_dpp(0, __builtin_bit_cast(int, x), 0xB1, 0xF, 0xF, true));
    x += __builtin_bit_cast(float, __builtin_amdgcn_update_dpp(0, __builtin_bit_cast(int, x), 0x4E, 0xF, 0xF, true));
    x += __builtin_bit_cast(float, __builtin_amdgcn_update_dpp(0, __builtin_bit_cast(int, x), 0x141, 0xF, 0xF, true));
    return x;
}
#define MFMA16(a, b, c) __builtin_amdgcn_mfma_f32_16x16x32_bf16((a), (b), (c), 0, 0, 0)
#define LDF(p) (*(const LAS bf16x8*)(p))
#define SYNC() asm volatile("s_waitcnt lgkmcnt(0)\n\ts_barrier" ::: "memory")

namespace pg8 {
struct EpiStoreBf16 {
    static constexpr bool PERM = true, F8 = false;
    bf16_t* O; int ldc;
    DI void operator()(const f32x4 (&acc)[2][2][4][2], const Unit& u, int wr, int wc, int fr, int fq) const {
        const int row0 = u.pm * BM + wr * 64 + fr, col0 = u.pn * BM + wc * 32 + 8 * fq;
#pragma unroll
        for (int ai = 0; ai < 2; ++ai)
#pragma unroll
            for (int m = 0; m < 4; ++m) { bf16_t* rowp = O + (size_t)(row0 + ai * HALF + m * 16) * ldc + col0;
#pragma unroll
                for (int bj = 0; bj < 2; ++bj) { const f32x4 v0 = acc[ai][bj][m][0], v1 = acc[ai][bj][m][1];
                    u32x4 w; w.x = cvt_pk_bf16(v0[0], v0[1]); w.y = cvt_pk_bf16(v0[2], v0[3]); w.z = cvt_pk_bf16(v1[0], v1[1]); w.w = cvt_pk_bf16(v1[2], v1[3]);
                    *(u32x4*)(rowp + bj * HALF) = w; } }
    }
};
template <bool B32_, bool F8_> struct EpiResT {
    static constexpr bool PERM = true, F8 = F8_;
    const float* base32; const bf16_t* base16; bf16_t* out; const float* gate;
    DI void operator()(const f32x4 (&acc)[2][2][4][2], const Unit& u, int wr, int wc, int fr, int fq) const {
        const int row0 = u.pm * BM + wr * 64 + fr, col0 = u.pn * BM + wc * 32 + 8 * fq;
        const float* gp = gate + (size_t)((u.pm * BM) / SEQ) * MODW + col0;
        f32x4 gv[2][2];
#pragma unroll
        for (int bj = 0; bj < 2; ++bj)
#pragma unroll
            for (int n = 0; n < 2; ++n) gv[bj][n] = *(const f32x4*)(gp + bj * HALF + n * 4);
#pragma unroll
        for (int ai = 0; ai < 2; ++ai) {
            f32x4 bs[4][2][2]; u32x4 br[4][2];
#pragma unroll
            for (int m = 0; m < 4; ++m) { const size_t off = (size_t)(row0 + ai * HALF + m * 16) * D + col0;
#pragma unroll
                for (int bj = 0; bj < 2; ++bj) {
                    if constexpr (B32_) { bs[m][bj][0] = *(const f32x4*)(base32 + off + bj * HALF); bs[m][bj][1] = *(const f32x4*)(base32 + off + bj * HALF + 4); }
                    else br[m][bj] = *(const u32x4*)(base16 + off + bj * HALF); } }
#pragma unroll
            for (int m = 0; m < 4; ++m) { const size_t off = (size_t)(row0 + ai * HALF + m * 16) * D + col0;
#pragma unroll
                for (int bj = 0; bj < 2; ++bj) {
                    if constexpr (!B32_) { const u32x4 w = br[m][bj];
                        bs[m][bj][0] = (f32x4){__uint_as_float(w.x << 16), __uint_as_float(w.x & 0xffff0000u), __uint_as_float(w.y << 16), __uint_as_float(w.y & 0xffff0000u)};
                        bs[m][bj][1] = (f32x4){__uint_as_float(w.z << 16), __uint_as_float(w.z & 0xffff0000u), __uint_as_float(w.w << 16), __uint_as_float(w.w & 0xffff0000u)}; }
                    const f32x4 v0 = bs[m][bj][0] + gv[bj][0] * acc[ai][bj][m][0], v1 = bs[m][bj][1] + gv[bj][1] * acc[ai][bj][m][1];
                    u32x4 w; w.x = cvt_pk_bf16(v0[0], v0[1]); w.y = cvt_pk_bf16(v0[2], v0[3]); w.z = cvt_pk_bf16(v1[0], v1[1]); w.w = cvt_pk_bf16(v1[2], v1[3]);
                    *(u32x4*)(out + off + bj * HALF) = w; } }
            asm volatile("" ::: "memory"); }
    }
};
typedef EpiResT<true, false> EpiRes32;
typedef EpiResT<false, false> EpiRes;
typedef EpiResT<false, true> EpiRes8;
struct EpiStoreBf16F8 : EpiStoreBf16 { static constexpr bool F8 = true; };
struct EpiSwiglu {
    static constexpr bool PERM = true, F8 = false;
    bf16_t* O; int ldc;
    DI void operator()(const f32x4 (&acc)[2][2][4][2], const Unit& u, int wr, int wc, int fr, int fq) const {
        const int row0 = u.pm * BM + wr * 64 + fr, col0 = u.pn * HALF + wc * 32 + 8 * fq;
#pragma unroll
        for (int ai = 0; ai < 2; ++ai)
#pragma unroll
            for (int m = 0; m < 4; ++m) { bf16_t* rowp = O + (size_t)(row0 + ai * HALF + m * 16) * ldc + col0;
                float v[8];
#pragma unroll
                for (int n = 0; n < 2; ++n)
#pragma unroll
                    for (int j = 0; j < 4; j += 2) {
                        const f32x2 g = {acc[ai][0][m][n][j], acc[ai][0][m][n][j + 1]}, up = {acc[ai][1][m][n][j], acc[ai][1][m][n][j + 1]};
                        const f32x2 t = g * -1.4426950408889634f;
                        const f32x2 e = {__builtin_amdgcn_exp2f(t.x), __builtin_amdgcn_exp2f(t.y)};
                        const f32x2 d = e + 1.0f;
                        const f32x2 rc = {__builtin_amdgcn_rcpf(d.x), __builtin_amdgcn_rcpf(d.y)};
                        const f32x2 o = (g * up) * rc;
                        v[n * 4 + j] = o.x; v[n * 4 + j + 1] = o.y; }
                u32x4 w; w.x = cvt_pk_bf16(v[0], v[1]); w.y = cvt_pk_bf16(v[2], v[3]); w.z = cvt_pk_bf16(v[4], v[5]); w.w = cvt_pk_bf16(v[6], v[7]);
                *(u32x4*)rowp = w; }
    }
};
struct EpiSwigluB : EpiSwiglu { static constexpr bool F8 = true; };
#if MOE_DOWN_F8
template <bool F8_> struct EpiSwiglu8T {
    static constexpr bool PERM = true, F8 = F8_;
    bf16_t* Ob; int ldc;
    DI void operator()(const f32x4 (&acc)[2][2][4][2], const Unit& u, int wr, int wc, int fr, int fq) const {
        unsigned char* O = (unsigned char*)Ob;
        const int row0 = u.pm * BM + wr * 64 + fr, col0 = u.pn * HALF + wc * 32 + 8 * fq;
#pragma unroll
        for (int ai = 0; ai < 2; ++ai)
#pragma unroll
            for (int m = 0; m < 4; ++m) { unsigned char* rowp = O + (size_t)(row0 + ai * HALF + m * 16) * ldc + col0;
                float v[8];
#pragma unroll
                for (int n = 0; n < 2; ++n)
#pragma unroll
                    for (int j = 0; j < 4; j += 2) {
                        const f32x2 g = {acc[ai][0][m][n][j], acc[ai][0][m][n][j + 1]}, up = {acc[ai][1][m][n][j], acc[ai][1][m][n][j + 1]};
                        const f32x2 t = g * -1.4426950408889634f;
                        const f32x2 e = {__builtin_amdgcn_exp2f(t.x), __builtin_amdgcn_exp2f(t.y)};
                        const f32x2 d = e * 0.125f + 0.125f;
                        const f32x2 rc = {__builtin_amdgcn_rcpf(d.x), __builtin_amdgcn_rcpf(d.y)};
                        const f32x2 o = (g * up) * rc;
                        v[n * 4 + j] = __builtin_amdgcn_fmed3f(o.x, -448.0f, 448.0f); v[n * 4 + j + 1] = __builtin_amdgcn_fmed3f(o.y, -448.0f, 448.0f); }
                int w0 = 0, w1 = 0;
                w0 = __builtin_amdgcn_cvt_pk_fp8_f32(v[0], v[1], w0, false); w0 = __builtin_amdgcn_cvt_pk_fp8_f32(v[2], v[3], w0, true);
                w1 = __builtin_amdgcn_cvt_pk_fp8_f32(v[4], v[5], w1, false); w1 = __builtin_amdgcn_cvt_pk_fp8_f32(v[6], v[7], w1, true);
                *(u32x2*)rowp = (u32x2){(unsigned)w0, (unsigned)w1}; }
    }
};
typedef EpiSwiglu8T<true> EpiSwiglu8;
typedef EpiSwiglu8T<false> EpiSwigluTo8;
#else
struct EpiSwiglu8 : EpiSwiglu { static constexpr bool F8 = true; };
#endif
struct EpiMoeDown {
    static constexpr bool PERM = true, F8 = (MOE_DOWN_F8 != 0);
    bf16_t* y0; bf16_t* y1; int split; const int* list; const float* roww;
    DI void operator()(const f32x4 (&acc)[2][2][4][2], const Unit& u, int wr, int wc, int fr, int fq) const {
        const int row0 = u.pm * BM + wr * 64 + fr, col0 = u.pn * BM + wc * 32 + 8 * fq;
        bf16_t* dst = (u.pm * BM >= split) ? y1 : y0;
        int tok[8]; float rw[8];
#pragma unroll
        for (int g = 0; g < 8; ++g) { const int r = row0 + (g >> 2) * HALF + (g & 3) * 16; tok[g] = list[r]; rw[g] = roww[r]; }
#pragma unroll
        for (int g = 0; g < 8; ++g) if (tok[g] >= 0) { bf16_t* op = dst + (size_t)tok[g] * D + col0; const int ai = g >> 2, m = g & 3;
#pragma unroll
            for (int bj = 0; bj < 2; ++bj) { const f32x4 v0 = acc[ai][bj][m][0] * rw[g], v1 = acc[ai][bj][m][1] * rw[g];
                u32x4 o; o.x = cvt_pk_bf16(v0[0], v0[1]); o.y = cvt_pk_bf16(v0[2], v0[3]); o.z = cvt_pk_bf16(v1[0], v1[1]); o.w = cvt_pk_bf16(v1[2], v1[3]);
                *(u32x4*)(op + bj * HALF) = o; } }
    }
};
template <bool GATHER_> struct MoeOrder {
    static constexpr bool GATHER = GATHER_;
    int nM, nN, nwg, G, c; const LAS int* tile_e; const int* list; size_t eB;
    int lo, hi, slices, kslice;
    DI void init(int nM_, int N, int G_, int c_) { nM = nM_; nN = N / BM; nwg = nM * nN; G = G_; c = c_; lo = 0; hi = nwg; slices = 1; kslice = 0; }
    DI void tile_of(int L, Unit& u) const {
        int wgid = L; { const int q = nwg / NXCD, r = nwg % NXCD, xcd = wgid % NXCD, off = wgid / NXCD; wgid = (xcd < r ? xcd * (q + 1) : r * (q + 1) + (xcd - r) * q) + off; }
        const int nig = WGM * nN, gid = wgid / nig, fm = gid * WGM, gsz = (nM - fm) < WGM ? (nM - fm) : WGM;
        u.pm = fm + ((wgid % nig) % gsz); u.pn = (wgid % nig) / gsz; }
    DI bool next(int i, Unit& u) const {
        const long S0 = (long)i * G + c; if (S0 >= (long)(hi - lo) * slices) return false;
        u.sub = (int)S0; u.ks = (int)(S0 % slices) * kslice; tile_of(lo + (int)(S0 / slices), u); return true;
    }
    DI const char* b_base(const Gemm& g, const Unit& u, size_t tstep) const { return (const char*)g.Bt + (size_t)__builtin_amdgcn_readfirstlane(tile_e[u.pm]) * eB + (size_t)u.pn * tstep; }
    LAS int* rowtab = nullptr;
    DI bool rowtab_ok() const { return list != nullptr && rowtab != nullptr; }
    DI const int* rows_ptr(const Unit& u) const { return list + u.pm * BM; }
    DI int row_of(const Unit& u, int r) const { if (list == nullptr) return u.pm * BM + r; const int tok = list[u.pm * BM + r]; return tok < 0 ? 0 : tok; }
};
struct EpiPartial {
    static constexpr bool PERM = false, F8 = (MOE_DOWN_F8 != 0);
    float* part;
    DI void operator()(const f32x4 (&acc)[2][2][4][2], const Unit& u, int wr, int wc, int fr, int fq) const {
        float* p = part + (size_t)u.sub * 65536 + (size_t)(((wr * 4 + wc) * 64) + fq * 16 + fr) * 128;
#pragma unroll
        for (int ai = 0; ai < 2; ++ai)
#pragma unroll
            for (int bj = 0; bj < 2; ++bj)
#pragma unroll
                for (int m = 0; m < 4; ++m)
#pragma unroll
                    for (int n = 0; n < 2; ++n) *(f32x4*)(p + (((ai * 2 + bj) * 4 + m) * 2 + n) * 4) = acc[ai][bj][m][n];
    }
};
}

struct Ctx { LAS unsigned char* lds; int tid, lane, wave, vcu, G, gw, NGW; };

struct XpItem { const float* src; bf16* dst; int K, N, k0, n0, drow0; float f8scale; };
DI void xp_load(const XpItem& I, f32x4 (&v)[8], int lane) {
    const int kr = lane >> 3, c4 = (lane & 7) * 4;
#pragma unroll
    for (int i = 0; i < 8; ++i) { const int kk = i * 8 + kr; v[i] = (f32x4){0.f, 0.f, 0.f, 0.f};
        if (I.n0 + c4 < I.N) v[i] = *(const f32x4*)(I.src + (size_t)(I.k0 + kk) * I.N + I.n0 + c4); }
}
DI void xp_finish(const XpItem& I, const f32x4 (&v)[8], LAS float* scr, int lane) {
    const int kr = lane >> 3, c4 = (lane & 7) * 4;
#pragma unroll
    for (int i = 0; i < 8; ++i) { const int kk = i * 8 + kr; scr[kk * 33 + c4 + 0] = v[i].x; scr[kk * 33 + c4 + 1] = v[i].y; scr[kk * 33 + c4 + 2] = v[i].z; scr[kk * 33 + c4 + 3] = v[i].w; }
    LDS_WAIT(); asm volatile("" ::: "memory");
    const int c = lane & 7;
    if (I.f8scale != 0.0f) { const float sc = I.f8scale; unsigned char* d8 = (unsigned char*)I.dst;
#pragma unroll
        for (int j = 0; j < 4; ++j) { const int n = (lane >> 3) + 8 * j; const LAS float* s = scr + (8 * c) * 33 + n;
            int w0 = 0, w1 = 0;
            w0 = __builtin_amdgcn_cvt_pk_fp8_f32(__builtin_amdgcn_fmed3f(s[0 * 33] * sc, -448.f, 448.f), __builtin_amdgcn_fmed3f(s[1 * 33] * sc, -448.f, 448.f), w0, false);
            w0 = __builtin_amdgcn_cvt_pk_fp8_f32(__builtin_amdgcn_fmed3f(s[2 * 33] * sc, -448.f, 448.f), __builtin_amdgcn_fmed3f(s[3 * 33] * sc, -448.f, 448.f), w0, true);
            w1 = __builtin_amdgcn_cvt_pk_fp8_f32(__builtin_amdgcn_fmed3f(s[4 * 33] * sc, -448.f, 448.f), __builtin_amdgcn_fmed3f(s[5 * 33] * sc, -448.f, 448.f), w1, false);
            w1 = __builtin_amdgcn_cvt_pk_fp8_f32(__builtin_amdgcn_fmed3f(s[6 * 33] * sc, -448.f, 448.f), __builtin_amdgcn_fmed3f(s[7 * 33] * sc, -448.f, 448.f), w1, true);
            *(u32x2*)(d8 + (size_t)(I.drow0 + n) * I.K + I.k0 + 8 * c) = (u32x2){(unsigned)w0, (unsigned)w1}; }
    } else {
#pragma unroll
    for (int j = 0; j < 4; ++j) { const int n = (lane >> 3) + 8 * j; const LAS float* s = scr + (8 * c) * 33 + n;
        v4u o; o.x = pk2(s[0 * 33], s[1 * 33]); o.y = pk2(s[2 * 33], s[3 * 33]); o.z = pk2(s[4 * 33], s[5 * 33]); o.w = pk2(s[6 * 33], s[7 * 33]);
        *(v4u*)(I.dst + (size_t)(I.drow0 + n) * I.K + I.k0 + 8 * c) = o; }
    }
    LDS_WAIT(); asm volatile("" ::: "memory");
}
DI bool xp_try(int& r, const float* W, int K, int N, int Npad, bf16* WT, int mode, XpItem& o, float f8scale = 0.0f) {
    const int nblk = Npad / 32, items = (K / 64) * nblk;
    if (r >= items) { r -= items; return false; }
    const int kb = r / nblk, n0 = (r % nblk) * 32;
    o.src = W; o.dst = WT; o.K = K; o.N = N; o.k0 = kb * 64; o.n0 = n0; o.f8scale = f8scale; o.drow0 = mode == 0 ? n0 : ((n0 >> 7) * 256 + (n0 & 127) + (mode == 2 ? 128 : 0));
    return true;
}
struct In { const float* p[30]; };
struct PtrTab { const LAS unsigned long long* t;
    DI const float* operator[](int k) const { const unsigned long long v = t[k]; const unsigned lo = __builtin_amdgcn_readfirstlane((unsigned)v), hi = __builtin_amdgcn_readfirstlane((unsigned)(v >> 32));
        return (const float*)(const GAS float*)(((unsigned long long)hi << 32) | lo); } };
struct InT { PtrTab p; };
DI void prologue_phase(const Ctx& X, const InT& I, unsigned char* ws) {
    LAS float* sct = (LAS float*)(X.lds + 98304);
    if (X.vcu < 2 * (MODW / 64)) {
        const float* cc = I.p[1];
        for (int i = X.tid; i < NBATCH * D; i += NTHR) { const int b = i / D, k = i % D; sct[k * 8 + b] = silu(cc[i]); }
        SYNC();
    }
    for (int it = X.vcu; it < 2 * (MODW / 64); it += X.G) {
        const int L = it / (MODW / 64), n = (it % (MODW / 64)) * 64 + X.lane;
        const float* aw = I.p[20] + (size_t)L * D * MODW + n;
        float acc[8];
#pragma unroll
        for (int b = 0; b < 8; ++b) acc[b] = 0.f;
        const int kb = X.wave * 128;
#pragma unroll 16
        for (int k = kb; k < kb + 128; ++k) { const float w = aw[(size_t)k * MODW]; const f32x4 s0 = *(const LAS f32x4*)(sct + k * 8), s1 = *(const LAS f32x4*)(sct + k * 8 + 4);
            acc[0] += s0.x * w; acc[1] += s0.y * w; acc[2] += s0.z * w; acc[3] += s0.w * w; acc[4] += s1.x * w; acc[5] += s1.y * w; acc[6] += s1.z * w; acc[7] += s1.w * w; }
        LAS float* red = (LAS float*)(X.lds + 81920);
#pragma unroll
        for (int b = 0; b < 8; ++b) red[(X.wave * 8 + b) * 64 + X.lane] = acc[b];
        SYNC();
        float s = I.p[21][(size_t)L * MODW + n];
#pragma unroll
        for (int w = 0; w < 8; ++w) s += red[(w * 8 + X.wave) * 64 + X.lane];
        ((float*)(ws + WS_MOD))[((size_t)L * 8 + X.wave) * MODW + n] = s;
        SYNC();
    }
    if (X.vcu < 2 * (MODW / 64)) {
        asm volatile("s_waitcnt vmcnt(0)" ::: "memory");
        __syncthreads();
        if (X.tid == 0) { __builtin_amdgcn_fence(__ATOMIC_RELEASE, "agent"); asm volatile("s_waitcnt vmcnt(0)" ::: "memory"); (void)xb_add((unsigned*)(ws + WS_CTL) + CW_MODCNT, 1u); }
    }
    LAS float* scr = (LAS float*)(X.lds + X.wave * 8704);
    constexpr int I_IN = 16 * (DINP / 32), I_OUT = 16 * 32, I_G = 16 * (DFF / 32), I_D = (DFF / 64) * 32;
    constexpr int NITEMS = 2 * I_IN + 2 * I_OUT + 2 * I_G + I_D;
    const float* w_in = I.p[2]; const float* w_out = I.p[17]; const float* wg = I.p[22]; const float* wu = I.p[23]; const float* wd = I.p[24];
#define PRO_DECODE(it_, o_) do { int r = (it_); \
        if (xp_try(r, w_in, D, DIN, DINP, (bf16*)(ws + WS_WIN), 0, o_)) break; \
        if (xp_try(r, w_in + (size_t)D * DIN, D, DIN, DINP, (bf16*)(ws + WS_WIN) + (size_t)DINP * D, 0, o_, INPROJ1_F8 ? 1024.0f : 0.0f)) break; \
        if (xp_try(r, w_out, D, D, D, (bf16*)(ws + WS_WOUT), 0, o_)) break; \
        if (xp_try(r, w_out + (size_t)D * D, D, D, D, (bf16*)(ws + WS_WOUT) + (size_t)D * D, 0, o_)) break; \
        if (xp_try(r, wg, D, DFF, DFF, (bf16*)(ws + WS_WGU), 1, o_, DENSE_GU_F8 ? 1024.0f : 0.0f)) break; \
        if (xp_try(r, wu, D, DFF, DFF, (bf16*)(ws + WS_WGU), 2, o_, DENSE_GU_F8 ? 1024.0f : 0.0f)) break; \
        xp_try(r, wd, DFF, D, D, (bf16*)(ws + WS_WDN), 0, o_, DENSE_DN_F8 ? 2048.0f : 0.0f); } while (0)
    if (X.gw < NITEMS) {
        XpItem cur, nx; f32x4 v[8], vn[8];
        PRO_DECODE(X.gw, cur); xp_load(cur, v, X.lane);
        for (int it = X.gw; it < NITEMS; it += X.NGW) {
            const bool more = it + X.NGW < NITEMS;
            if (more) { PRO_DECODE(it + X.NGW, nx); xp_load(nx, vn, X.lane); }
            xp_finish(cur, v, scr, X.lane);
            if (more) { cur = nx;
#pragma unroll
                for (int i = 0; i < 8; ++i) v[i] = vn[i]; }
        }
    }
#undef PRO_DECODE
}
DI void mod_wait(const Ctx& X, unsigned char* ws) {
    if (X.tid == 0) { unsigned* bar = (unsigned*)(ws + WS_CTL) + CW_BAR; const unsigned want = (unsigned)(X.G < 2 * (MODW / 64) ? X.G : 2 * (MODW / 64));
        XB_SPIN(xb_ld((unsigned*)(ws + WS_CTL) + CW_MODCNT) < want, bar);
        __builtin_amdgcn_fence(__ATOMIC_ACQUIRE, "agent"); asm volatile("s_waitcnt vmcnt(0)" ::: "memory"); }
    __syncthreads();
}
DI void moe_convert(const Ctx& X, const InT& I, unsigned char* ws, int lo, int hi, int wk, int nwk) {
    LAS float* scr = (LAS float*)(X.lds + 40960 + X.wave * 8704);
    constexpr int PER = 1792;
    const float* mg = I.p[26]; const float* mu = I.p[27]; const float* md = I.p[28];
#define MOE_DECODE(it_, o_) do { const int mat = (it_) / PER; int r = (it_) % PER; const int e = mat / 3, which = mat % 3; \
        if (which == 0) xp_try(r, mg + (size_t)e * D * DFFE, D, DFFE, DFFE, (bf16*)(ws + WS_MOEGU + (size_t)e * 2 * DFFE * D), 1, o_, 1024.0f); \
        else if (which == 1) xp_try(r, mu + (size_t)e * D * DFFE, D, DFFE, DFFE, (bf16*)(ws + WS_MOEGU + (size_t)e * 2 * DFFE * D), 2, o_, 1024.0f); \
        else xp_try(r, md + (size_t)e * DFFE * D, DFFE, D, D, (bf16*)(ws + WS_MOEDN + (size_t)e * D * DFFE * (MOE_DOWN_F8 ? 1 : 2)), 0, o_, MOE_DOWN_F8 ? 2048.0f : 0.0f); } while (0)
    const int first = lo + wk * NWAVES + X.wave, step = nwk * NWAVES;
    if (first < hi) {
        XpItem cur, nx; f32x4 v[8], vn[8];
        MOE_DECODE(first, cur); xp_load(cur, v, X.lane);
        for (int it = first; it < hi; it += step) {
            const bool more = it + step < hi;
            if (more) { MOE_DECODE(it + step, nx); xp_load(nx, vn, X.lane); }
            xp_finish(cur, v, scr, X.lane);
            if (more) { cur = nx;
#pragma unroll
                for (int i = 0; i < 8; ++i) v[i] = vn[i]; }
        }
    }
#undef MOE_DECODE
}

template <bool ROUTER, bool XB, bool F8OUT = ROUTER> DI void norm_phase(const Ctx& X, const void* xin_, const float* nw, const float* modL, int sh_off, int sc_off, bf16* hout, const float* router_w, unsigned char* ws) {
    LAS float* rw = (LAS float*)X.lds;
    if (ROUTER) { for (int i = X.tid; i < D * NEXP / 4; i += NTHR) ((LAS f32x4*)rw)[i] = ((const f32x4*)router_w)[i]; SYNC(); }
    for (int rb = X.gw; rb < T / 16; rb += X.NGW) {
        const int m0 = rb * 16, b = m0 / SEQ;
        f32x4 a[4], s[4];
#pragma unroll
        for (int j = 0; j < 4; ++j) { const int col = 4 * X.lane + 256 * j; const f32x4 w = *(const f32x4*)(nw + col), sc = *(const f32x4*)(modL + (size_t)b * MODW + sc_off + col);
            a[j] = w * (1.0f + sc); s[j] = *(const f32x4*)(modL + (size_t)b * MODW + sh_off + col); }
        unsigned long long cnt0 = 0ull, cnt1 = 0ull;
        f32x4 vnx[4];
#define NORM_LDROW(m_, dst) do { if (XB) { const u32x2* xr_ = (const u32x2*)((const bf16*)xin_ + (size_t)(m_) * D) + X.lane; \
            _Pragma("unroll") for (int j = 0; j < 4; ++j) { const u32x2 w_ = xr_[64 * j]; dst[j] = (f32x4){__uint_as_float(w_.x << 16), __uint_as_float(w_.x & 0xffff0000u), __uint_as_float(w_.y << 16), __uint_as_float(w_.y & 0xffff0000u)}; } } \
          else { const f32x4* xr_ = (const f32x4*)((const float*)xin_ + (size_t)(m_) * D) + X.lane; _Pragma("unroll") for (int j = 0; j < 4; ++j) dst[j] = xr_[64 * j]; } } while (0)
        NORM_LDROW(m0, vnx);
        for (int jr = 0; jr < 16; ++jr) {
            const int m = m0 + jr;
            f32x4 v[4]; float ss = 0.f;
#pragma unroll
            for (int j = 0; j < 4; ++j) v[j] = vnx[j];
            NORM_LDROW(m0 + (jr < 15 ? jr + 1 : jr), vnx);
#pragma unroll
            for (int j = 0; j < 4; ++j) ss += (v[j].x * v[j].x + v[j].y * v[j].y) + (v[j].z * v[j].z + v[j].w * v[j].w);
            const float rstd = frsq(wave_sum(ss, X.lane) * (1.0f / D) + EPS);
            unsigned long long* o8 = (unsigned long long*)(hout + (size_t)m * D) + X.lane;
#pragma unroll
            for (int j = 0; j < 4; ++j) { v[j] = v[j] * rstd * a[j] + s[j];
                if (F8OUT) { int w = 0;
                    w = __builtin_amdgcn_cvt_pk_fp8_f32(__builtin_amdgcn_fmed3f(32.0f * v[j].x, -448.f, 448.f), __builtin_amdgcn_fmed3f(32.0f * v[j].y, -448.f, 448.f), w, false);
                    w = __builtin_amdgcn_cvt_pk_fp8_f32(__builtin_amdgcn_fmed3f(32.0f * v[j].z, -448.f, 448.f), __builtin_amdgcn_fmed3f(32.0f * v[j].w, -448.f, 448.f), w, true);
                    ((int*)((unsigned char*)hout + (size_t)m * D))[X.lane + 64 * j] = w; }
                else o8[64 * j] = (unsigned long long)pk2(v[j].x, v[j].y) | ((unsigned long long)pk2(v[j].z, v[j].w) << 32); }
            if (ROUTER) {
                float lg[8];
#pragma unroll
                for (int e = 0; e < 8; ++e) lg[e] = 0.f;
#pragma unroll
                for (int j = 0; j < 4; ++j) { asm volatile("" ::: "memory");
#pragma unroll
                    for (int i = 0; i < 4; ++i) { const int col = 4 * X.lane + 256 * j + i; const f32x4 w0 = *(const LAS f32x4*)(rw + col * 8), w1 = *(const LAS f32x4*)(rw + col * 8 + 4); const float hv = v[j][i];
                        lg[0] += hv * w0.x; lg[1] += hv * w0.y; lg[2] += hv * w0.z; lg[3] += hv * w0.w; lg[4] += hv * w1.x; lg[5] += hv * w1.y; lg[6] += hv * w1.z; lg[7] += hv * w1.w; } }
#pragma unroll
                for (int e = 0; e < 8; ++e) lg[e] = wave_sum(lg[e], X.lane);
                int e0 = 0; float v0 = lg[0];
#pragma unroll
                for (int e = 1; e < 8; ++e) if (lg[e] > v0) { v0 = lg[e]; e0 = e; }
                int e1 = -1; float v1 = -3.0e38f;
#pragma unroll
                for (int e = 0; e < 8; ++e) if (e != e0 && lg[e] > v1) { v1 = lg[e]; e1 = e; }
                const float w1 = frcp(1.0f + fexp(v0 - v1)), w0 = 1.0f - w1;
                cnt0 += 1ull << (8 * e0); cnt1 += 1ull << (8 * e1);
                if (X.lane == 0) { ((int*)(ws + WS_ROUTE_E))[m] = e0 | (e1 << 8); ((f32x2*)(ws + WS_ROUTE_W))[m] = (f32x2){w0, w1}; }
            }
        }
        if (ROUTER && X.lane == 0) { ((unsigned long long*)(ws + WS_WCNT))[rb * 2] = cnt0; ((unsigned long long*)(ws + WS_WCNT))[rb * 2 + 1] = cnt1; }
    }
}
DI void final_norm_phase(const Ctx& X, const bf16* xin, const bf16* y0, const bf16* y1, const float* gate, const float* nw, float* out) {
    f32x4 a[4];
#pragma unroll
    for (int j = 0; j < 4; ++j) a[j] = *(const f32x4*)(nw + 4 * X.lane + 256 * j);
    u32x2 wn[4], pn[4], qn[4];
    { const size_t o0 = (size_t)(X.gw < T ? X.gw : 0) * D; const u32x2* xr0 = (const u32x2*)(xin + o0) + X.lane; const u32x2* pr0 = (const u32x2*)(y0 + o0) + X.lane; const u32x2* qr0 = (const u32x2*)(y1 + o0) + X.lane;
#pragma unroll
        for (int j = 0; j < 4; ++j) { wn[j] = xr0[64 * j]; pn[j] = pr0[64 * j]; qn[j] = qr0[64 * j]; } }
#define FN_UP(w_) ((f32x4){__uint_as_float((w_).x << 16), __uint_as_float((w_).x & 0xffff0000u), __uint_as_float((w_).y << 16), __uint_as_float((w_).y & 0xffff0000u)})
    for (int m = X.gw; m < T; m += X.NGW) {
        const int mn = m + X.NGW < T ? m + X.NGW : m;
        const u32x2* xr = (const u32x2*)(xin + (size_t)mn * D) + X.lane; const u32x2* pr = (const u32x2*)(y0 + (size_t)mn * D) + X.lane; const u32x2* qr = (const u32x2*)(y1 + (size_t)mn * D) + X.lane;
        const float* gp = gate + (size_t)(m / SEQ) * MODW + 4 * X.lane;
        f32x4 v[4]; float ss = 0.f;
#pragma unroll
        for (int j = 0; j < 4; ++j) { const u32x2 w = wn[j], y = pn[j], z = qn[j]; wn[j] = xr[64 * j]; pn[j] = pr[64 * j]; qn[j] = qr[64 * j];
            v[j] = FN_UP(w) + *(const f32x4*)(gp + 256 * j) * (FN_UP(y) + FN_UP(z));
            ss += (v[j].x * v[j].x + v[j].y * v[j].y) + (v[j].z * v[j].z + v[j].w * v[j].w); }
        const float rstd = frsq(wave_sum(ss, X.lane) * (1.0f / D) + EPS);
        f32x4* o = (f32x4*)(out + (size_t)m * D) + X.lane;
#pragma unroll
        for (int j = 0; j < 4; ++j) o[64 * j] = v[j] * rstd * a[j];
    }
#undef FN_UP
}

DI void moe_list_phase(const Ctx& X, unsigned char* ws) {
    const unsigned long long* wc = (const unsigned long long*)(ws + WS_WCNT);
    int* list = (int*)(ws + WS_LIST); float* roww = (float*)(ws + WS_ROWW); int* tiles = (int*)(ws + WS_TILES);
    for (int rb = X.gw; rb < T / 16; rb += X.NGW) {
        int tot[2][8], pre[2][8];
#pragma unroll
        for (int s = 0; s < 2; ++s)
#pragma unroll
            for (int e = 0; e < 8; ++e) { tot[s][e] = 0; pre[s][e] = 0; }
        for (int r2 = X.lane; r2 < T / 16; r2 += 64) {
            const unsigned long long c0 = wc[r2 * 2], c1 = wc[r2 * 2 + 1]; const bool lt = r2 < rb;
#pragma unroll
            for (int e = 0; e < 8; ++e) { const int a0 = (int)((c0 >> (8 * e)) & 0xffull), a1 = (int)((c1 >> (8 * e)) & 0xffull);
                tot[0][e] += a0; tot[1][e] += a1; pre[0][e] += lt ? a0 : 0; pre[1][e] += lt ? a1 : 0; }
        }
#pragma unroll
        for (int s = 0; s < 2; ++s)
#pragma unroll
            for (int e = 0; e < 8; ++e) {
#pragma unroll
                for (int o = 1; o < 64; o <<= 1) { tot[s][e] += bperm_i(X.lane ^ o, tot[s][e]); pre[s][e] += bperm_i(X.lane ^ o, pre[s][e]); } }
        int base[2][8], nt[2];
#pragma unroll
        for (int s = 0; s < 2; ++s) { int acc = 0;
#pragma unroll
            for (int e = 0; e < 8; ++e) { base[s][e] = acc; acc += (tot[s][e] + 255) & ~255; } nt[s] = acc / 256; }
        const int j = X.lane & 15, m = rb * 16 + j;
        const int ee = ((const int*)(ws + WS_ROUTE_E))[m]; const f32x2 ww = ((const f32x2*)(ws + WS_ROUTE_W))[m];
#pragma unroll
        for (int s = 0; s < 2; ++s) {
            const int es = s == 0 ? (ee & 0xff) : ((ee >> 8) & 0xff);
            int pos = 0;
#pragma unroll
            for (int e = 0; e < 8; ++e) pos = (es == e) ? base[s][e] + pre[s][e] : pos;
            int rank = 0;
#pragma unroll
            for (int jj = 0; jj < 16; ++jj) { const int eo = bperm_i(jj, es); rank += (jj < j && eo == es) ? 1 : 0; }
            const int off = s == 0 ? 0 : nt[0] * 256;
            if (X.lane < 16) { list[off + pos + rank] = m; roww[off + pos + rank] = s == 0 ? ww.x : ww.y; }
        }
        if (rb == 0) {
#pragma unroll
            for (int s = 0; s < 2; ++s) { const int off = s == 0 ? 0 : nt[0] * 256;
#pragma unroll
                for (int e = 0; e < 8; ++e) { const int lo = base[s][e] + tot[s][e], hi = base[s][e] + ((tot[s][e] + 255) & ~255);
                    for (int r = lo + X.lane; r < hi; r += 64) { list[off + r] = -1; roww[off + r] = 0.f; }
                    for (int t = base[s][e] / 256 + X.lane; t < hi / 256; t += 64) tiles[off / 256 + t] = e; }
            }
            if (X.lane == 0) { tiles[TILE_TAB - 2] = nt[0]; tiles[TILE_TAB - 1] = nt[0] + nt[1]; }
        }
    }
}

DI void dn_prep_phase(const Ctx& X, const bf16* proj, const float* convw, const float* a_log, const float* dt_bias, unsigned char* ws, bf16* dnb) {
    LAS float* qf = (LAS float*)(X.lds + 0); LAS float* kf = (LAS float*)(X.lds + 16640); LAS float* vf = (LAS float*)(X.lds + 33280);
    LAS float* Ld = (LAS float*)(X.lds + 49920); LAS float* Tinv = (LAS float*)(X.lds + 55040);
    LAS float* cwb = (LAS float*)(X.lds + 60160);
    LAS float* hpar = (LAS float*)(X.lds + 63232);
    LAS bf16* Qb = (LAS bf16*)(X.lds + 67328); LAS bf16* Kb = (LAS bf16*)(X.lds + 76544); LAS bf16* KBb = (LAS bf16*)(X.lds + 85760);
    LAS float* gcv = (LAS float*)(X.lds + 94976); LAS float* betav = gcv + 64; LAS float* egv = gcv + 128; LAS float* ekv = gcv + 192; LAS float* gv = gcv + 256;
    LAS bf16* Lb = (LAS bf16*)(X.lds + 96256);
    LAS bf16* Xt = (LAS bf16*)(X.lds + 105472);
    const int tid = X.tid, lane = X.lane;
#define DNP_LOAD(u_, XR, BD) do { const int uu = (u_) < NBATCH * 6 * NCHUNK ? (u_) : X.vcu; const int b_ = uu / (6 * NCHUNK), h_ = (uu / NCHUNK) % 6, n_ = uu % NCHUNK; \
        _Pragma("unroll") for (int k = 0; k < 3; ++k) { const int it = tid + k * NTHR, t_ = it / 24, g8 = it % 24, which = g8 >> 3, col = (which == 0 ? C_DQ : (which == 1 ? C_DK : C_DV)) + h_ * 64 + (g8 & 7) * 8; \
            _Pragma("unroll") for (int j = 0; j < 4; ++j) { const int tt = n_ * 64 + t_ - 3 + j; XR[k][j] = *(const v4u*)(proj + ((size_t)b_ * SEQ + (tt < 0 ? 0 : tt)) * DINP + col); } \
            BD[k] = *(const unsigned*)(proj + ((size_t)b_ * SEQ + n_ * 64 + t_) * DINP + C_DB + 2 * (h_ >> 1)); } \
        if (tid < 64) BD[3] = *(const unsigned*)(proj + ((size_t)b_ * SEQ + n_ * 64 + tid) * DINP + C_DA + 2 * (h_ >> 1)); \
        if (tid < 192) cwq = *(const f32x4*)(convw + (tid / 48) * 1152 + (((tid % 48) * 4) >> 6) * 384 + h_ * 64 + (((tid % 48) * 4) & 63)); } while (0)
    v4u xr[3][4]; unsigned bd[4] = {0u, 0u, 0u, 0u}; f32x4 cwq = (f32x4){0.f, 0.f, 0.f, 0.f};
    DNP_LOAD(X.vcu, xr, bd);
    if (tid < 192) *(LAS f32x4*)(cwb + tid * 4) = cwq;
    if (tid < 6) { hpar[2 * tid] = -fexp(a_log[tid]); hpar[2 * tid + 1] = dt_bias[tid]; }
    SYNC();
    for (int u = X.vcu; u < NBATCH * 6 * NCHUNK; u += X.G) {
        const int b = u / (6 * NCHUNK), h = (u / NCHUNK) % 6, n = u % NCHUNK;
        bf16* ub = dnb + (size_t)u * 5 * 4096;
#pragma unroll
        for (int k = 0; k < 3; ++k) {
            const int it = tid + k * NTHR, t = it / 24, g8 = it % 24, which = g8 >> 3, d0 = (g8 & 7) * 8, cch = which * 384 + h * 64 + d0;
            float y[8];
#pragma unroll
            for (int i = 0; i < 8; ++i) y[i] = 0.f;
#pragma unroll
            for (int j = 0; j < 4; ++j) { v4u xw = xr[k][j]; if (n * 64 + t - 3 + j < 0) xw = (v4u){0u, 0u, 0u, 0u}; float xf[8]; unpack8(xw, xf);
                const f32x4 w0 = *(const LAS f32x4*)(cwb + j * 192 + which * 64 + d0), w1 = *(const LAS f32x4*)(cwb + j * 192 + which * 64 + d0 + 4);
                y[0] += w0.x * xf[0]; y[1] += w0.y * xf[1]; y[2] += w0.z * xf[2]; y[3] += w0.w * xf[3]; y[4] += w1.x * xf[4]; y[5] += w1.y * xf[5]; y[6] += w1.z * xf[6]; y[7] += w1.w * xf[7]; }
            float ss = 0.f;
#pragma unroll
            for (int i = 0; i < 8; ++i) { y[i] = silu(y[i]); ss += y[i] * y[i]; }
            ss = dpp_sum8(ss);
            const float sc = which == 2 ? 1.0f : frsq(ss + EPS) * (which == 0 ? 0.125f : 1.0f);
#pragma unroll
            for (int i = 0; i < 8; ++i) y[i] *= sc;
            LAS float* dst = (which == 0 ? qf : (which == 1 ? kf : vf)) + t * 65 + d0;
#pragma unroll
            for (int i = 0; i < 8; ++i) dst[i] = y[i];
            const float bt = sigm(bf2f((h & 1) ? (bd[k] >> 16) : (bd[k] & 0xffffu)));
            if (which == 0) *(LAS v4u*)(Qb + t * 72 + d0) = pack8(y);
            if (which == 1) { *(LAS v4u*)(Kb + t * 72 + d0) = pack8(y);
#pragma unroll
                for (int i = 0; i < 8; ++i) y[i] *= bt;
                *(LAS v4u*)(KBb + t * 72 + d0) = pack8(y); }
            if (which == 2 && d0 == 0) betav[t] = bt;
        }
        for (int i = tid; i < 128 * 72 / 2; i += NTHR) ((LAS unsigned*)Xt)[i] = 0u;
        if (tid < 64) gv[tid] = hpar[2 * h] * softplus(bf2f((h & 1) ? (bd[3] >> 16) : (bd[3] & 0xffffu)) + hpar[2 * h + 1]);
        SYNC();
        if (X.wave == 0) { float v = gv[lane];
#pragma unroll
            for (int o = 1; o < 64; o <<= 1) { const float up = bperm_f(lane - o, v); if (lane >= o) v += up; }
            const float gl = bperm_f(63, v);
            gcv[lane] = v; egv[lane] = fexp(v); ekv[lane] = fexp(gl - v);
            if (lane == 63) ((float*)(ws + WS_DNDEC))[u] = fexp(gl); }
        const int tr = X.wave >> 1, r = lane & 15, q = lane >> 4, tc0 = (X.wave & 1) * 2;
        f32x4 akk0, akk1, aqk0, aqk1;
        { const f32x4 z = (f32x4){0.f, 0.f, 0.f, 0.f};
            const LAS bf16* pa = KBb + (16 * tr + r) * 72 + q * 8; const LAS bf16* pq = Qb + (16 * tr + r) * 72 + q * 8; const LAS bf16* pb = Kb + (16 * tc0 + r) * 72 + q * 8;
            const bf16x8 a0 = LDF(pa), a1 = LDF(pa + 32), q0 = LDF(pq), q1 = LDF(pq + 32), b00 = LDF(pb), b01 = LDF(pb + 32), b10 = LDF(pb + 16 * 72), b11 = LDF(pb + 16 * 72 + 32);
            akk0 = MFMA16(a0, b00, z); akk1 = MFMA16(a0, b10, z); aqk0 = MFMA16(q0, b00, z); aqk1 = MFMA16(q0, b10, z);
            akk0 = MFMA16(a1, b01, akk0); akk1 = MFMA16(a1, b11, akk1); aqk0 = MFMA16(q1, b01, aqk0); aqk1 = MFMA16(q1, b11, aqk1); }
        SYNC();
#pragma unroll
        for (int e = 0; e < 2; ++e) { const int tc = tc0 + e; const f32x4 akk = e == 0 ? akk0 : akk1, aqk = e == 0 ? aqk0 : aqk1;
            const int j = 16 * tc + r; const float gj = gcv[j];
#pragma unroll
            for (int ii = 0; ii < 4; ++ii) { const int i = 16 * tr + q * 4 + ii; const float dec = fexp(fminf(gcv[i] - gj, 0.f));
                const float lv = (j < i) ? akk[ii] * dec : 0.f;
                Lb[i * 72 + j] = (bf16)f2bf(lv);
                if (tr == tc) Ld[tr * 320 + (q * 4 + ii) * 20 + r] = lv;
                ub[4 * 4096 + i * 64 + j] = (bf16)f2bf((j <= i) ? aqk[ii] * dec : 0.f); } }
        if ((tr >> 1) == (X.wave & 1)) {
            asm volatile("s_waitcnt lgkmcnt(0)" ::: "memory");
            if (lane < 16) { const int c = lane; const LAS float* Lp = Ld + tr * 320;
                f32x4 Lr[16][4];
#define DNP_LROWS(m0_, m1_) _Pragma("unroll") for (int m = (m0_); m <= (m1_); ++m) _Pragma("unroll") for (int v = 0; v <= (m - 1) / 4; ++v) Lr[m][v] = *(const LAS f32x4*)(Lp + m * 20 + 4 * v)
#define DNP_TROWS(m0_, m1_) _Pragma("unroll") for (int m = (m0_); m <= (m1_); ++m) { float s = fmaxf(0.f, 1.0f - fabsf(cf - (float)m));   \
                    _Pragma("unroll") for (int k = 0; k < m; ++k) s -= Lr[m][k >> 2][k & 3] * tcol[k]; tcol[m] = s; }
                float cf = (float)c; asm volatile("" : "+v"(cf));
                float tcol[16];
                DNP_LROWS(1, 8); DNP_LROWS(9, 12);
                asm volatile("" ::: "memory");
                DNP_TROWS(0, 8);
                asm volatile("" ::: "memory");
                DNP_LROWS(13, 15);
                asm volatile("" ::: "memory");
                DNP_TROWS(9, 12);
                DNP_TROWS(13, 15);
#undef DNP_LROWS
#undef DNP_TROWS
#pragma unroll
                for (int m = 0; m < 16; ++m) Tinv[tr * 320 + m * 20 + c] = tcol[m]; }
        }
        for (int it = tid; it < 1024; it += NTHR) {
            float f[8];
            if (it < 512) { const int d = it >> 3, t0 = (it & 7) * 8;
#pragma unroll
                for (int i = 0; i < 8; ++i) f[i] = kf[(t0 + i) * 65 + d] * ekv[t0 + i];
                *(v4u*)(ub + 2 * 4096 + d * 64 + t0) = pack8(f);
            } else { const int i2 = it - 512, t = i2 >> 3, d0 = (i2 & 7) * 8; const float e = egv[t];
#pragma unroll
                for (int i = 0; i < 8; ++i) f[i] = qf[t * 65 + d0 + i] * e;
                *(v4u*)(ub + 3 * 4096 + t * 64 + d0) = pack8(f); }
        }
        SYNC();
        DNP_LOAD(u + X.G, xr, bd);
        { const int r = lane & 15, q = lane >> 4, c = 16 * X.wave + r; const bool isW = X.wave >= 4; const int cc = c & 63;
            f32x4 rhs[4], tfv[4];
            { const LAS float* src = (isW ? kf : vf) + cc;
#pragma unroll
                for (int i = 0; i < 4; ++i) { const int row = 16 * i + q * 4; f32x4 sc = *(const LAS f32x4*)(betav + row); if (isW) sc = sc * *(const LAS f32x4*)(egv + row);
                    rhs[i] = (f32x4){src[row * 65] * sc.x, src[(row + 1) * 65] * sc.y, src[(row + 2) * 65] * sc.z, src[(row + 3) * 65] * sc.w};
                    tfv[i] = *(const LAS f32x4*)(Tinv + i * 320 + r * 20 + 4 * q); } }
#pragma unroll
            for (int i = 0; i < 4; ++i) {
                f32x4 acc = (f32x4){0.f, 0.f, 0.f, 0.f};
                if (i > 0) { if (i < 3) acc = mm16<32>(Lb + 16 * i * 72, 72, Xt + 16 * X.wave * 72, 72, acc, lane); else acc = mm16<64>(Lb + 16 * i * 72, 72, Xt + 16 * X.wave * 72, 72, acc, lane); }
                const f32x4 tf = tfv[i];
                const f32x4 y = rhs[i] - acc;
                f32x4 xo = (f32x4){0.f, 0.f, 0.f, 0.f};
                xo = __builtin_amdgcn_mfma_f32_16x16x4f32(tf[0], y[0], xo, 0, 0, 0);
                xo = __builtin_amdgcn_mfma_f32_16x16x4f32(tf[1], y[1], xo, 0, 0, 0);
                xo = __builtin_amdgcn_mfma_f32_16x16x4f32(tf[2], y[2], xo, 0, 0, 0);
                xo = __builtin_amdgcn_mfma_f32_16x16x4f32(tf[3], y[3], xo, 0, 0, 0);
                const u32x2 pk = pack4(xo[0], xo[1], xo[2], xo[3]);
                *(LAS u32x2*)(Xt + c * 72 + 16 * i + q * 4) = pk;
                if (!isW) *(u32x2*)(ub + 1 * 4096 + cc * 64 + 16 * i + q * 4) = pk;
                else {
#pragma unroll
                    for (int ii = 0; ii < 4; ++ii) ub[(16 * i + q * 4 + ii) * 64 + cc] = (bf16)f2bf(xo[ii]); }
                asm volatile("s_waitcnt lgkmcnt(0)" ::: "memory");
            }
        }
        if (tid < 192) *(LAS f32x4*)(cwb + tid * 4) = cwq;
        SYNC();
    }
#undef DNP_LOAD
}

DI void dn_chain(const Ctx& X, int bh, const bf16* proj, const float* normw, const unsigned char* ws, const bf16* dnb, bf16* merged) {
    LAS bf16* Wl = (LAS bf16*)(X.lds + 0); LAS bf16* Utl = (LAS bf16*)(X.lds + 9216); LAS bf16* KEl = (LAS bf16*)(X.lds + 18432); LAS bf16* QDl = (LAS bf16*)(X.lds + 27648); LAS bf16* QKl = (LAS bf16*)(X.lds + 36864);
    LAS bf16* St0 = (LAS bf16*)(X.lds + 46080); LAS bf16* Vtl = (LAS bf16*)(X.lds + 64512); LAS float* Of = (LAS float*)(X.lds + 73728);
    const int tid = X.tid, lane = X.lane, b = bh / 6, h = bh % 6;
    const int prow = tid >> 3, pseg = (tid & 7) * 8;
    const int tr = X.wave >> 1, tc0 = (X.wave & 1) * 2, r = lane & 15, q = lane >> 4;
    const bf16* ubase = dnb + (size_t)bh * NCHUNK * 5 * 4096 + prow * 64 + pseg;
    const bf16* zbase = proj + ((size_t)b * SEQ + prow) * DINP + C_DZ + h * 64 + pseg;
    const float decl = ((const float*)(ws + WS_DNDEC))[bh * NCHUNK + lane];
    float nwv[8];
#pragma unroll
    for (int i = 0; i < 8; ++i) nwv[i] = normw[pseg + i];
    for (int i = tid; i < 2 * 64 * 72 / 2; i += NTHR) ((LAS unsigned*)St0)[i] = 0u;
    v4u pfE[5], pfO[5], dzE, dzO;
#pragma unroll
    for (int k = 0; k < 5; ++k) { pfE[k] = *(const v4u*)(ubase + k * 4096); pfO[k] = *(const v4u*)(ubase + (size_t)5 * 4096 + k * 4096); }
    dzE = *(const v4u*)zbase; dzO = *(const v4u*)(zbase + (size_t)64 * DINP);
#pragma unroll
    for (int k = 0; k < 5; ++k) *(LAS v4u*)(Wl + k * 4608 + prow * 72 + pseg) = pfE[k];
    f32x4 sreg0 = (f32x4){0.f, 0.f, 0.f, 0.f}, sreg1 = sreg0;
    const LAS bf16* aW = Wl + (16 * tr + r) * 72 + q * 8; const LAS bf16* aKE = KEl + (16 * tr + r) * 72 + q * 8; const LAS bf16* aQD = QDl + (16 * tr + r) * 72 + q * 8; const LAS bf16* aQK = QKl + (16 * tr + r) * 72 + q * 8;
    const int bo0 = (16 * tc0 + r) * 72 + q * 8, bo1 = bo0 + 16 * 72;
    const int co0 = (16 * tc0 + r) * 72 + 16 * tr + q * 4, co1 = co0 + 16 * 72;
    SYNC();
#define DN_OUT(nn, OFB, DZV) do { float o[8]; const f32x4 oa = *(const LAS f32x4*)((OFB) + prow * 68 + pseg), ob = *(const LAS f32x4*)((OFB) + prow * 68 + pseg + 4); \
          o[0] = oa.x; o[1] = oa.y; o[2] = oa.z; o[3] = oa.w; o[4] = ob.x; o[5] = ob.y; o[6] = ob.z; o[7] = ob.w; \
          float ss = 0.f; _Pragma("unroll") for (int i = 0; i < 8; ++i) ss += o[i] * o[i]; \
          ss = dpp_sum8(ss); const float rstd = frsq(ss * (1.0f / 64.0f) + EPS); \
          float zf[8]; unpack8(DZV, zf); _Pragma("unroll") for (int i = 0; i < 8; ++i) o[i] = o[i] * rstd * nwv[i] * silu(zf[i]); \
          *(v4u*)(merged + ((size_t)b * SEQ + (size_t)(nn) * 64 + prow) * D + 640 + h * 64 + pseg) = pack8(o); } while (0)
#define DN_ITER(n, DZC, PFF, DZF, PFS) do { \
        const v4u dzv = DZC; \
        { const int n2 = (n) + 2 < NCHUNK ? (n) + 2 : NCHUNK - 1; const bf16* up = ubase + (size_t)n2 * 5 * 4096; \
          _Pragma("unroll") for (int k = 0; k < 5; ++k) PFF[k] = *(const v4u*)(up + k * 4096); \
          DZF = *(const v4u*)(zbase + (size_t)n2 * 64 * DINP); } \
        const float dec = __builtin_bit_cast(float, __builtin_amdgcn_readlane(__builtin_bit_cast(int, decl), (n))); \
        LAS bf16* Sc = St0 + cur * 4608; LAS bf16* Sn = St0 + (cur ^ 1) * 4608; LAS float* Ofc = Of + cur * 4352; LAS float* Ofp = Of + (cur ^ 1) * 4352; \
        const f32x4 z = (f32x4){0.f, 0.f, 0.f, 0.f}; \
          \
        const bf16x8 w0 = LDF(aW), w1 = LDF(aW + 32), s00 = LDF(Sc + bo0), s01 = LDF(Sc + bo0 + 32), s10 = LDF(Sc + bo1), s11 = LDF(Sc + bo1 + 32); \
        const u32x2 ut0 = *(const LAS u32x2*)(Utl + co0), ut1 = *(const LAS u32x2*)(Utl + co1); \
        f32x4 a0 = MFMA16(w0, s00, z), a1 = MFMA16(w0, s10, z); a0 = MFMA16(w1, s01, a0); a1 = MFMA16(w1, s11, a1); \
        { float u0[4], u1[4]; unpack4(ut0, u0); unpack4(ut1, u1); \
          *(LAS u32x2*)(Vtl + co0) = pack4(u0[0] - a0[0], u0[1] - a0[1], u0[2] - a0[2], u0[3] - a0[3]); \
          *(LAS u32x2*)(Vtl + co1) = pack4(u1[0] - a1[0], u1[1] - a1[1], u1[2] - a1[2], u1[3] - a1[3]); } \
        const bf16x8 ke0 = LDF(aKE), ke1 = LDF(aKE + 32), qd0 = LDF(aQD), qd1 = LDF(aQD + 32), qk0 = LDF(aQK), qk1 = LDF(aQK + 32); \
        SYNC(); \
          \
        const bf16x8 v00 = LDF(Vtl + bo0), v01 = LDF(Vtl + bo0 + 32), v10 = LDF(Vtl + bo1), v11 = LDF(Vtl + bo1 + 32); \
        f32x4 o0 = MFMA16(qd0, s00, z), o1 = MFMA16(qd0, s10, z); o0 = MFMA16(qd1, s01, o0); o1 = MFMA16(qd1, s11, o1); \
        f32x4 n0 = MFMA16(ke0, v00, z), n1 = MFMA16(ke0, v10, z); \
        o0 = MFMA16(qk0, v00, o0); o1 = MFMA16(qk0, v10, o1); \
        n0 = MFMA16(ke1, v01, n0); n1 = MFMA16(ke1, v11, n1); \
        o0 = MFMA16(qk1, v01, o0); o1 = MFMA16(qk1, v11, o1); \
        if ((n) > 0) DN_OUT((n) - 1, Ofp, dzp);     \
        sreg0 = sreg0 * dec + n0; sreg1 = sreg1 * dec + n1; \
        *(LAS u32x2*)(Sn + co0) = pack4(sreg0[0], sreg0[1], sreg0[2], sreg0[3]); *(LAS u32x2*)(Sn + co1) = pack4(sreg1[0], sreg1[1], sreg1[2], sreg1[3]); \
        _Pragma("unroll") for (int i = 0; i < 4; ++i) { Ofc[(16 * tr + q * 4 + i) * 68 + 16 * tc0 + r] = o0[i]; Ofc[(16 * tr + q * 4 + i) * 68 + 16 * tc0 + 16 + r] = o1[i]; } \
        _Pragma("unroll") for (int k = 0; k < 5; ++k) *(LAS v4u*)(Wl + k * 4608 + prow * 72 + pseg) = PFS[k]; \
        SYNC(); dzp = dzv; cur ^= 1; } while (0)
    int cur = 0; v4u dzp = dzE;
    for (int n = 0; n < NCHUNK; n += 2) {
        DN_ITER(n, dzE, pfE, dzE, pfO);
        DN_ITER(n + 1, dzO, pfO, dzO, pfE);
    }
    DN_OUT(NCHUNK - 1, Of + (cur ^ 1) * 4352, dzp);
    SYNC();
#undef DN_ITER
#undef DN_OUT
}

DI void gla_prep_phase(const Ctx& X, const bf16* proj, const float* w2, const float* b2, unsigned char* ws) {
    LAS float* W2s = (LAS float*)(X.lds + 0); LAS float* b2s = (LAS float*)(X.lds + 2048);
    LAS float* la = (LAS float*)(X.lds + 2304);
    LAS float* tot = (LAS float*)(X.lds + 10752);
    LAS bf16* QDl = (LAS bf16*)(X.lds + 12800); LAS bf16* KDl = (LAS bf16*)(X.lds + 17920);
    LAS bf16* KEl = (LAS bf16*)(X.lds + 23040);
    LAS bf16* Vtl = (LAS bf16*)(X.lds + 27648); LAS bf16* Pl = (LAS bf16*)(X.lds + 36864);
    const int tid = X.tid, lane = X.lane, t = tid >> 3, part = tid & 7, r = lane & 15, q = lane >> 4;
#define GLAP_LOAD(u_, Q4, K4, V8, G0, G1, WV, BV) do { const int uu = (u_) < NBATCH * 6 * NCHUNK ? (u_) : X.vcu; const int b_ = uu / (6 * NCHUNK), h_ = (uu / NCHUNK) % 6, n_ = uu % NCHUNK; \
        const bf16* pr_ = proj + ((size_t)b_ * SEQ + (size_t)n_ * 64 + t) * DINP; \
        Q4 = *(const u32x2*)(pr_ + C_GQ + h_ * 32 + part * 4); K4 = *(const u32x2*)(pr_ + C_GK + h_ * 32 + part * 4); V8 = *(const v4u*)(pr_ + C_GV + h_ * 64 + part * 8); \
        G0 = *(const v4u*)(pr_ + C_GLR); G1 = *(const v4u*)(pr_ + C_GLR + 8); WV = w2[(tid >> 5) * 192 + h_ * 32 + (tid & 31)]; BV = b2[h_ * 32 + (tid & 31)]; } while (0)
    u32x2 q4, k4, q4n, k4n; v4u v8, g0, g1, v8n, g0n, g1n; float wv, bv, wvn, bvn;
    GLAP_LOAD(X.vcu, q4, k4, v8, g0, g1, wv, bv);
    for (int u = X.vcu; u < NBATCH * 6 * NCHUNK; u += X.G) {
        const int b = u / (6 * NCHUNK), h = (u / NCHUNK) % 6, n = u % NCHUNK;
        bf16* ub = (bf16*)(ws + WS_GLA) + (size_t)u * 8192;
        W2s[tid] = wv;
        if (tid < 32) b2s[tid] = bv;
        GLAP_LOAD(u + X.G, q4n, k4n, v8n, g0n, g1n, wvn, bvn);
        SYNC();
        { float gl[16]; { float t0[8], t1[8]; unpack8(g0, t0); unpack8(g1, t1);
#pragma unroll
                for (int i = 0; i < 8; ++i) { gl[i] = t0[i]; gl[8 + i] = t1[i]; } }
            f32x4 zz = *(const LAS f32x4*)(b2s + part * 4);
#pragma unroll
            for (int rr = 0; rr < 16; ++rr) zz += *(const LAS f32x4*)(W2s + rr * 32 + part * 4) * gl[rr];
#pragma unroll
            for (int cc = 0; cc < 4; ++cc) la[t * 33 + part * 4 + cc] = -softplus(-zz[cc]) * (1.0f / 16.0f); }
        SYNC();
        const int cc2 = tid & 31, seg = tid >> 5;
        const float l0 = la[(seg * 4 + 0) * 33 + cc2], l1 = l0 + la[(seg * 4 + 1) * 33 + cc2], l2 = l1 + la[(seg * 4 + 2) * 33 + cc2], l3 = l2 + la[(seg * 4 + 3) * 33 + cc2];
        tot[seg * 32 + cc2] = l3;
        SYNC();
        { float off = 0.f;
#pragma unroll
            for (int s2 = 0; s2 < 15; ++s2) off += (s2 < seg) ? tot[s2 * 32 + cc2] : 0.f;
            la[(seg * 4 + 0) * 33 + cc2] = off + l0; la[(seg * 4 + 1) * 33 + cc2] = off + l1; la[(seg * 4 + 2) * 33 + cc2] = off + l2; la[(seg * 4 + 3) * 33 + cc2] = off + l3; }
        SYNC();
        { float qf[4], kf[4]; unpack4(q4, qf); unpack4(k4, kf); float qd[4], kd[4];
#pragma unroll
            for (int cc = 0; cc < 4; ++cc) { const int c = part * 4 + cc; const float bc = la[t * 33 + c], bl = la[63 * 33 + c];
                qd[cc] = qf[cc] * 0.17677669529663687f * fexp(bc); kd[cc] = kf[cc] * fexp(-bc);
                KEl[c * 72 + t] = (bf16)f2bf(kf[cc] * fexp(bl - bc)); }
            const u32x2 qp = pack4(qd[0], qd[1], qd[2], qd[3]);
            *(LAS u32x2*)(QDl + t * 40 + part * 4) = qp; *(u32x2*)(ub + t * 32 + part * 4) = qp;
            *(LAS u32x2*)(KDl + t * 40 + part * 4) = pack4(kd[0], kd[1], kd[2], kd[3]);
            const unsigned vw[4] = {v8.x, v8.y, v8.z, v8.w};
#pragma unroll
            for (int i = 0; i < 4; ++i) { Vtl[(part * 8 + 2 * i) * 72 + t] = (bf16)(vw[i] & 0xffffu); Vtl[(part * 8 + 2 * i + 1) * 72 + t] = (bf16)(vw[i] >> 16); }
            if (tid < 32) ((float*)(ws + WS_GLADEC))[(size_t)u * 32 + tid] = fexp(la[63 * 33 + tid]); }
        SYNC();
        { const f32x4 z = (f32x4){0.f, 0.f, 0.f, 0.f}; const int trs = X.wave >> 1;
#pragma unroll
            for (int e = 0; e < 2; ++e) { const int tct = (X.wave & 1) * 2 + e;
                const f32x4 a = mm16<32>(KDl + 16 * trs * 40, 40, QDl + 16 * tct * 40, 40, z, lane);
                const int tq = 16 * tct + r, s0 = 16 * trs + q * 4;
                *(LAS u32x2*)(Pl + tq * 72 + s0) = pack4(s0 <= tq ? a[0] : 0.f, s0 + 1 <= tq ? a[1] : 0.f, s0 + 2 <= tq ? a[2] : 0.f, s0 + 3 <= tq ? a[3] : 0.f); }
            const int trS = X.wave >> 2, tcS = X.wave & 3;
            const f32x4 a = mm16<64>(KEl + 16 * trS * 72, 72, Vtl + 16 * tcS * 72, 72, z, lane);
            *(u32x2*)(ub + 6144 + ((trS * 4 + tcS) * 64 + lane) * 4) = pack4(a[0], a[1], a[2], a[3]); }
        SYNC();
        { const f32x4 z = (f32x4){0.f, 0.f, 0.f, 0.f}; const int tr = X.wave >> 1;
#pragma unroll
            for (int e = 0; e < 2; ++e) { const int tc = (X.wave & 1) * 2 + e;
                const f32x4 o = mm16<64>(Pl + 16 * tr * 72, 72, Vtl + 16 * tc * 72, 72, z, lane);
                *(u32x2*)(ub + 2048 + ((tr * 4 + tc) * 64 + lane) * 4) = pack4(o[0], o[1], o[2], o[3]); } }
        q4 = q4n; k4 = k4n; v8 = v8n; g0 = g0n; g1 = g1n; wv = wvn; bv = bvn;
        SYNC();
    }
#undef GLAP_LOAD
}
DI void gla_chain(const Ctx& X, int bh, const bf16* proj, const float* normw, const unsigned char* ws, bf16* merged) {
    LAS bf16* St0 = (LAS bf16*)(X.lds + 0);
    LAS float* Of0 = (LAS float*)(X.lds + 10240);
    const int tid = X.tid, lane = X.lane, b = bh / 6, h = bh % 6;
    const int t = tid >> 3, part = tid & 7, r = lane & 15, q = lane >> 4;
    const int tr = X.wave >> 1, tc0 = (X.wave & 1) * 2, trS = X.wave >> 2, tcS = X.wave & 3;
    for (int i = tid; i < 2 * 64 * 40 / 2; i += NTHR) ((LAS unsigned*)St0)[i] = 0u;
    float nwv[8];
#pragma unroll
    for (int i = 0; i < 8; ++i) nwv[i] = normw[part * 8 + i];
    const bf16* ub0 = (const bf16*)(ws + WS_GLA) + (size_t)bh * NCHUNK * 8192;
    const float* dp0 = (const float*)(ws + WS_GLADEC) + (size_t)bh * NCHUNK * 32;
    const bf16* zp0 = proj + ((size_t)b * SEQ + t) * DINP + C_GZ + h * 64 + part * 8;
    f32x4 sreg = (f32x4){0.f, 0.f, 0.f, 0.f};
#define GLA_LOAD(n, QD, OI0, OI1, KV, DC, Z) do { const int n4 = (n) < NCHUNK ? (n) : NCHUNK - 1; const bf16* ubn = ub0 + (size_t)n4 * 8192; \
        QD = *(const v4u*)(ubn + (16 * tr + r) * 32 + q * 8); \
        OI0 = *(const u32x2*)(ubn + 2048 + ((tr * 4 + tc0) * 64 + lane) * 4); OI1 = *(const u32x2*)(ubn + 2048 + ((tr * 4 + tc0 + 1) * 64 + lane) * 4); \
        KV = *(const u32x2*)(ubn + 6144 + ((trS * 4 + tcS) * 64 + lane) * 4); \
        DC = *(const f32x4*)(dp0 + (size_t)n4 * 32 + 16 * trS + 4 * q); \
        Z = *(const v4u*)(zp0 + (size_t)n4 * 64 * DINP); } while (0)
    v4u qdA, qdB, qdC, qdD, zA, zB, zC, zD; u32x2 o0A, o1A, kvA, o0B, o1B, kvB, o0C, o1C, kvC, o0D, o1D, kvD; f32x4 dcA, dcB, dcC, dcD;
    GLA_LOAD(0, qdA, o0A, o1A, kvA, dcA, zA); GLA_LOAD(1, qdB, o0B, o1B, kvB, dcB, zB); GLA_LOAD(2, qdC, o0C, o1C, kvC, dcC, zC); GLA_LOAD(3, qdD, o0D, o1D, kvD, dcD, zD);
    SYNC();
    int cur = 0;
#define GLA_ITER(n, QD, OI0, OI1, KV, DC, Z) do { \
        LAS bf16* Sc = St0 + cur * 2560; LAS bf16* Sn = St0 + (cur ^ 1) * 2560; LAS float* Of = Of0 + cur * 4352; \
        const bf16x8 qa = __builtin_bit_cast(bf16x8, QD); \
        const bf16x8 sb0 = LDF(Sc + (16 * tc0 + r) * 40 + q * 8), sb1 = LDF(Sc + (16 * tc0 + 16 + r) * 40 + q * 8); \
        const f32x4 z = (f32x4){0.f, 0.f, 0.f, 0.f}; \
        const f32x4 oa = MFMA16(qa, sb0, z), ob = MFMA16(qa, sb1, z); \
        { float f0[4], f1[4]; unpack4(OI0, f0); unpack4(OI1, f1); \
          _Pragma("unroll") for (int i = 0; i < 4; ++i) { Of[(16 * tr + q * 4 + i) * 68 + 16 * tc0 + r] = oa[i] + f0[i]; Of[(16 * tr + q * 4 + i) * 68 + 16 * tc0 + 16 + r] = ob[i] + f1[i]; } } \
        { float kf[4]; unpack4(KV, kf); _Pragma("unroll") for (int i = 0; i < 4; ++i) sreg[i] = DC[i] * sreg[i] + kf[i]; \
          *(LAS u32x2*)(Sn + (16 * tcS + r) * 40 + 16 * trS + q * 4) = pack4(sreg[0], sreg[1], sreg[2], sreg[3]); } \
        SYNC(); \
        { float o[8]; const f32x4 p0 = *(const LAS f32x4*)(Of + t * 68 + part * 8), p1 = *(const LAS f32x4*)(Of + t * 68 + part * 8 + 4); \
          o[0] = p0.x; o[1] = p0.y; o[2] = p0.z; o[3] = p0.w; o[4] = p1.x; o[5] = p1.y; o[6] = p1.z; o[7] = p1.w; \
          float ss = 0.f; _Pragma("unroll") for (int i = 0; i < 8; ++i) ss += o[i] * o[i]; \
          ss = dpp_sum8(ss); const float rstd = frsq(ss * (1.0f / 64.0f) + EPS); \
          float zf[8]; unpack8(Z, zf); _Pragma("unroll") for (int i = 0; i < 8; ++i) o[i] = o[i] * rstd * nwv[i] * silu(zf[i]); \
          *(v4u*)(merged + ((size_t)b * SEQ + (size_t)(n) * 64 + t) * D + h * 64 + part * 8) = pack8(o); } \
        GLA_LOAD((n) + 4, QD, OI0, OI1, KV, DC, Z); \
        cur ^= 1; } while (0)
    for (int n = 0; n < NCHUNK; n += 4) {
        GLA_ITER(n, qdA, o0A, o1A, kvA, dcA, zA); GLA_ITER(n + 1, qdB, o0B, o1B, kvB, dcB, zB); GLA_ITER(n + 2, qdC, o0C, o1C, kvC, dcC, zC); GLA_ITER(n + 3, qdD, o0D, o1D, kvD, dcD, zD);
    }
#undef GLA_ITER
#undef GLA_LOAD
    SYNC();
}

template <bool PASSB> DI void lru_units(const Ctx& X, int first, int stride, const bf16* proj, const float* convw, const float* convb, const float* wa, const float* ba, const float* wx, const float* bx, const float* lam, unsigned char* ws, bf16* merged) {
    LAS bf16* WAt = (LAS bf16*)(X.lds + 0); LAS bf16* WXt = (LAS bf16*)(X.lds + 9216); LAS bf16* xrb = (LAS bf16*)(X.lds + 18432);
    LAS float* xrf = (LAS float*)(X.lds + 27648); LAS float* af = (LAS float*)(X.lds + 44288); LAS float* uf = (LAS float*)(X.lds + 60928);
    LAS float* cws = (LAS float*)(X.lds + 77568);
    const int tid = X.tid, lane = X.lane, nb = first & 3;
    const int t = tid >> 3, part = tid & 7, r = lane & 15, q = lane >> 4, tr = X.wave >> 1;
    if (first >= NBATCH * NCHUNK * 4) return;
    for (int i = tid; i < 4096; i += NTHR) { const int j = i >> 6, k = i & 63; WAt[k * 72 + j] = (bf16)f2bf(wa[(size_t)nb * 4096 + i]); WXt[k * 72 + j] = (bf16)f2bf(wx[(size_t)nb * 4096 + i]); }
    if (tid < 320) cws[tid] = tid < 256 ? convw[(tid >> 6) * 256 + nb * 64 + (tid & 63)] : convb[nb * 64 + (tid & 63)];
    float bav[2], bxv[2], spv[2];
#pragma unroll
    for (int e = 0; e < 2; ++e) { const int ch = nb * 64 + 16 * ((X.wave & 1) * 2 + e) + r; bav[e] = ba[ch]; bxv[e] = bx[ch]; spv[e] = softplus(-lam[ch]); }
    float* carry = (float*)(ws + WS_LRUC);
    LAS float* segA = (LAS float*)(X.lds + 78848); LAS float* segH = segA + 512;
#define LRU_LOAD(u_, XV, LG) do { const int uu = (u_) < NBATCH * NCHUNK * 4 ? (u_) : first; const int b_ = uu >> 8, n_ = (uu >> 2) & 63; \
        _Pragma("unroll") for (int j = 0; j < 4; ++j) { const int tt = n_ * 64 + t - 3 + j; XV[j] = *(const v4u*)(proj + ((size_t)b_ * SEQ + (tt < 0 ? 0 : tt)) * DINP + C_LX + nb * 64 + part * 8); } \
        if (PASSB) LG = *(const v4u*)(proj + ((size_t)b_ * SEQ + n_ * 64 + t) * DINP + C_LG + nb * 64 + part * 8); } while (0)
    v4u xv[4], xn[4], lg8 = (v4u){0u, 0u, 0u, 0u}, lgn = (v4u){0u, 0u, 0u, 0u};
    LRU_LOAD(first, xv, lg8);
    SYNC();
    for (int u = first; u < NBATCH * NCHUNK * 4; u += stride) {
        const int b = u >> 8, n = (u >> 2) & 63;
        const size_t row = (size_t)b * SEQ + (size_t)n * 64 + t;
        LRU_LOAD(u + stride, xn, lgn);
        float hreg = 0.f;
        if (PASSB) {
            const float* cp = carry + ((size_t)(b * 64) * 4 + nb) * 128 + lane; float ca[8], ch[8];
#pragma unroll
            for (int j = 0; j < 8; ++j) { const int m = 8 * X.wave + j; const bool ok = m < n; ca[j] = ok ? cp[(size_t)m * 512] : 1.0f; ch[j] = ok ? cp[(size_t)m * 512 + 64] : 0.0f; }
            float fa = 1.f, fh = 0.f;
#pragma unroll
            for (int j = 0; j < 8; ++j) { fh = ca[j] * fh + ch[j]; fa *= ca[j]; }
            segA[X.wave * 64 + lane] = fa; segH[X.wave * 64 + lane] = fh;
        }
        { float y[8];
#pragma unroll
            for (int i = 0; i < 8; ++i) y[i] = cws[256 + part * 8 + i];
#pragma unroll
            for (int j = 0; j < 4; ++j) { const int tt = n * 64 + t - 3 + j; const float msk = tt >= 0 ? 1.0f : 0.0f; float xf[8]; unpack8(xv[j], xf);
#pragma unroll
                for (int i = 0; i < 8; ++i) y[i] += cws[j * 64 + part * 8 + i] * (xf[i] * msk); }
#pragma unroll
            for (int i = 0; i < 8; ++i) xrf[t * 65 + part * 8 + i] = y[i];
            *(LAS v4u*)(xrb + t * 72 + part * 8) = pack8(y); }
        SYNC();
        { const f32x4 z = (f32x4){0.f, 0.f, 0.f, 0.f};
#pragma unroll
            for (int e = 0; e < 2; ++e) { const int tc = (X.wave & 1) * 2 + e, ch = 16 * tc + r;
                const f32x4 ar = mm16<64>(xrb + 16 * tr * 72, 72, WAt + 16 * tc * 72, 72, z, lane);
                const f32x4 ai = mm16<64>(xrb + 16 * tr * 72, 72, WXt + 16 * tc * 72, 72, z, lane);
#pragma unroll
                for (int i = 0; i < 4; ++i) { const int tt = 16 * tr + q * 4 + i;
                    const float rr = sigm(ar[i] + bav[e]), ig = sigm(ai[i] + bxv[e]), lga = -8.0f * rr * spv[e];
                    af[tt * 65 + ch] = fexp(lga); uf[tt * 65 + ch] = __builtin_amdgcn_sqrtf(1.0f - fexp(2.0f * lga)) * ig * xrf[tt * 65 + ch]; } } }
        SYNC();
        if (X.wave == 7) {
            if (PASSB) {
#pragma unroll
                for (int g = 0; g < 8; ++g) hreg = segA[g * 64 + lane] * hreg + segH[g * 64 + lane];
#pragma unroll 8
                for (int tt = 0; tt < 64; ++tt) { hreg = af[tt * 65 + lane] * hreg + uf[tt * 65 + lane]; uf[tt * 65 + lane] = hreg; }
            } else { float pa = 1.f;
#pragma unroll 8
                for (int tt = 0; tt < 64; ++tt) { const float a = af[tt * 65 + lane]; hreg = a * hreg + uf[tt * 65 + lane]; pa *= a; }
                carry[(size_t)u * 128 + lane] = pa; carry[(size_t)u * 128 + 64 + lane] = hreg; }
        }
        SYNC();
        if (PASSB) { float gf[8], o[8]; unpack8(lg8, gf);
#pragma unroll
            for (int i = 0; i < 8; ++i) o[i] = uf[t * 65 + part * 8 + i] * gelu_tanh(gf[i]);
            *(v4u*)(merged + row * D + 384 + nb * 64 + part * 8) = pack8(o); }
#pragma unroll
        for (int j = 0; j < 4; ++j) xv[j] = xn[j];
        lg8 = lgn;
    }
#undef LRU_LOAD
    SYNC();
}
constexpr int TAIL_SLICES = MOE_DOWN_F8 ? 2 : 4;

constexpr int N_PHASES = 19;
constexpr int MOE_ITEMS = 3 * NEXP * 1792;
#ifndef REP_PROL
#define REP_PROL 1
#endif
#ifndef REP_NORM
#define REP_NORM 1
#endif
#ifndef REP_INPROJ
#define REP_INPROJ 1
#endif
#ifndef REP_PREP
#define REP_PREP 1
#endif
#ifndef REP_CHAIN
#define REP_CHAIN 1
#endif
#ifndef REP_FFNGU
#define REP_FFNGU 1
#endif
#ifndef REP_MOEGU
#define REP_MOEGU 1
#endif
#ifndef REP_MOEDN
#define REP_MOEDN 1
#endif
#ifndef STAGGER_TICKS
#define STAGGER_TICKS 0
#endif
#ifndef REP_OUTPROJ
#define REP_OUTPROJ 1
#endif
#ifndef REP_FFNDN
#define REP_FFNDN 1
#endif
#ifndef REP_COMBINE
#define REP_COMBINE 1
#endif
#ifndef REP_MOEDN_TAIL
#define REP_MOEDN_TAIL 1
#endif
#ifndef REP_DNP
#define REP_DNP 1
#endif
#ifndef REP_GLAP
#define REP_GLAP 1
#endif
#ifndef REP_LRUA
#define REP_LRUA 1
#endif
#ifndef REP_DNC
#define REP_DNC 1
#endif
#ifndef REP_GLAC
#define REP_GLAC 1
#endif
#ifndef REP_LRUB
#define REP_LRUB 1
#endif
#define REPEAT(n) for (int rep_ = 0; rep_ < (n); ++rep_)
struct Args { In in; float* out; unsigned char* ws; int ph_lo, ph_hi; };
__global__ void __launch_bounds__(NTHR, 2) hybrid_fwd(Args args) {
    extern __shared__ __attribute__((aligned(16))) unsigned char lds_raw[];
    Ctx X;
    const int wave_id = __builtin_amdgcn_readfirstlane((int)threadIdx.x >> 6);
#define MKCTX() do { int l_; asm volatile("v_mbcnt_lo_u32_b32 %0, -1, 0\n\tv_mbcnt_hi_u32_b32 %0, -1, %0" : "=v"(l_)); { GAS unsigned char* wsg_ = (GAS unsigned char*)args.ws; asm volatile("" : "+s"(wsg_)); ws = (unsigned char*)wsg_; } X.lds = (LAS unsigned char*)lds_raw; X.lane = l_; X.wave = wave_id; X.tid = wave_id * 64 + l_; \
        X.G = gridDim.x; { const int bx = blockIdx.x; X.vcu = (X.G % 8 == 0) ? (bx % 8) * (X.G / 8) + bx / 8 : bx; } X.gw = X.vcu * NWAVES + X.wave; X.NGW = X.G * NWAVES; } while (0)
    unsigned char* ws = args.ws;
    MKCTX();
    InT I; I.p.t = (const LAS unsigned long long*)(X.lds + PTR_OFF);
    gu32* ctl = (gu32*)(ws + WS_CTL);
    volatile LAS unsigned* MISC = (volatile LAS unsigned*)(X.lds + MISC_OFF);
    for (int u = X.tid; u < (LDS_BYTES - RING_BYTES) / 4; u += NTHR) ((LAS unsigned*)(X.lds + RING_BYTES))[u] = 0u;
#pragma unroll
    for (int k = 0; k < 30; ++k) if (X.tid == k) ((LAS unsigned long long*)(X.lds + PTR_OFF))[k] = (unsigned long long)args.in.p[k];
    __syncthreads();
#if MK_ONE_LAUNCH
    XcdBarrier bar = xcd_barrier_post((unsigned*)(ctl + CW_BAR), MISC + 8);
#define GRID_BAR() do { XcdBarrier b_ = bar; asm volatile("" : "+s"(b_.bar), "+s"(b_.x)); xcd_barrier(b_); } while (0)
#else
#define GRID_BAR() do {} while (0)
#endif
#if MK_ONE_LAUNCH
#define IN(k) true
#define SEAM(k) GRID_BAR()
#else
    const int lo = args.ph_lo, hi = args.ph_hi;
#define IN(k) (lo <= (k) && (k) < hi)
#define SEAM(k) do { if (IN(k) && IN((k) + 1)) GRID_BAR(); } while (0)
#endif
#define x_in (I.p[0])
#define xres ((bf16*)(ws + WS_XRES))
#define MOD ((float*)(ws + WS_MOD))
#define Hb ((bf16*)(ws + WS_H))
#define PROJ ((bf16*)(ws + WS_PROJ))
#define ring (X.lds)

    if (IN(0)) { MKCTX(); prologue_phase(X, I, ws); }
#if MK_ONE_LAUNCH
    { MKCTX(); mod_wait(X, ws); }
#endif
    if (IN(1)) { MKCTX(); REPEAT(REP_NORM) norm_phase<false, false>(X, x_in, I.p[18], MOD, 0, D, Hb, nullptr, ws); } SEAM(1);

    for (int L = 0; L < 2; ++L) {
        const int pb = 2 + 8 * L;
        const float* modL = MOD + (size_t)L * 8 * MODW;
        if (IN(pb)) { MKCTX();
            if (INPROJ1_F8 && L == 1) {
                pg8::Gemm g{Hb, (const bf16*)(ws + WS_WIN) + (size_t)DINP * D, T, DINP, D / 2, 0, 127 - 5, 127 - 10}; pg8::MoeOrder<true> S; S.init(T / 256, DINP, X.G, (int)blockIdx.x);
                S.tile_e = (LAS int*)(X.lds + TAB_OFF); S.list = nullptr; S.eB = 0;
                pg8::EpiStoreBf16F8 E{{PROJ, DINP}};
                pg8::gemm_phase<pg8::EpiStoreBf16F8, pg8::MoeOrder<true>, true>(ring, g, S, E, wave_id);
            } else {
            pg8::Gemm g{Hb, (const bf16*)(ws + WS_WIN) + (size_t)L * DINP * D, T, DINP, D}; pg8::StaticOrder S; S.init(T, DINP, X.G, (int)blockIdx.x);
            pg8::EpiStoreBf16 E{PROJ, DINP};
            REPEAT(REP_INPROJ) pg8::gemm_phase<pg8::EpiStoreBf16, pg8::StaticOrder, false>(ring, g, S, E, wave_id);
            }
            if (blockIdx.x >= 128) { MKCTX(); moe_convert(X, I, ws, L * 22000, L * 22000 + 8000, (int)blockIdx.x - 128, (int)X.G - 128); }
        } SEAM(pb);
        if (IN(pb + 1)) { MKCTX();
            {
                REPEAT(REP_DNP) dn_prep_phase(X, PROJ, I.p[13] + (size_t)L * 4 * 1152, I.p[14] + L * 6, I.p[15] + L * 6, ws, (bf16*)args.out);
                REPEAT(REP_GLAP) gla_prep_phase(X, PROJ, I.p[3] + (size_t)L * 16 * 192, I.p[4] + L * 192, ws);
                REPEAT(REP_LRUA) lru_units<false>(X, X.vcu, X.G, PROJ, I.p[6] + (size_t)L * 4 * 256, I.p[7] + L * 256, I.p[8] + (size_t)L * 4 * 4096, I.p[9] + L * 256, I.p[10] + (size_t)L * 4 * 4096, I.p[11] + L * 256, I.p[12] + L * 256, ws, Hb);
            }
        } SEAM(pb + 1);
        if (IN(pb + 2)) { MKCTX();
            REPEAT(REP_CHAIN) for (int ru = (int)blockIdx.x; ru < 256; ru += X.G) {
                if (ru < 48) { MKCTX(); REPEAT(REP_DNC) dn_chain(X, ru, PROJ, I.p[16] + L * 64, ws, (const bf16*)args.out, Hb); }
                else if (ru < 96) { MKCTX(); REPEAT(REP_GLAC) gla_chain(X, ru - 48, PROJ, I.p[5] + L * 64, ws, Hb); }
                else { MKCTX(); REPEAT(REP_LRUB) lru_units<true>(X, ru - 96, 160, PROJ, I.p[6] + (size_t)L * 4 * 256, I.p[7] + L * 256, I.p[8] + (size_t)L * 4 * 4096, I.p[9] + L * 256, I.p[10] + (size_t)L * 4 * 4096, I.p[11] + L * 256, I.p[12] + L * 256, ws, Hb);
                       MKCTX(); moe_convert(X, I, ws, L * 22000 + 8000, L == 0 ? 22000 : MOE_ITEMS, ru - 96, 160); }
            }
        } SEAM(pb + 2);
        if (IN(pb + 3)) { MKCTX();
            pg8::Gemm g{Hb, (const bf16*)(ws + WS_WOUT) + (size_t)L * D * D, T, D, D}; pg8::StaticOrder S; S.init(T, D, X.G, (int)blockIdx.x);
            if (L == 0) { pg8::EpiRes32 E{x_in, xres, xres, modL + 2 * D}; pg8::gemm_phase<pg8::EpiRes32, pg8::StaticOrder, true>(ring, g, S, E, wave_id); }
            else { pg8::EpiRes E{nullptr, xres, xres, modL + 2 * D}; pg8::gemm_phase<pg8::EpiRes, pg8::StaticOrder, true>(ring, g, S, E, wave_id); }
        } SEAM(pb + 3);
        if (L == 0) {
            if (IN(6)) { MKCTX(); REPEAT(REP_NORM) norm_phase<false, true, DENSE_GU_F8 != 0>(X, xres, I.p[19], modL, 3 * D, 4 * D, Hb, nullptr, ws); } SEAM(6);
            if (IN(7)) { MKCTX();
#if DENSE_GU_F8
                pg8::Gemm g{Hb, (const bf16*)(ws + WS_WGU), T, 2 * DFF, D / 2, 0, 127 - 5, 127 - 10}; pg8::MoeOrder<true> S; S.init(T / 256, 2 * DFF, X.G, (int)blockIdx.x);
                S.tile_e = (LAS int*)(X.lds + TAB_OFF); S.list = nullptr; S.eB = 0;
#if DENSE_DN_F8
                pg8::EpiSwiglu8 E{PROJ, DFF};
                REPEAT(REP_FFNGU) pg8::gemm_phase<pg8::EpiSwiglu8, pg8::MoeOrder<true>, true>(ring, g, S, E, wave_id);
#else
                pg8::EpiSwigluB E{{PROJ, DFF}};
                REPEAT(REP_FFNGU) pg8::gemm_phase<pg8::EpiSwigluB, pg8::MoeOrder<true>, true>(ring, g, S, E, wave_id);
#endif
#else
                pg8::Gemm g{Hb, (const bf16*)(ws + WS_WGU), T, 2 * DFF, D}; pg8::StaticOrder S; S.init(T, 2 * DFF, X.G, (int)blockIdx.x);
#if DENSE_DN_F8
                pg8::EpiSwigluTo8 E{PROJ, DFF};
                REPEAT(REP_FFNGU) pg8::gemm_phase<pg8::EpiSwigluTo8, pg8::StaticOrder, true>(ring, g, S, E, wave_id);
#else
                pg8::EpiSwiglu E{PROJ, DFF};
                REPEAT(REP_FFNGU) pg8::gemm_phase<pg8::EpiSwiglu, pg8::StaticOrder, true>(ring, g, S, E, wave_id);
#endif
#endif
            } SEAM(7);
            if (IN(8)) { MKCTX();
#if DENSE_DN_F8
                pg8::Gemm g{PROJ, (const bf16*)(ws + WS_WDN), T, D, DFF / 2, 0, 127 - 3, 127 - 11}; pg8::MoeOrder<true> S; S.init(T / 256, D, X.G, (int)blockIdx.x);
                S.tile_e = (LAS int*)(X.lds + TAB_OFF); S.list = nullptr; S.eB = 0;
                pg8::EpiRes8 E{nullptr, xres, xres, modL + 5 * D};
                pg8::gemm_phase<pg8::EpiRes8, pg8::MoeOrder<true>, true>(ring, g, S, E, wave_id);
#else
                pg8::Gemm g{PROJ, (const bf16*)(ws + WS_WDN), T, D, DFF}; pg8::StaticOrder S; S.init(T, D, X.G, (int)blockIdx.x);
                pg8::EpiRes E{nullptr, xres, xres, modL + 5 * D};
                pg8::gemm_phase<pg8::EpiRes, pg8::StaticOrder, true>(ring, g, S, E, wave_id);
#endif
            } SEAM(8);
            if (IN(9)) { MKCTX(); REPEAT(REP_NORM) norm_phase<false, true, INPROJ1_F8 != 0>(X, xres, I.p[18] + D, MOD + (size_t)8 * MODW, 0, D, Hb, nullptr, ws); } SEAM(9);
        }
    }
    if (IN(14)) { MKCTX(); REPEAT(REP_NORM) norm_phase<true, true>(X, xres, I.p[19] + D, MOD + (size_t)8 * MODW, 3 * D, 4 * D, Hb, I.p[25], ws); } SEAM(14);
    if (IN(15)) { MKCTX(); moe_list_phase(X, ws); } SEAM(15);
    {
        LAS int* tab = (LAS int*)(X.lds + TAB_OFF);
        if (IN(16) || IN(17)) { __syncthreads(); if (X.tid < TILE_TAB) tab[X.tid] = ((const int*)(ws + WS_TILES))[X.tid]; __syncthreads(); }
        const int nM0 = __builtin_amdgcn_readfirstlane(tab[TILE_TAB - 2]), nM = __builtin_amdgcn_readfirstlane(tab[TILE_TAB - 1]);
        const int* list = (const int*)(ws + WS_LIST); const float* roww = (const float*)(ws + WS_ROWW);
        if (IN(16)) { MKCTX();
            pg8::Gemm g{Hb, (const bf16*)(ws + WS_MOEGU), 2 * MOE_ROWS, 2 * DFFE, D / 2, 0, 127 - 5, 127 - 10}; pg8::MoeOrder<true> S; S.init(nM, 2 * DFFE, X.G, (int)blockIdx.x);
            S.tile_e = tab; S.list = list; S.eB = (size_t)2 * DFFE * D; S.rowtab = (LAS int*)(X.lds + ROWTAB_OFF);
            pg8::EpiSwiglu8 E{PROJ, DFFE};
            REPEAT(REP_MOEGU) pg8::gemm_phase<pg8::EpiSwiglu8, pg8::MoeOrder<true>, true>(ring, g, S, E, wave_id);
        } SEAM(16);
        if (IN(17)) { MKCTX();
            pg8::MoeOrder<true> S; S.init(nM, D, X.G, (int)blockIdx.x);
            S.tile_e = tab; S.list = nullptr; S.eB = (size_t)D * DFFE;
            pg8::Gemm g{PROJ, (const bf16*)(ws + WS_MOEDN), 2 * MOE_ROWS, D, DFFE / 2, 0, 127 - 3, 127 - 11};
            pg8::EpiMoeDown E{(bf16*)(ws + WS_Y0), Hb, nM0 * 256, list, roww};
            pg8::gemm_phase<pg8::EpiMoeDown, pg8::MoeOrder<true>, true>(ring, g, S, E, wave_id);
        } SEAM(17);
    }
    if (IN(18)) { MKCTX(); final_norm_phase(X, xres, (const bf16*)(ws + WS_Y0), Hb, MOD + (size_t)8 * MODW + 5 * D, I.p[29], args.out); }
#undef IN
#undef SEAM
#undef x_in
#undef xres
#undef MOD
#undef Hb
#undef PROJ
#undef ring
}

extern "C" void kernel_launch(void* const* d_in, const int* in_sizes, int n_in, void* d_out, int out_size, void* d_ws, size_t ws_size, hipStream_t stream) {
    static int grid = 0;
    if (grid == 0) {
        if (n_in != 30 || in_sizes[0] != T * D || out_size != T * D || ws_size < WS_END) { fprintf(stderr, "kernel_launch: unexpected shapes (n_in %d, in0 %d, out %d, ws %zu); nothing launched\n", n_in, n_in > 0 ? in_sizes[0] : -1, out_size, ws_size); grid = -1; return; }
        int dev = 0, cus = 0;
        if (hipGetDevice(&dev) != hipSuccess || hipDeviceGetAttribute(&cus, hipDeviceAttributeMultiprocessorCount, dev) != hipSuccess) { fprintf(stderr, "kernel_launch: device query failed\n"); grid = -1; return; }
        if (hipFuncSetAttribute((const void*)hybrid_fwd, hipFuncAttributeMaxDynamicSharedMemorySize, LDS_BYTES) != hipSuccess) { fprintf(stderr, "kernel_launch: hipFuncSetAttribute failed\n"); grid = -1; return; }
        int per_cu = 0;
        if (hipOccupancyMaxActiveBlocksPerMultiprocessor(&per_cu, (const void*)hybrid_fwd, NTHR, LDS_BYTES) != hipSuccess || per_cu < 1) fprintf(stderr, "kernel_launch: note: occupancy query reports %d workgroups per CU\n", per_cu);
        (void)hipGetLastError();
        grid = cus;
    }
    if (grid < 0) return;
    if (hipMemsetAsync((char*)d_ws + WS_CTL, 0, CTL_ZERO_BYTES, stream) != hipSuccess) { fprintf(stderr, "kernel_launch: memset failed\n"); return; }
    Args a{};
    for (int i = 0; i < 30; ++i) a.in.p[i] = (const float*)d_in[i];
    a.out = (float*)d_out; a.ws = (unsigned char*)d_ws;
#if MK_ONE_LAUNCH
    a.ph_lo = 0; a.ph_hi = N_PHASES;
    hipLaunchKernelGGL(hybrid_fwd, dim3(grid), dim3(NTHR), LDS_BYTES, stream, a);
#else
    for (int k = 0; k < N_PHASES; ++k) { a.ph_lo = k; a.ph_hi = k + 1; hipLaunchKernelGGL(hybrid_fwd, dim3(grid), dim3(NTHR), LDS_BYTES, stream, a); }
#endif
    const hipError_t le = hipPeekAtLastError();
    if (le != hipSuccess) fprintf(stderr, "kernel_launch: launch failed: %s\n", hipGetErrorName(le));
}
```

```cpp
#include <hip/hip_runtime.h>
#include <cstdio>
#include <cstdint>

#ifndef MK_ONE_LAUNCH
#define MK_ONE_LAUNCH 1
#endif

namespace pg8 {
#define PG8_LAS __attribute__((address_space(3)))
typedef unsigned short bf16_t;
typedef short bf16x8 __attribute__((ext_vector_type(8)));
typedef float f32x4 __attribute__((ext_vector_type(4)));
typedef unsigned u32x4 __attribute__((ext_vector_type(4)));
typedef int i32x4 __attribute__((ext_vector_type(4)));
constexpr int BM = 256, BK = 64, HALF = 128, HTB = HALF * BK * 2  , STAGE_BYTES = 8 * HTB, NXCD = 8, WGM = 8;

__host__ __device__ __forceinline__ int lds_byte(int r, int c) { const int st = (r >> 4) * 2 + (c >> 5), rr = r & 15, cc = c & 31, ob = rr * 64 + cc * 2; return st * 1024 + (ob ^ (((ob >> 9) & 1) << 5)); }
__host__ __device__ __forceinline__ void stage_rc(int b, int& R, int& C) { const int st = b / 1024, sb = b % 1024, swz = sb ^ (((sb >> 9) & 1) << 5); R = (st >> 1) * 16 + swz / 64; C = (st & 1) * 32 + (swz % 64) / 2; }
__host__ __device__ __forceinline__ int perm32(int rho) { const int n = rho >> 4, i = rho & 15; return 8 * (i >> 2) + 4 * n + (i & 3); }

struct Unit { int pm, pn, ks, sub; };
struct Gemm { const bf16_t* A; const bf16_t* Bt; int M, N, K; int ld = 0; int scA = 127, scB = 127; };

struct StaticOrder {
    static constexpr bool GATHER = false;
    int nM, nN, nwg, G, c;
    __host__ __device__ void init(int M, int N, int G_, int c_) { nM = M / BM; nN = N / BM; nwg = nM * nN; G = G_; c = c_; }
    __host__ __device__ bool next(int i, Unit& u) const {
        const long L = (long)i * G + c; if (L >= nwg) return false;
        int wgid = (int)L; { const int q = nwg / NXCD, r = nwg % NXCD, xcd = wgid % NXCD, off = wgid / NXCD; wgid = (xcd < r ? xcd * (q + 1) : r * (q + 1) + (xcd - r) * q) + off; }
        const int nig = WGM * nN, gid = wgid / nig, fm = gid * WGM, gsz = (nM - fm) < WGM ? (nM - fm) : WGM;
        u.pm = fm + ((wgid % nig) % gsz); u.pn = (wgid % nig) / gsz; u.ks = 0; u.sub = 0; return true;
    }
    __device__ __forceinline__ const char* b_base(const Gemm& g, const Unit& u, size_t tstep) const { return (const char*)g.Bt + (size_t)u.pn * tstep; }
    __device__ __forceinline__ int row_of(const Unit&, int r) const { return r; }
    __device__ __forceinline__ bool rowtab_ok() const { return false; }
    __device__ __forceinline__ const int* rows_ptr(const Unit&) const { return nullptr; }
    PG8_LAS int* rowtab;
};

typedef float cv_f32x2_t __attribute__((ext_vector_type(2)));
typedef __bf16 cv_bf16x2_t __attribute__((ext_vector_type(2)));
__device__ __forceinline__ unsigned cvt_pk_bf16(float lo, float hi) { const cv_f32x2_t v = {lo, hi}; const cv_bf16x2_t b = __builtin_convertvector(v, cv_bf16x2_t); return __builtin_bit_cast(unsigned, b); }

template <class Epi, class Sched, bool ALIGN_EPI>
__device__ __forceinline__ void gemm_phase(PG8_LAS unsigned char* lds, const Gemm g, const Sched& S, const Epi& E, const int wid_in) {
    constexpr bool GA = Sched::GATHER;
    int lane_; asm volatile("v_mbcnt_lo_u32_b32 %0, -1, 0\n\tv_mbcnt_hi_u32_b32 %0, -1, %0" : "=v"(lane_));
    int wid_ = wid_in; asm volatile("" : "+s"(wid_));
    const int wid = wid_, lane = lane_, tid = wid * 64 + lane, wr = wid >> 2, wc = wid & 3, fr = lane & 15, fq = lane >> 4;
    const int K = g.ld ? g.ld : g.K, nt = g.K / BK;
    unsigned voffA, voffB;
    { int R, C; stage_rc(tid * 16, R, C); const int Rb = Epi::PERM ? ((R & ~31) + perm32(R & 31)) : R; voffA = (unsigned)(R * K + C) * 2u; voffB = (unsigned)(Rb * K + C) * 2u; }
    const size_t rstep = (size_t)64 * K * 2;
    const int scA = g.scA, scB = g.scB;
    unsigned vAc[2][2];
#define PG8_GATHER_ROWS(U) do { _Pragma("unroll") for (int _h = 0; _h < 2; ++_h) _Pragma("unroll") for (int _i = 0; _i < 2; ++_i) { int _R, _C; stage_rc(tid * 16 + _i * 8192, _R, _C); \
        vAc[_h][_i] = (unsigned)(S.row_of(U, _h * HALF + _R) * K + _C) * 2u; } } while (0)
    const size_t kstep = (size_t)(BK * 2);
    const size_t hstep = (size_t)HALF * K * 2;
    const size_t tstep = 2 * hstep;
    const unsigned ldsw = (unsigned)wid * 1024u;
    const int aoff = lds_byte(wr * 64 + fr, fq * 8), boff = lds_byte(wc * 32 + fr, fq * 8);
#define PG8_SA(b, h) (((b) * 2 + (h)) * HTB)
#define PG8_SB(b, h) ((4 + (b) * 2 + (h)) * HTB)
#define PG8_STAGE(bufoff, gbase, voff) do { _Pragma("unroll") for (int _i = 0; _i < 2; ++_i) \
        __builtin_amdgcn_global_load_lds((const unsigned*)((const char*)(gbase) + _i * rstep + (voff)), (PG8_LAS unsigned*)(lds + (bufoff) + ldsw + _i * 8192), 16, 0, 0); } while (0)
#define PG8_STA(bufoff, kb, h, nx) do { if constexpr (GA) { _Pragma("unroll") for (int _i = 0; _i < 2; ++_i) \
        __builtin_amdgcn_global_load_lds((const unsigned*)((const char*)(kb) + vAc[h][_i]), (PG8_LAS unsigned*)(lds + (bufoff) + ldsw + _i * 8192), 16, 0, 0); } \
        else { PG8_STAGE(bufoff, (kb) + (h) * hstep, voffA); } } while (0)
#define PG8_LDA(dst, b, h) do { _Pragma("unroll") for (int m = 0; m < 4; ++m) _Pragma("unroll") for (int k = 0; k < 2; ++k) dst[m][k] = *(const PG8_LAS bf16x8*)(lds + PG8_SA(b, h) + aoff + m * 2048 + k * 1024); } while (0)
#define PG8_LDB(dst, b, h) do { _Pragma("unroll") for (int n = 0; n < 2; ++n) _Pragma("unroll") for (int k = 0; k < 2; ++k) dst[n][k] = *(const PG8_LAS bf16x8*)(lds + PG8_SB(b, h) + boff + n * 2048 + k * 1024); } while (0)
#define PG8_CAT8(lo, hi) __builtin_shufflevector(__builtin_bit_cast(i32x4, lo), __builtin_bit_cast(i32x4, hi), 0, 1, 2, 3, 4, 5, 6, 7)
#define PG8_MMA(ai, bj, At, Bt, Z) do { __builtin_amdgcn_s_setprio(1); _Pragma("unroll") for (int m = 0; m < 4; ++m) _Pragma("unroll") for (int n = 0; n < 2; ++n) { \
        if constexpr (Epi::F8) acc[ai][bj][m][n] = __builtin_amdgcn_mfma_scale_f32_16x16x128_f8f6f4(PG8_CAT8(Bt[n][0], Bt[n][1]), PG8_CAT8(At[m][0], At[m][1]), (Z) ? (f32x4){0.f, 0.f, 0.f, 0.f} : acc[ai][bj][m][n], 0, 0, 0, scB, 0, scA); \
        else { _Pragma("unroll") for (int k = 0; k < 2; ++k) acc[ai][bj][m][n] = __builtin_amdgcn_mfma_f32_16x16x32_bf16(Bt[n][k], At[m][k], ((Z) && k == 0) ? (f32x4){0.f, 0.f, 0.f, 0.f} : acc[ai][bj][m][n], 0, 0, 0); } } __builtin_amdgcn_s_setprio(0); } while (0)
#define PG8_WAIT_V(n) asm volatile("s_waitcnt vmcnt(" #n ")" ::: "memory")
#define PG8_WAIT_L(n) asm volatile("s_waitcnt lgkmcnt(" #n ")" ::: "memory")
#define PG8_BAR __builtin_amdgcn_s_barrier()
#define PG8_SCHED __builtin_amdgcn_sched_barrier(0)
#define PG8_KITER(T_, Z_) do { \
            const bool last = ((T_) == nt - 2); \
            const char* a1 = cA + (size_t)((T_) + 1) * kstep; \
            const char* a2 = last ? nA : cA + (size_t)((T_) + 2) * kstep; const char* b2 = last ? nB : cB + (size_t)((T_) + 2) * kstep; \
            const char* a3 = a2 + kstep; const char* b3 = b2 + kstep; \
            PG8_LDB(B0, 0, 0); PG8_LDB(B1, 0, 1); PG8_SCHED; PG8_LDA(At, 0, 0); PG8_STA(PG8_SA(1, 1), a1, 1, false); \
            if constexpr (GA) { if (last && has_next) { \
            if (S.rowtab_ok()) { \
            _Pragma("unroll") \
            for (int _h = 0; _h < 2; ++_h) \
            _Pragma("unroll") \
            for (int _i = 0; _i < 2; ++_i) { int _R, _C; stage_rc(tid * 16 + _i * 8192, _R, _C); const int tok_ = ((volatile PG8_LAS int*)S.rowtab)[_h * HALF + _R]; \
            vAc[_h][_i] = (unsigned)((tok_ < 0 ? 0 : tok_) * K + _C) * 2u; } \
            } else PG8_GATHER_ROWS(nxt); } } \
            PG8_WAIT_V(8); PG8_WAIT_L(0); PG8_BAR; PG8_MMA(0, 0, At, B0, Z_); PG8_MMA(0, 1, At, B1, Z_); PG8_BAR; PG8_SCHED; \
            PG8_LDA(At, 0, 1); PG8_STAGE(PG8_SB(0, 0), b2, voffB); PG8_STAGE(PG8_SB(0, 1), b2 + hstep, voffB); PG8_STA(PG8_SA(0, 0), a2, 0, last); \
            PG8_WAIT_V(8); PG8_WAIT_L(0); PG8_BAR; PG8_MMA(1, 0, At, B0, Z_); PG8_MMA(1, 1, At, B1, Z_); PG8_BAR; PG8_SCHED; \
            PG8_LDB(B0, 1, 0); PG8_LDB(B1, 1, 1); PG8_SCHED; PG8_LDA(At, 1, 0); PG8_STA(PG8_SA(0, 1), a2, 1, last); \
            PG8_WAIT_V(8); PG8_WAIT_L(0); PG8_BAR; PG8_MMA(0, 0, At, B0, false); PG8_MMA(0, 1, At, B1, false); PG8_BAR; PG8_SCHED; \
            PG8_LDA(At, 1, 1); PG8_STAGE(PG8_SB(1, 0), b3, voffB); PG8_STAGE(PG8_SB(1, 1), b3 + hstep, voffB); PG8_STA(PG8_SA(1, 0), a3, 0, last); \
            PG8_WAIT_V(8); PG8_WAIT_L(0); PG8_BAR; PG8_MMA(1, 0, At, B0, false); PG8_MMA(1, 1, At, B1, false); PG8_BAR; PG8_SCHED; \
        } while (0)
    Unit cur, nxt; int ui = 0;
    if (!S.next(0, cur)) return;
    constexpr bool PEEL = !Epi::F8;
    f32x4 acc[2][2][4][2];
#define PG8_ZERO_ACC() do { _Pragma("unroll") for (int a = 0; a < 2; ++a) _Pragma("unroll") for (int b = 0; b < 2; ++b) _Pragma("unroll") for (int m = 0; m < 4; ++m) _Pragma("unroll") for (int n = 0; n < 2; ++n) acc[a][b][m][n] = (f32x4){0.f, 0.f, 0.f, 0.f}; } while (0)
    if constexpr (!PEEL) PG8_ZERO_ACC();
    bf16x8 At[4][2], B0[2][2], B1[2][2];
    const char* cA = (GA ? (const char*)g.A : (const char*)g.A + (size_t)cur.pm * tstep) + (size_t)cur.ks * 2; const char* cB = S.b_base(g, cur, tstep) + (size_t)cur.ks * 2;
    if constexpr (GA) PG8_GATHER_ROWS(cur);
    PG8_STAGE(PG8_SB(0, 0), cB, voffB); PG8_STAGE(PG8_SB(0, 1), cB + hstep, voffB); PG8_STA(PG8_SA(0, 0), cA, 0, false); PG8_STA(PG8_SA(0, 1), cA, 1, false);
    if (wr == 1) PG8_BAR;
    PG8_WAIT_V(2); PG8_BAR;
    PG8_STAGE(PG8_SB(1, 0), cB + kstep, voffB); PG8_STA(PG8_SA(1, 0), cA + kstep, 0, false); PG8_STAGE(PG8_SB(1, 1), cB + hstep + kstep, voffB);
    PG8_WAIT_V(6); PG8_BAR;
    for (;;) {
        const bool has_next = S.next(ui + 1, nxt);
        if constexpr (GA) { if (has_next && S.rowtab_ok() && wid == 0)
            __builtin_amdgcn_global_load_lds((const unsigned*)(S.rows_ptr(nxt) + lane * 4), (PG8_LAS unsigned*)S.rowtab, 16, 0, 0); }
        const char* nA = has_next ? (GA ? (const char*)g.A : (const char*)g.A + (size_t)nxt.pm * tstep) + (size_t)nxt.ks * 2 : cA; const char* nB = has_next ? S.b_base(g, nxt, tstep) + (size_t)nxt.ks * 2 : cB;
        if constexpr (PEEL) { PG8_KITER(0, true); for (int t = 2; t < nt; t += 2) PG8_KITER(t, false); }
        else { for (int t = 0; t < nt; t += 2) PG8_KITER(t, false); }
        if constexpr (ALIGN_EPI) { if (wr == 0) PG8_BAR; }
        { int le_; asm volatile("v_mbcnt_lo_u32_b32 %0, -1, 0\n\tv_mbcnt_hi_u32_b32 %0, -1, %0" : "=v"(le_));
          E(acc, cur, wr, wc, le_ & 15, le_ >> 4); }
        if (!has_next) break;
        if constexpr (!PEEL) PG8_ZERO_ACC();
        cur = nxt; cA = nA; cB = nB; ++ui;
        if constexpr (ALIGN_EPI) { if (wr == 1) PG8_BAR; }
    }
    PG8_WAIT_V(0);
    if constexpr (!ALIGN_EPI) { if (wr == 0) PG8_BAR; }
    PG8_BAR;
#undef PG8_SA
#undef PG8_SB
#undef PG8_STAGE
#undef PG8_STA
#undef PG8_GATHER_ROWS
#undef PG8_LDA
#undef PG8_LDB
#undef PG8_MMA
#undef PG8_KITER
#undef PG8_ZERO_ACC
#undef PG8_CAT8
#undef PG8_WAIT_V
#undef PG8_WAIT_L
#undef PG8_BAR
#undef PG8_SCHED
}
}
#define GAS __attribute__((address_space(1)))
#define LAS __attribute__((address_space(3)))
typedef unsigned short bf16;
typedef unsigned v4u __attribute__((ext_vector_type(4)));
typedef float f32x4 __attribute__((ext_vector_type(4)));
typedef short bf16x8 __attribute__((ext_vector_type(8)));
typedef GAS unsigned gu32;
typedef GAS unsigned long long gu64;
#define RLX_AGENT __ATOMIC_RELAXED, __HIP_MEMORY_SCOPE_AGENT
#define LDS_WAIT() asm volatile("s_waitcnt lgkmcnt(0)" ::: "memory")
#define VM_WAIT() asm volatile("s_waitcnt vmcnt(0)" ::: "memory")
__device__ __forceinline__ unsigned long long rt() { return __builtin_amdgcn_s_memrealtime(); }
__device__ __forceinline__ unsigned f2bf(float f) { return (unsigned)__builtin_bit_cast(unsigned short, (__bf16)f); }
typedef float pk_f32x2_t __attribute__((ext_vector_type(2)));
typedef __bf16 pk_bf16x2_t __attribute__((ext_vector_type(2)));
__device__ __forceinline__ unsigned pk2(float lo, float hi) { const pk_f32x2_t v = {lo, hi}; const pk_bf16x2_t b = __builtin_convertvector(v, pk_bf16x2_t); return __builtin_bit_cast(unsigned, b); }
#define XB_TMO      128
#define XB_XCNT(j)  (256  + 64 * (j))
#define XB_XSUB(j)  (1280 + 64 * (j))
#define XB_XGEN(j)  (2304 + 64 * (j))
#define XB_TOP      3328
#define XB_TOPGEN   3392
#define XCD_BAR_WORDS 3456
#define XB_SPIN_CAP (1u << 18)

__device__ __forceinline__ unsigned xb_ld(unsigned* p)              { return __hip_atomic_load(p, __ATOMIC_RELAXED, __HIP_MEMORY_SCOPE_AGENT); }
__device__ __forceinline__ unsigned xb_add(unsigned* p, unsigned v) { return __hip_atomic_fetch_add(p, v, __ATOMIC_RELAXED, __HIP_MEMORY_SCOPE_AGENT); }
__device__ __forceinline__ unsigned xb_xcc_id() { return (unsigned)__builtin_amdgcn_s_getreg((3 << 11) | 20) & 0xFu; }
#define XB_SPIN(cond, bar) do { unsigned _sp = 0; while (cond) { __builtin_amdgcn_s_sleep(1); \
    if ((++_sp & 255u) == 0u) { if (xb_ld(&(bar)[XB_TMO])) break; if (_sp > XB_SPIN_CAP) { atomicAdd(&(bar)[XB_TMO], 1u); break; } } } } while (0)

struct XcdBarrier {
    unsigned* bar; unsigned x;
    volatile LAS unsigned* st;
};

__device__ __forceinline__ XcdBarrier xcd_barrier_post(unsigned* bar, volatile LAS unsigned* st) {
    XcdBarrier b; b.bar = bar; b.x = xb_xcc_id(); b.st = st;
    if (threadIdx.x == 0) (void)xb_add(&bar[XB_XCNT(b.x)], 1u);
    return b;
}
__device__ __forceinline__ void xcd_barrier_complete(unsigned* bar, unsigned x, unsigned& nloc, unsigned& nx) {
    const unsigned G = gridDim.x * gridDim.y * gridDim.z;
    unsigned sum, cnt, mine, sp = 0u;
    for (;;) {
        sum = 0u; cnt = 0u; mine = 0u;
#pragma unroll
        for (unsigned j = 0; j < 16; ++j) { const unsigned c = xb_ld(&bar[XB_XCNT(j)]); sum += c; cnt += (c > 0u) ? 1u : 0u; mine = (j == x) ? c : mine; }
        if (sum == G) break;
        __builtin_amdgcn_s_sleep(1);
        if ((++sp & 255u) == 0u) { if (xb_ld(&bar[XB_TMO])) break; if (sp > XB_SPIN_CAP) { atomicAdd(&bar[XB_TMO], 1u); break; } }
    }
    nloc = mine > 0u ? mine : 1u; nx = cnt > 0u ? cnt : 1u;
}

__device__ __forceinline__ void xcd_barrier(const XcdBarrier& b) {
    asm volatile("s_waitcnt vmcnt(0)" ::: "memory");
    __syncthreads();
    if (threadIdx.x == 0) {
        unsigned* bar = b.bar;
        __builtin_amdgcn_s_waitcnt(0);
        unsigned nloc = b.st[0], nx = b.st[1];
        if (nloc == 0u) { xcd_barrier_complete(bar, b.x, nloc, nx); b.st[0] = nloc; b.st[1] = nx; }
        const unsigned old = xb_add(&bar[XB_XSUB(b.x)], 1u);
        const unsigned gen = old / nloc;
        if (old + 1u == (gen + 1u) * nloc) {
            __builtin_amdgcn_fence(__ATOMIC_RELEASE, "agent");
            asm volatile("s_waitcnt vmcnt(0)" ::: "memory");
            const unsigned og = xb_add(&bar[XB_TOP], 1u);
            const unsigned tg = og / nx;
            if (og + 1u == (tg + 1u) * nx) xb_add(&bar[XB_TOPGEN], 1u);
            else XB_SPIN(xb_ld(&bar[XB_TOPGEN]) == tg, bar);
            __builtin_amdgcn_fence(__ATOMIC_ACQUIRE, "agent");
            xb_add(&bar[XB_XGEN(b.x)], 1u);
            asm volatile("s_waitcnt vmcnt(0)" ::: "memory");
        } else {
            XB_SPIN(xb_ld(&bar[XB_XGEN(b.x)]) == gen, bar);
            __builtin_amdgcn_fence(__ATOMIC_ACQUIRE, "agent");
            asm volatile("s_waitcnt vmcnt(0)" ::: "memory");
        }
    }
    __syncthreads();
}

#ifndef INPROJ1_F8
#define INPROJ1_F8 0
#endif
#ifndef DENSE_GU_F8
#define DENSE_GU_F8 1
#endif
#ifndef DENSE_DN_F8
#define DENSE_DN_F8 0
#endif
#ifndef MOE_DOWN_F8
#define MOE_DOWN_F8 1
#endif
constexpr int D = 1024, NBATCH = 8, SEQ = 4096, T = NBATCH * SEQ, DIN = 3228, DINP = 3328, DFF = 2816, NEXP = 8, DFFE = 3584, NCHUNK = 64;
constexpr int C_GQ = 0, C_GK = 192, C_GV = 384, C_GZ = 768, C_GLR = 1152, C_LX = 1168, C_LG = 1424, C_DQ = 1680, C_DK = 2064, C_DV = 2448, C_DZ = 2832, C_DB = 3216, C_DA = 3222;
constexpr int MODW = 6 * D;
constexpr float EPS = 1e-6f;
constexpr int NWAVES = 8, NTHR = 512;
constexpr int MOE_ROWS = T + NEXP * 256;
constexpr int MOE_TILES = MOE_ROWS / 256;
constexpr int TILE_TAB = 320;

constexpr size_t MiB = 1u << 20;
constexpr size_t WS_CTL = 0, CTL_ZERO_BYTES = 1 * MiB;
constexpr size_t WS_MOD = 1 * MiB;
constexpr size_t WS_ROUTE_E = 2 * MiB;
constexpr size_t WS_ROUTE_W = 3 * MiB;
constexpr size_t WS_WCNT = 4 * MiB;
constexpr size_t WS_LIST = 5 * MiB;
constexpr size_t WS_ROWW = 6 * MiB;
constexpr size_t WS_TILES = 7 * MiB;
constexpr size_t WS_DNDEC = 7 * MiB + 65536;
constexpr size_t WS_WIN = 8 * MiB;
constexpr size_t WS_WOUT = 21 * MiB;
constexpr size_t WS_WGU = 25 * MiB;
constexpr size_t WS_WDN = 36 * MiB;
constexpr size_t WS_H = 42 * MiB;
constexpr size_t WS_PROJ = 106 * MiB;
constexpr size_t DN_BYTES = (size_t)3072 * 5 * 8192;
constexpr size_t WS_MOEGU = 344 * MiB;
constexpr size_t WS_MOEDN = 400 * MiB;
constexpr size_t WS_GLA = 464 * MiB;
constexpr size_t WS_GLADEC = 6 * MiB;
constexpr size_t WS_LRUC = 5 * MiB;
constexpr size_t WS_PART = 8 * MiB;
constexpr size_t WS_Y0 = 432 * MiB;
constexpr size_t WS_XRES = 512 * MiB;
constexpr size_t WS_END = 576 * MiB;
static_assert(WS_PROJ + (size_t)T * DINP * 2 <= WS_MOEGU && WS_PROJ + (size_t)2 * MOE_ROWS * DFFE <= WS_MOEGU && DN_BYTES <= (size_t)T * D * 4 && WS_MOEGU + (size_t)8 * 7168 * 1024 <= WS_MOEDN && WS_MOEDN + (size_t)8 * 1024 * 3584 * 2 <= WS_GLA, "d_ws map");
static_assert(MOE_DOWN_F8 && WS_MOEDN + (size_t)8 * 1024 * 3584 <= WS_Y0 && WS_Y0 + (size_t)T * D * 2 <= WS_XRES, "d_ws map");
static_assert(WS_H + (size_t)T * D * 2 <= WS_PROJ && WS_WDN + (size_t)1024 * 2816 * 2 <= WS_H, "d_ws map");
constexpr int CW_TMO = 0, CW_CODE = 1, CW_BAR = 4096, CW_MODCNT = 8192;

constexpr int RING_BYTES = 131072;
constexpr int MISC_OFF = RING_BYTES + 320;
constexpr int PTR_OFF = RING_BYTES + 512;
constexpr int TAB_OFF = RING_BYTES + 1024;
constexpr int ROWTAB_OFF = RING_BYTES + 3072;
constexpr int LDS_BYTES = 147456;

#define DI __device__ __forceinline__
typedef float f32x2 __attribute__((ext_vector_type(2)));
typedef unsigned u32x2 __attribute__((ext_vector_type(2)));

DI float bf2f(unsigned b) { return __uint_as_float(b << 16); }
DI void unpack8(const v4u w, float (&f)[8]) {
    f[0] = __uint_as_float(w.x << 16); f[1] = __uint_as_float(w.x & 0xffff0000u); f[2] = __uint_as_float(w.y << 16); f[3] = __uint_as_float(w.y & 0xffff0000u);
    f[4] = __uint_as_float(w.z << 16); f[5] = __uint_as_float(w.z & 0xffff0000u); f[6] = __uint_as_float(w.w << 16); f[7] = __uint_as_float(w.w & 0xffff0000u); }
DI void unpack4(const u32x2 w, float (&f)[4]) { f[0] = __uint_as_float(w.x << 16); f[1] = __uint_as_float(w.x & 0xffff0000u); f[2] = __uint_as_float(w.y << 16); f[3] = __uint_as_float(w.y & 0xffff0000u); }
DI v4u pack8(const float (&f)[8]) { v4u w; w.x = pk2(f[0], f[1]); w.y = pk2(f[2], f[3]); w.z = pk2(f[4], f[5]); w.w = pk2(f[6], f[7]); return w; }
DI u32x2 pack4(float a, float b, float c, float d) { u32x2 w; w.x = pk2(a, b); w.y = pk2(c, d); return w; }
DI float fexp(float x) { return __builtin_amdgcn_exp2f(x * 1.4426950408889634f); }
DI float frcp(float x) { return __builtin_amdgcn_rcpf(x); }
DI float frsq(float x) { return __builtin_amdgcn_rsqf(x); }
DI float sigm(float x) { return frcp(1.0f + fexp(-x)); }
DI float silu(float x) { return x * frcp(1.0f + fexp(-x)); }
DI float softplus(float x) { return fmaxf(x, 0.0f) + 0.6931471805599453f * __builtin_amdgcn_logf(1.0f + fexp(-fabsf(x))); }
DI float gelu_tanh(float x) { const float u = 1.5957691216057308f * (x + 0.044715f * x * x * x); return x * frcp(1.0f + fexp(-u)); }
DI int bperm_i(int srclane, int v) { return __builtin_amdgcn_ds_bpermute(srclane << 2, v); }
DI float bperm_f(int srclane, float v) { return __builtin_bit_cast(float, __builtin_amdgcn_ds_bpermute(srclane << 2, __builtin_bit_cast(int, v))); }
DI float wave_sum(float v, int lane) {
    (void)lane;
    v += __builtin_bit_cast(float, __builtin_amdgcn_update_dpp(0, __builtin_bit_cast(int, v), 0xB1, 0xF, 0xF, true));
    v += __builtin_bit_cast(float, __builtin_amdgcn_update_dpp(0, __builtin_bit_cast(int, v), 0x4E, 0xF, 0xF, true));
    v += __builtin_bit_cast(float, __builtin_amdgcn_update_dpp(0, __builtin_bit_cast(int, v), 0x141, 0xF, 0xF, true));
    v += __builtin_bit_cast(float, __builtin_amdgcn_update_dpp(0, __builtin_bit_cast(int, v), 0x140, 0xF, 0xF, true));
    const int vi = __builtin_bit_cast(int, v);
    const float r0 = __builtin_bit_cast(float, __builtin_amdgcn_readlane(vi, 0)), r1 = __builtin_bit_cast(float, __builtin_amdgcn_readlane(vi, 16));
    const float r2 = __builtin_bit_cast(float, __builtin_amdgcn_readlane(vi, 32)), r3 = __builtin_bit_cast(float, __builtin_amdgcn_readlane(vi, 48));
    return (r0 + r1) + (r2 + r3);
}
template <int K> DI f32x4 mm16(const LAS bf16* A, int lda, const LAS bf16* Bt, int ldb, f32x4 acc, int lane) {
    const int r = lane & 15, q = lane >> 4;
#pragma unroll
    for (int k0 = 0; k0 < K; k0 += 32) {
        const bf16x8 a = *(const LAS bf16x8*)(A + r * lda + k0 + q * 8);
        const bf16x8 b = *(const LAS bf16x8*)(Bt + r * ldb + k0 + q * 8);
        acc = __builtin_amdgcn_mfma_f32_16x16x32_bf16(a, b, acc, 0, 0, 0);
    }
    return acc;
}
DI float dpp_sum8(float x) {
    x += __builtin_bit_cast(float, __builtin_amdgcn_update_dpp(0, __builtin_bit_cast(int, x), 0xB1, 0xF, 0xF, true));
    x += __builtin_bit_cast(float, __builtin_amdgcn_update_dpp(0, __builtin_bit_cast(int, x), 0x4E, 0xF, 0xF, true));
    x += __builtin_bit_cast(float, __builtin_amdgcn_update_dpp(0, __builtin_bit_cast(int, x), 0x141, 0xF, 0xF, true));
    return x;
}
#define MFMA16(a, b, c) __builtin_amdgcn_mfma_f32_16x16x32_bf16((a), (b), (c), 0, 0, 0)
#define LDF(p) (*(const LAS bf16x8*)(p))
#define SYNC() asm volatile("s_waitcnt lgkmcnt(0)\n\ts_barrier" ::: "memory")

namespace pg8 {
struct EpiStoreBf16 {
    static constexpr bool PERM = true, F8 = false;
    bf16_t* O; int ldc;
    DI void operator()(const f32x4 (&acc)[2][2][4][2], const Unit& u, int wr, int wc, int fr, int fq) const {
        const int row0 = u.pm * BM + wr * 64 + fr, col0 = u.pn * BM + wc * 32 + 8 * fq;
#pragma unroll
        for (int ai = 0; ai < 2; ++ai)
#pragma unroll
            for (int m = 0; m < 4; ++m) { bf16_t* rowp = O + (size_t)(row0 + ai * HALF + m * 16) * ldc + col0;
#pragma unroll
                for (int bj = 0; bj < 2; ++bj) { const f32x4 v0 = acc[ai][bj][m][0], v1 = acc[ai][bj][m][1];
                    u32x4 w; w.x = cvt_pk_bf16(v0[0], v0[1]); w.y = cvt_pk_bf16(v0[2], v0[3]); w.z = cvt_pk_bf16(v1[0], v1[1]); w.w = cvt_pk_bf16(v1[2], v1[3]);
                    *(u32x4*)(rowp + bj * HALF) = w; } }
    }
};
template <bool B32_, bool F8_> struct EpiResT {
    static constexpr bool PERM = true, F8 = F8_;
    const float* base32; const bf16_t* base16; bf16_t* out; const float* gate;
    DI void operator()(const f32x4 (&acc)[2][2][4][2], const Unit& u, int wr, int wc, int fr, int fq) const {
        const int row0 = u.pm * BM + wr * 64 + fr, col0 = u.pn * BM + wc * 32 + 8 * fq;
        const float* gp = gate + (size_t)((u.pm * BM) / SEQ) * MODW + col0;
        f32x4 gv[2][2];
#pragma unroll
        for (int bj = 0; bj < 2; ++bj)
#pragma unroll
            for (int n = 0; n < 2; ++n) gv[bj][n] = *(const f32x4*)(gp + bj * HALF + n * 4);
#pragma unroll
        for (int ai = 0; ai < 2; ++ai) {
            f32x4 bs[4][2][2]; u32x4 br[4][2];
#pragma unroll
            for (int m = 0; m < 4; ++m) { const size_t off = (size_t)(row0 + ai * HALF + m * 16) * D + col0;
#pragma unroll
                for (int bj = 0; bj < 2; ++bj) {
                    if constexpr (B32_) { bs[m][bj][0] = *(const f32x4*)(base32 + off + bj * HALF); bs[m][bj][1] = *(const f32x4*)(base32 + off + bj * HALF + 4); }
                    else br[m][bj] = *(const u32x4*)(base16 + off + bj * HALF); } }
#pragma unroll
            for (int m = 0; m < 4; ++m) { const size_t off = (size_t)(row0 + ai * HALF + m * 16) * D + col0;
#pragma unroll
                for (int bj = 0; bj < 2; ++bj) {
                    if constexpr (!B32_) { const u32x4 w = br[m][bj];
                        bs[m][bj][0] = (f32x4){__uint_as_float(w.x << 16), __uint_as_float(w.x & 0xffff0000u), __uint_as_float(w.y << 16), __uint_as_float(w.y & 0xffff0000u)};
                        bs[m][bj][1] = (f32x4){__uint_as_float(w.z << 16), __uint_as_float(w.z & 0xffff0000u), __uint_as_float(w.w << 16), __uint_as_float(w.w & 0xffff0000u)}; }
                    const f32x4 v0 = bs[m][bj][0] + gv[bj][0] * acc[ai][bj][m][0], v1 = bs[m][bj][1] + gv[bj][1] * acc[ai][bj][m][1];
                    u32x4 w; w.x = cvt_pk_bf16(v0[0], v0[1]); w.y = cvt_pk_bf16(v0[2], v0[3]); w.z = cvt_pk_bf16(v1[0], v1[1]); w.w = cvt_pk_bf16(v1[2], v1[3]);
                    *(u32x4*)(out + off + bj * HALF) = w; } }
            asm volatile("" ::: "memory"); }
    }
};
typedef EpiResT<true, false> EpiRes32;
typedef EpiResT<false, false> EpiRes;
typedef EpiResT<false, true> EpiRes8;
struct EpiStoreBf16F8 : EpiStoreBf16 { static constexpr bool F8 = true; };
struct EpiSwiglu {
    static constexpr bool PERM = true, F8 = false;
    bf16_t* O; int ldc;
    DI void operator()(const f32x4 (&acc)[2][2][4][2], const Unit& u, int wr, int wc, int fr, int fq) const {
        const int row0 = u.pm * BM + wr * 64 + fr, col0 = u.pn * HALF + wc * 32 + 8 * fq;
#pragma unroll
        for (int ai = 0; ai < 2; ++ai)
#pragma unroll
            for (int m = 0; m < 4; ++m) { bf16_t* rowp = O + (size_t)(row0 + ai * HALF + m * 16) * ldc + col0;
                float v[8];
#pragma unroll
                for (int n = 0; n < 2; ++n)
#pragma unroll
                    for (int j = 0; j < 4; j += 2) {
                        const f32x2 g = {acc[ai][0][m][n][j], acc[ai][0][m][n][j + 1]}, up = {acc[ai][1][m][n][j], acc[ai][1][m][n][j + 1]};
                        const f32x2 t = g * -1.4426950408889634f;
                        const f32x2 e = {__builtin_amdgcn_exp2f(t.x), __builtin_amdgcn_exp2f(t.y)};
                        const f32x2 d = e + 1.0f;
                        const f32x2 rc = {__builtin_amdgcn_rcpf(d.x), __builtin_amdgcn_rcpf(d.y)};
                        const f32x2 o = (g * up) * rc;
                        v[n * 4 + j] = o.x; v[n * 4 + j + 1] = o.y; }
                u32x4 w; w.x = cvt_pk_bf16(v[0], v[1]); w.y = cvt_pk_bf16(v[2], v[3]); w.z = cvt_pk_bf16(v[4], v[5]); w.w = cvt_pk_bf16(v[6], v[7]);
                *(u32x4*)rowp = w; }
    }
};
struct EpiSwigluB : EpiSwiglu { static constexpr bool F8 = true; };
#if MOE_DOWN_F8
template <bool F8_> struct EpiSwiglu8T {
    static constexpr bool PERM = true, F8 = F8_;
    bf16_t* Ob; int ldc;
    DI void operator()(const f32x4 (&acc)[2][2][4][2], const Unit& u, int wr, int wc, int fr, int fq) const {
        unsigned char* O = (unsigned char*)Ob;
        const int row0 = u.pm * BM + wr * 64 + fr, col0 = u.pn * HALF + wc * 32 + 8 * fq;
#pragma unroll
        for (int ai = 0; ai < 2; ++ai)
#pragma unroll
            for (int m = 0; m < 4; ++m) { unsigned char* rowp = O + (size_t)(row0 + ai * HALF + m * 16) * ldc + col0;
                float v[8];
#pragma unroll
                for (int n = 0; n < 2; ++n)
#pragma unroll
                    for (int j = 0; j < 4; j += 2) {
                        const f32x2 g = {acc[ai][0][m][n][j], acc[ai][0][m][n][j + 1]}, up = {acc[ai][1][m][n][j], acc[ai][1][m][n][j + 1]};
                        const f32x2 t = g * -1.4426950408889634f;
                        const f32x2 e = {__builtin_amdgcn_exp2f(t.x), __builtin_amdgcn_exp2f(t.y)};
                        const f32x2 d = e * 0.125f + 0.125f;
                        const f32x2 rc = {__builtin_amdgcn_rcpf(d.x), __builtin_amdgcn_rcpf(d.y)};
                        const f32x2 o = (g * up) * rc;
                        v[n * 4 + j] = __builtin_amdgcn_fmed3f(o.x, -448.0f, 448.0f); v[n * 4 + j + 1] = __builtin_amdgcn_fmed3f(o.y, -448.0f, 448.0f); }
                int w0 = 0, w1 = 0;
                w0 = __builtin_amdgcn_cvt_pk_fp8_f32(v[0], v[1], w0, false); w0 = __builtin_amdgcn_cvt_pk_fp8_f32(v[2], v[3], w0, true);
                w1 = __builtin_amdgcn_cvt_pk_fp8_f32(v[4], v[5], w1, false); w1 = __builtin_amdgcn_cvt_pk_fp8_f32(v[6], v[7], w1, true);
                *(u32x2*)rowp = (u32x2){(unsigned)w0, (unsigned)w1}; }
    }
};
typedef EpiSwiglu8T<true> EpiSwiglu8;
typedef EpiSwiglu8T<false> EpiSwigluTo8;
#else
struct EpiSwiglu8 : EpiSwiglu { static constexpr bool F8 = true; };
#endif
struct EpiMoeDown {
    static constexpr bool PERM = true, F8 = (MOE_DOWN_F8 != 0);
    bf16_t* y0; bf16_t* y1; int split; const int* list; const float* roww;
    DI void operator()(const f32x4 (&acc)[2][2][4][2], const Unit& u, int wr, int wc, int fr, int fq) const {
        const int row0 = u.pm * BM + wr * 64 + fr, col0 = u.pn * BM + wc * 32 + 8 * fq;
        bf16_t* dst = (u.pm * BM >= split) ? y1 : y0;
        int tok[8]; float rw[8];
#pragma unroll
        for (int g = 0; g < 8; ++g) { const int r = row0 + (g >> 2) * HALF + (g & 3) * 16; tok[g] = list[r]; rw[g] = roww[r]; }
#pragma unroll
        for (int g = 0; g < 8; ++g) if (tok[g] >= 0) { bf16_t* op = dst + (size_t)tok[g] * D + col0; const int ai = g >> 2, m = g & 3;
#pragma unroll
            for (int bj = 0; bj < 2; ++bj) { const f32x4 v0 = acc[ai][bj][m][0] * rw[g], v1 = acc[ai][bj][m][1] * rw[g];
                u32x4 o; o.x = cvt_pk_bf16(v0[0], v0[1]); o.y = cvt_pk_bf16(v0[2], v0[3]); o.z = cvt_pk_bf16(v1[0], v1[1]); o.w = cvt_pk_bf16(v1[2], v1[3]);
                *(u32x4*)(op + bj * HALF) = o; } }
    }
};
template <bool GATHER_> struct MoeOrder {
    static constexpr bool GATHER = GATHER_;
    int nM, nN, nwg, G, c; const LAS int* tile_e; const int* list; size_t eB;
    int lo, hi, slices, kslice;
    DI void init(int nM_, int N, int G_, int c_) { nM = nM_; nN = N / BM; nwg = nM * nN; G = G_; c = c_; lo = 0; hi = nwg; slices = 1; kslice = 0; }
    DI void tile_of(int L, Unit& u) const {
        int wgid = L; { const int q = nwg / NXCD, r = nwg % NXCD, xcd = wgid % NXCD, off = wgid / NXCD; wgid = (xcd < r ? xcd * (q + 1) : r * (q + 1) + (xcd - r) * q) + off; }
        const int nig = WGM * nN, gid = wgid / nig, fm = gid * WGM, gsz = (nM - fm) < WGM ? (nM - fm) : WGM;
        u.pm = fm + ((wgid % nig) % gsz); u.pn = (wgid % nig) / gsz; }
    DI bool next(int i, Unit& u) const {
        const long S0 = (long)i * G + c; if (S0 >= (long)(hi - lo) * slices) return false;
        u.sub = (int)S0; u.ks = (int)(S0 % slices) * kslice; tile_of(lo + (int)(S0 / slices), u); return true;
    }
    DI const char* b_base(const Gemm& g, const Unit& u, size_t tstep) const { return (const char*)g.Bt + (size_t)__builtin_amdgcn_readfirstlane(tile_e[u.pm]) * eB + (size_t)u.pn * tstep; }
    LAS int* rowtab = nullptr;
    DI bool rowtab_ok() const { return list != nullptr && rowtab != nullptr; }
    DI const int* rows_ptr(const Unit& u) const { return list + u.pm * BM; }
    DI int row_of(const Unit& u, int r) const { if (list == nullptr) return u.pm * BM + r; const int tok = list[u.pm * BM + r]; return tok < 0 ? 0 : tok; }
};
struct EpiPartial {
    static constexpr bool PERM = false, F8 = (MOE_DOWN_F8 != 0);
    float* part;
    DI void operator()(const f32x4 (&acc)[2][2][4][2], const Unit& u, int wr, int wc, int fr, int fq) const {
        float* p = part + (size_t)u.sub * 65536 + (size_t)(((wr * 4 + wc) * 64) + fq * 16 + fr) * 128;
#pragma unroll
        for (int ai = 0; ai < 2; ++ai)
#pragma unroll
            for (int bj = 0; bj < 2; ++bj)
#pragma unroll
                for (int m = 0; m < 4; ++m)
#pragma unroll
                    for (int n = 0; n < 2; ++n) *(f32x4*)(p + (((ai * 2 + bj) * 4 + m) * 2 + n) * 4) = acc[ai][bj][m][n];
    }
};
}

struct Ctx { LAS unsigned char* lds; int tid, lane, wave, vcu, G, gw, NGW; };

struct XpItem { const float* src; bf16* dst; int K, N, k0, n0, drow0; float f8scale; };
DI void xp_load(const XpItem& I, f32x4 (&v)[8], int lane) {
    const int kr = lane >> 3, c4 = (lane & 7) * 4;
#pragma unroll
    for (int i = 0; i < 8; ++i) { const int kk = i * 8 + kr; v[i] = (f32x4){0.f, 0.f, 0.f, 0.f};
        if (I.n0 + c4 < I.N) v[i] = *(const f32x4*)(I.src + (size_t)(I.k0 + kk) * I.N + I.n0 + c4); }
}
DI void xp_finish(const XpItem& I, const f32x4 (&v)[8], LAS float* scr, int lane) {
    const int kr = lane >> 3, c4 = (lane & 7) * 4;
#pragma unroll
    for (int i = 0; i < 8; ++i) { const int kk = i * 8 + kr; scr[kk * 33 + c4 + 0] = v[i].x; scr[kk * 33 + c4 + 1] = v[i].y; scr[kk * 33 + c4 + 2] = v[i].z; scr[kk * 33 + c4 + 3] = v[i].w; }
    LDS_WAIT(); asm volatile("" ::: "memory");
    const int c = lane & 7;
    if (I.f8scale != 0.0f) { const float sc = I.f8scale; unsigned char* d8 = (unsigned char*)I.dst;
#pragma unroll
        for (int j = 0; j < 4; ++j) { const int n = (lane >> 3) + 8 * j; const LAS float* s = scr + (8 * c) * 33 + n;
            int w0 = 0, w1 = 0;
            w0 = __builtin_amdgcn_cvt_pk_fp8_f32(__builtin_amdgcn_fmed3f(s[0 * 33] * sc, -448.f, 448.f), __builtin_amdgcn_fmed3f(s[1 * 33] * sc, -448.f, 448.f), w0, false);
            w0 = __builtin_amdgcn_cvt_pk_fp8_f32(__builtin_amdgcn_fmed3f(s[2 * 33] * sc, -448.f, 448.f), __builtin_amdgcn_fmed3f(s[3 * 33] * sc, -448.f, 448.f), w0, true);
            w1 = __builtin_amdgcn_cvt_pk_fp8_f32(__builtin_amdgcn_fmed3f(s[4 * 33] * sc, -448.f, 448.f), __builtin_amdgcn_fmed3f(s[5 * 33] * sc, -448.f, 448.f), w1, false);
            w1 = __builtin_amdgcn_cvt_pk_fp8_f32(__builtin_amdgcn_fmed3f(s[6 * 33] * sc, -448.f, 448.f), __builtin_amdgcn_fmed3f(s[7 * 33] * sc, -448.f, 448.f), w1, true);
            *(u32x2*)(d8 + (size_t)(I.drow0 + n) * I.K + I.k0 + 8 * c) = (u32x2){(unsigned)w0, (unsigned)w1}; }
    } else {
#pragma unroll
    for (int j = 0; j < 4; ++j) { const int n = (lane >> 3) + 8 * j; const LAS float* s = scr + (8 * c) * 33 + n;
        v4u o; o.x = pk2(s[0 * 33], s[1 * 33]); o.y = pk2(s[2 * 33], s[3 * 33]); o.z = pk2(s[4 * 33], s[5 * 33]); o.w = pk2(s[6 * 33], s[7 * 33]);
        *(v4u*)(I.dst + (size_t)(I.drow0 + n) * I.K + I.k0 + 8 * c) = o; }
    }
    LDS_WAIT(); asm volatile("" ::: "memory");
}
DI bool xp_try(int& r, const float* W, int K, int N, int Npad, bf16* WT, int mode, XpItem& o, float f8scale = 0.0f) {
    const int nblk = Npad / 32, items = (K / 64) * nblk;
    if (r >= items) { r -= items; return false; }
    const int kb = r / nblk, n0 = (r % nblk) * 32;
    o.src = W; o.dst = WT; o.K = K; o.N = N; o.k0 = kb * 64; o.n0 = n0; o.f8scale = f8scale; o.drow0 = mode == 0 ? n0 : ((n0 >> 7) * 256 + (n0 & 127) + (mode == 2 ? 128 : 0));
    return true;
}
struct In { const float* p[30]; };
struct PtrTab { const LAS unsigned long long* t;
    DI const float* operator[](int k) const { const unsigned long long v = t[k]; const unsigned lo = __builtin_amdgcn_readfirstlane((unsigned)v), hi = __builtin_amdgcn_readfirstlane((unsigned)(v >> 32));
        return (const float*)(const GAS float*)(((unsigned long long)hi << 32) | lo); } };
struct InT { PtrTab p; };
DI void prologue_phase(const Ctx& X, const InT& I, unsigned char* ws) {
    LAS float* sct = (LAS float*)(X.lds + 98304);
    if (X.vcu < 2 * (MODW / 64)) {
        const float* cc = I.p[1];
        for (int i = X.tid; i < NBATCH * D; i += NTHR) { const int b = i / D, k = i % D; sct[k * 8 + b] = silu(cc[i]); }
        SYNC();
    }
    for (int it = X.vcu; it < 2 * (MODW / 64); it += X.G) {
        const int L = it / (MODW / 64), n = (it % (MODW / 64)) * 64 + X.lane;
        const float* aw = I.p[20] + (size_t)L * D * MODW + n;
        float acc[8];
#pragma unroll
        for (int b = 0; b < 8; ++b) acc[b] = 0.f;
        const int kb = X.wave * 128;
#pragma unroll 16
        for (int k = kb; k < kb + 128; ++k) { const float w = aw[(size_t)k * MODW]; const f32x4 s0 = *(const LAS f32x4*)(sct + k * 8), s1 = *(const LAS f32x4*)(sct + k * 8 + 4);
            acc[0] += s0.x * w; acc[1] += s0.y * w; acc[2] += s0.z * w; acc[3] += s0.w * w; acc[4] += s1.x * w; acc[5] += s1.y * w; acc[6] += s1.z * w; acc[7] += s1.w * w; }
        LAS float* red = (LAS float*)(X.lds + 81920);
#pragma unroll
        for (int b = 0; b < 8; ++b) red[(X.wave * 8 + b) * 64 + X.lane] = acc[b];
        SYNC();
        float s = I.p[21][(size_t)L * MODW + n];
#pragma unroll
        for (int w = 0; w < 8; ++w) s += red[(w * 8 + X.wave) * 64 + X.lane];
        ((float*)(ws + WS_MOD))[((size_t)L * 8 + X.wave) * MODW + n] = s;
        SYNC();
    }
    if (X.vcu < 2 * (MODW / 64)) {
        asm volatile("s_waitcnt vmcnt(0)" ::: "memory");
        __syncthreads();
        if (X.tid == 0) { __builtin_amdgcn_fence(__ATOMIC_RELEASE, "agent"); asm volatile("s_waitcnt vmcnt(0)" ::: "memory"); (void)xb_add((unsigned*)(ws + WS_CTL) + CW_MODCNT, 1u); }
    }
    LAS float* scr = (LAS float*)(X.lds + X.wave * 8704);
    constexpr int I_IN = 16 * (DINP / 32), I_OUT = 16 * 32, I_G = 16 * (DFF / 32), I_D = (DFF / 64) * 32;
    constexpr int NITEMS = 2 * I_IN + 2 * I_OUT + 2 * I_G + I_D;
    const float* w_in = I.p[2]; const float* w_out = I.p[17]; const float* wg = I.p[22]; const float* wu = I.p[23]; const float* wd = I.p[24];
#define PRO_DECODE(it_, o_) do { int r = (it_); \
        if (xp_try(r, w_in, D, DIN, DINP, (bf16*)(ws + WS_WIN), 0, o_)) break; \
        if (xp_try(r, w_in + (size_t)D * DIN, D, DIN, DINP, (bf16*)(ws + WS_WIN) + (size_t)DINP * D, 0, o_, INPROJ1_F8 ? 1024.0f : 0.0f)) break; \
        if (xp_try(r, w_out, D, D, D, (bf16*)(ws + WS_WOUT), 0, o_)) break; \
        if (xp_try(r, w_out + (size_t)D * D, D, D, D, (bf16*)(ws + WS_WOUT) + (size_t)D * D, 0, o_)) break; \
        if (xp_try(r, wg, D, DFF, DFF, (bf16*)(ws + WS_WGU), 1, o_, DENSE_GU_F8 ? 1024.0f : 0.0f)) break; \
        if (xp_try(r, wu, D, DFF, DFF, (bf16*)(ws + WS_WGU), 2, o_, DENSE_GU_F8 ? 1024.0f : 0.0f)) break; \
        xp_try(r, wd, DFF, D, D, (bf16*)(ws + WS_WDN), 0, o_, DENSE_DN_F8 ? 2048.0f : 0.0f); } while (0)
    if (X.gw < NITEMS) {
        XpItem cur, nx; f32x4 v[8], vn[8];
        PRO_DECODE(X.gw, cur); xp_load(cur, v, X.lane);
        for (int it = X.gw; it < NITEMS; it += X.NGW) {
            const bool more = it + X.NGW < NITEMS;
            if (more) { PRO_DECODE(it + X.NGW, nx); xp_load(nx, vn, X.lane); }
            xp_finish(cur, v, scr, X.lane);
            if (more) { cur = nx;
#pragma unroll
                for (int i = 0; i < 8; ++i) v[i] = vn[i]; }
        }
    }
#undef PRO_DECODE
}
DI void mod_wait(const Ctx& X, unsigned char* ws) {
    if (X.tid == 0) { unsigned* bar = (unsigned*)(ws + WS_CTL) + CW_BAR; const unsigned want = (unsigned)(X.G < 2 * (MODW / 64) ? X.G : 2 * (MODW / 64));
        XB_SPIN(xb_ld((unsigned*)(ws + WS_CTL) + CW_MODCNT) < want, bar);
        __builtin_amdgcn_fence(__ATOMIC_ACQUIRE, "agent"); asm volatile("s_waitcnt vmcnt(0)" ::: "memory"); }
    __syncthreads();
}
DI void moe_convert(const Ctx& X, const InT& I, unsigned char* ws, int lo, int hi, int wk, int nwk) {
    LAS float* scr = (LAS float*)(X.lds + 40960 + X.wave * 8704);
    constexpr int PER = 1792;
    const float* mg = I.p[26]; const float* mu = I.p[27]; const float* md = I.p[28];
#define MOE_DECODE(it_, o_) do { const int mat = (it_) / PER; int r = (it_) % PER; const int e = mat / 3, which = mat % 3; \
        if (which == 0) xp_try(r, mg + (size_t)e * D * DFFE, D, DFFE, DFFE, (bf16*)(ws + WS_MOEGU + (size_t)e * 2 * DFFE * D), 1, o_, 1024.0f); \
        else if (which == 1) xp_try(r, mu + (size_t)e * D * DFFE, D, DFFE, DFFE, (bf16*)(ws + WS_MOEGU + (size_t)e * 2 * DFFE * D), 2, o_, 1024.0f); \
        else xp_try(r, md + (size_t)e * DFFE * D, DFFE, D, D, (bf16*)(ws + WS_MOEDN + (size_t)e * D * DFFE * (MOE_DOWN_F8 ? 1 : 2)), 0, o_, MOE_DOWN_F8 ? 2048.0f : 0.0f); } while (0)
    const int first = lo + wk * NWAVES + X.wave, step = nwk * NWAVES;
    if (first < hi) {
        XpItem cur, nx; f32x4 v[8], vn[8];
        MOE_DECODE(first, cur); xp_load(cur, v, X.lane);
        for (int it = first; it < hi; it += step) {
            const bool more = it + step < hi;
            if (more) { MOE_DECODE(it + step, nx); xp_load(nx, vn, X.lane); }
            xp_finish(cur, v, scr, X.lane);
            if (more) { cur = nx;
#pragma unroll
                for (int i = 0; i < 8; ++i) v[i] = vn[i]; }
        }
    }
#undef MOE_DECODE
}

template <bool ROUTER, bool XB, bool F8OUT = ROUTER> DI void norm_phase(const Ctx& X, const void* xin_, const float* nw, const float* modL, int sh_off, int sc_off, bf16* hout, const float* router_w, unsigned char* ws) {
    LAS float* rw = (LAS float*)X.lds;
    if (ROUTER) { for (int i = X.tid; i < D * NEXP / 4; i += NTHR) ((LAS f32x4*)rw)[i] = ((const f32x4*)router_w)[i]; SYNC(); }
    for (int rb = X.gw; rb < T / 16; rb += X.NGW) {
        const int m0 = rb * 16, b = m0 / SEQ;
        f32x4 a[4], s[4];
#pragma unroll
        for (int j = 0; j < 4; ++j) { const int col = 4 * X.lane + 256 * j; const f32x4 w = *(const f32x4*)(nw + col), sc = *(const f32x4*)(modL + (size_t)b * MODW + sc_off + col);
            a[j] = w * (1.0f + sc); s[j] = *(const f32x4*)(modL + (size_t)b * MODW + sh_off + col); }
        unsigned long long cnt0 = 0ull, cnt1 = 0ull;
        f32x4 vnx[4];
#define NORM_LDROW(m_, dst) do { if (XB) { const u32x2* xr_ = (const u32x2*)((const bf16*)xin_ + (size_t)(m_) * D) + X.lane; \
            _Pragma("unroll") for (int j = 0; j < 4; ++j) { const u32x2 w_ = xr_[64 * j]; dst[j] = (f32x4){__uint_as_float(w_.x << 16), __uint_as_float(w_.x & 0xffff0000u), __uint_as_float(w_.y << 16), __uint_as_float(w_.y & 0xffff0000u)}; } } \
          else { const f32x4* xr_ = (const f32x4*)((const float*)xin_ + (size_t)(m_) * D) + X.lane; _Pragma("unroll") for (int j = 0; j < 4; ++j) dst[j] = xr_[64 * j]; } } while (0)
        NORM_LDROW(m0, vnx);
        for (int jr = 0; jr < 16; ++jr) {
            const int m = m0 + jr;
            f32x4 v[4]; float ss = 0.f;
#pragma unroll
            for (int j = 0; j < 4; ++j) v[j] = vnx[j];
            NORM_LDROW(m0 + (jr < 15 ? jr + 1 : jr), vnx);
#pragma unroll
            for (int j = 0; j < 4; ++j) ss += (v[j].x * v[j].x + v[j].y * v[j].y) + (v[j].z * v[j].z + v[j].w * v[j].w);
            const float rstd = frsq(wave_sum(ss, X.lane) * (1.0f / D) + EPS);
            unsigned long long* o8 = (unsigned long long*)(hout + (size_t)m * D) + X.lane;
#pragma unroll
            for (int j = 0; j < 4; ++j) { v[j] = v[j] * rstd * a[j] + s[j];
                if (F8OUT) { int w = 0;
                    w = __builtin_amdgcn_cvt_pk_fp8_f32(__builtin_amdgcn_fmed3f(32.0f * v[j].x, -448.f, 448.f), __builtin_amdgcn_fmed3f(32.0f * v[j].y, -448.f, 448.f), w, false);
                    w = __builtin_amdgcn_cvt_pk_fp8_f32(__builtin_amdgcn_fmed3f(32.0f * v[j].z, -448.f, 448.f), __builtin_amdgcn_fmed3f(32.0f * v[j].w, -448.f, 448.f), w, true);
                    ((int*)((unsigned char*)hout + (size_t)m * D))[X.lane + 64 * j] = w; }
                else o8[64 * j] = (unsigned long long)pk2(v[j].x, v[j].y) | ((unsigned long long)pk2(v[j].z, v[j].w) << 32); }
            if (ROUTER) {
                float lg[8];
#pragma unroll
                for (int e = 0; e < 8; ++e) lg[e] = 0.f;
#pragma unroll
                for (int j = 0; j < 4; ++j) { asm volatile("" ::: "memory");
#pragma unroll
                    for (int i = 0; i < 4; ++i) { const int col = 4 * X.lane + 256 * j + i; const f32x4 w0 = *(const LAS f32x4*)(rw + col * 8), w1 = *(const LAS f32x4*)(rw + col * 8 + 4); const float hv = v[j][i];
                        lg[0] += hv * w0.x; lg[1] += hv * w0.y; lg[2] += hv * w0.z; lg[3] += hv * w0.w; lg[4] += hv * w1.x; lg[5] += hv * w1.y; lg[6] += hv * w1.z; lg[7] += hv * w1.w; } }
#pragma unroll
                for (int e = 0; e < 8; ++e) lg[e] = wave_sum(lg[e], X.lane);
                int e0 = 0; float v0 = lg[0];
#pragma unroll
                for (int e = 1; e < 8; ++e) if (lg[e] > v0) { v0 = lg[e]; e0 = e; }
                int e1 = -1; float v1 = -3.0e38f;
#pragma unroll
                for (int e = 0; e < 8; ++e) if (e != e0 && lg[e] > v1) { v1 = lg[e]; e1 = e; }
                const float w1 = frcp(1.0f + fexp(v0 - v1)), w0 = 1.0f - w1;
                cnt0 += 1ull << (8 * e0); cnt1 += 1ull << (8 * e1);
                if (X.lane == 0) { ((int*)(ws + WS_ROUTE_E))[m] = e0 | (e1 << 8); ((f32x2*)(ws + WS_ROUTE_W))[m] = (f32x2){w0, w1}; }
            }
        }
        if (ROUTER && X.lane == 0) { ((unsigned long long*)(ws + WS_WCNT))[rb * 2] = cnt0; ((unsigned long long*)(ws + WS_WCNT))[rb * 2 + 1] = cnt1; }
    }
}
DI void final_norm_phase(const Ctx& X, const bf16* xin, const bf16* y0, const bf16* y1, const float* gate, const float* nw, float* out) {
    f32x4 a[4];
#pragma unroll
    for (int j = 0; j < 4; ++j) a[j] = *(const f32x4*)(nw + 4 * X.lane + 256 * j);
    u32x2 wn[4], pn[4], qn[4];
    { const size_t o0 = (size_t)(X.gw < T ? X.gw : 0) * D; const u32x2* xr0 = (const u32x2*)(xin + o0) + X.lane; const u32x2* pr0 = (const u32x2*)(y0 + o0) + X.lane; const u32x2* qr0 = (const u32x2*)(y1 + o0) + X.lane;
#pragma unroll
        for (int j = 0; j < 4; ++j) { wn[j] = xr0[64 * j]; pn[j] = pr0[64 * j]; qn[j] = qr0[64 * j]; } }
#define FN_UP(w_) ((f32x4){__uint_as_float((w_).x << 16), __uint_as_float((w_).x & 0xffff0000u), __uint_as_float((w_).y << 16), __uint_as_float((w_).y & 0xffff0000u)})
    for (int m = X.gw; m < T; m += X.NGW) {
        const int mn = m + X.NGW < T ? m + X.NGW : m;
        const u32x2* xr = (const u32x2*)(xin + (size_t)mn * D) + X.lane; const u32x2* pr = (const u32x2*)(y0 + (size_t)mn * D) + X.lane; const u32x2* qr = (const u32x2*)(y1 + (size_t)mn * D) + X.lane;
        const float* gp = gate + (size_t)(m / SEQ) * MODW + 4 * X.lane;
        f32x4 v[4]; float ss = 0.f;
#pragma unroll
        for (int j = 0; j < 4; ++j) { const u32x2 w = wn[j], y = pn[j], z = qn[j]; wn[j] = xr[64 * j]; pn[j] = pr[64 * j]; qn[j] = qr[64 * j];
            v[j] = FN_UP(w) + *(const f32x4*)(gp + 256 * j) * (FN_UP(y) + FN_UP(z));
            ss += (v[j].x * v[j].x + v[j].y * v[j].y) + (v[j].z * v[j].z + v[j].w * v[j].w); }
        const float rstd = frsq(wave_sum(ss, X.lane) * (1.0f / D) + EPS);
        f32x4* o = (f32x4*)(out + (size_t)m * D) + X.lane;
#pragma unroll
        for (int j = 0; j < 4; ++j) o[64 * j] = v[j] * rstd * a[j];
    }
#undef FN_UP
}

DI void moe_list_phase(const Ctx& X, unsigned char* ws) {
    const unsigned long long* wc = (const unsigned long long*)(ws + WS_WCNT);
    int* list = (int*)(ws + WS_LIST); float* roww = (float*)(ws + WS_ROWW); int* tiles = (int*)(ws + WS_TILES);
    for (int rb = X.gw; rb < T / 16; rb += X.NGW) {
        int tot[2][8], pre[2][8];
#pragma unroll
        for (int s = 0; s < 2; ++s)
#pragma unroll
            for (int e = 0; e < 8; ++e) { tot[s][e] = 0; pre[s][e] = 0; }
        for (int r2 = X.lane; r2 < T / 16; r2 += 64) {
            const unsigned long long c0 = wc[r2 * 2], c1 = wc[r2 * 2 + 1]; const bool lt = r2 < rb;
#pragma unroll
            for (int e = 0; e < 8; ++e) { const int a0 = (int)((c0 >> (8 * e)) & 0xffull), a1 = (int)((c1 >> (8 * e)) & 0xffull);
                tot[0][e] += a0; tot[1][e] += a1; pre[0][e] += lt ? a0 : 0; pre[1][e] += lt ? a1 : 0; }
        }
#pragma unroll
        for (int s = 0; s < 2; ++s)
#pragma unroll
            for (int e = 0; e < 8; ++e) {
#pragma unroll
                for (int o = 1; o < 64; o <<= 1) { tot[s][e] += bperm_i(X.lane ^ o, tot[s][e]); pre[s][e] += bperm_i(X.lane ^ o, pre[s][e]); } }
        int base[2][8], nt[2];
#pragma unroll
        for (int s = 0; s < 2; ++s) { int acc = 0;
#pragma unroll
            for (int e = 0; e < 8; ++e) { base[s][e] = acc; acc += (tot[s][e] + 255) & ~255; } nt[s] = acc / 256; }
        const int j = X.lane & 15, m = rb * 16 + j;
        const int ee = ((const int*)(ws + WS_ROUTE_E))[m]; const f32x2 ww = ((const f32x2*)(ws + WS_ROUTE_W))[m];
#pragma unroll
        for (int s = 0; s < 2; ++s) {
            const int es = s == 0 ? (ee & 0xff) : ((ee >> 8) & 0xff);
            int pos = 0;
#pragma unroll
            for (int e = 0; e < 8; ++e) pos = (es == e) ? base[s][e] + pre[s][e] : pos;
            int rank = 0;
#pragma unroll
            for (int jj = 0; jj < 16; ++jj) { const int eo = bperm_i(jj, es); rank += (jj < j && eo == es) ? 1 : 0; }
            const int off = s == 0 ? 0 : nt[0] * 256;
            if (X.lane < 16) { list[off + pos + rank] = m; roww[off + pos + rank] = s == 0 ? ww.x : ww.y; }
        }
        if (rb == 0) {
#pragma unroll
            for (int s = 0; s < 2; ++s) { const int off = s == 0 ? 0 : nt[0] * 256;
#pragma unroll
                for (int e = 0; e < 8; ++e) { const int lo = base[s][e] + tot[s][e], hi = base[s][e] + ((tot[s][e] + 255) & ~255);
                    for (int r = lo + X.lane; r < hi; r += 64) { list[off + r] = -1; roww[off + r] = 0.f; }
                    for (int t = base[s][e] / 256 + X.lane; t < hi / 256; t += 64) tiles[off / 256 + t] = e; }
            }
            if (X.lane == 0) { tiles[TILE_TAB - 2] = nt[0]; tiles[TILE_TAB - 1] = nt[0] + nt[1]; }
        }
    }
}

DI void dn_prep_phase(const Ctx& X, const bf16* proj, const float* convw, const float* a_log, const float* dt_bias, unsigned char* ws, bf16* dnb) {
    LAS float* qf = (LAS float*)(X.lds + 0); LAS float* kf = (LAS float*)(X.lds + 16640); LAS float* vf = (LAS float*)(X.lds + 33280);
    LAS float* Ld = (LAS float*)(X.lds + 49920); LAS float* Tinv = (LAS float*)(X.lds + 55040);
    LAS float* cwb = (LAS float*)(X.lds + 60160);
    LAS float* hpar = (LAS float*)(X.lds + 63232);
    LAS bf16* Qb = (LAS bf16*)(X.lds + 67328); LAS bf16* Kb = (LAS bf16*)(X.lds + 76544); LAS bf16* KBb = (LAS bf16*)(X.lds + 85760);
    LAS float* gcv = (LAS float*)(X.lds + 94976); LAS float* betav = gcv + 64; LAS float* egv = gcv + 128; LAS float* ekv = gcv + 192; LAS float* gv = gcv + 256;
    LAS bf16* Lb = (LAS bf16*)(X.lds + 96256);
    LAS bf16* Xt = (LAS bf16*)(X.lds + 105472);
    const int tid = X.tid, lane = X.lane;
#define DNP_LOAD(u_, XR, BD) do { const int uu = (u_) < NBATCH * 6 * NCHUNK ? (u_) : X.vcu; const int b_ = uu / (6 * NCHUNK), h_ = (uu / NCHUNK) % 6, n_ = uu % NCHUNK; \
        _Pragma("unroll") for (int k = 0; k < 3; ++k) { const int it = tid + k * NTHR, t_ = it / 24, g8 = it % 24, which = g8 >> 3, col = (which == 0 ? C_DQ : (which == 1 ? C_DK : C_DV)) + h_ * 64 + (g8 & 7) * 8; \
            _Pragma("unroll") for (int j = 0; j < 4; ++j) { const int tt = n_ * 64 + t_ - 3 + j; XR[k][j] = *(const v4u*)(proj + ((size_t)b_ * SEQ + (tt < 0 ? 0 : tt)) * DINP + col); } \
            BD[k] = *(const unsigned*)(proj + ((size_t)b_ * SEQ + n_ * 64 + t_) * DINP + C_DB + 2 * (h_ >> 1)); } \
        if (tid < 64) BD[3] = *(const unsigned*)(proj + ((size_t)b_ * SEQ + n_ * 64 + tid) * DINP + C_DA + 2 * (h_ >> 1)); \
        if (tid < 192) cwq = *(const f32x4*)(convw + (tid / 48) * 1152 + (((tid % 48) * 4) >> 6) * 384 + h_ * 64 + (((tid % 48) * 4) & 63)); } while (0)
    v4u xr[3][4]; unsigned bd[4] = {0u, 0u, 0u, 0u}; f32x4 cwq = (f32x4){0.f, 0.f, 0.f, 0.f};
    DNP_LOAD(X.vcu, xr, bd);
    if (tid < 192) *(LAS f32x4*)(cwb + tid * 4) = cwq;
    if (tid < 6) { hpar[2 * tid] = -fexp(a_log[tid]); hpar[2 * tid + 1] = dt_bias[tid]; }
    SYNC();
    for (int u = X.vcu; u < NBATCH * 6 * NCHUNK; u += X.G) {
        const int b = u / (6 * NCHUNK), h = (u / NCHUNK) % 6, n = u % NCHUNK;
        bf16* ub = dnb + (size_t)u * 5 * 4096;
#pragma unroll
        for (int k = 0; k < 3; ++k) {
            const int it = tid + k * NTHR, t = it / 24, g8 = it % 24, which = g8 >> 3, d0 = (g8 & 7) * 8, cch = which * 384 + h * 64 + d0;
            float y[8];
#pragma unroll
            for (int i = 0; i < 8; ++i) y[i] = 0.f;
#pragma unroll
            for (int j = 0; j < 4; ++j) { v4u xw = xr[k][j]; if (n * 64 + t - 3 + j < 0) xw = (v4u){0u, 0u, 0u, 0u}; float xf[8]; unpack8(xw, xf);
                const f32x4 w0 = *(const LAS f32x4*)(cwb + j * 192 + which * 64 + d0), w1 = *(const LAS f32x4*)(cwb + j * 192 + which * 64 + d0 + 4);
                y[0] += w0.x * xf[0]; y[1] += w0.y * xf[1]; y[2] += w0.z * xf[2]; y[3] += w0.w * xf[3]; y[4] += w1.x * xf[4]; y[5] += w1.y * xf[5]; y[6] += w1.z * xf[6]; y[7] += w1.w * xf[7]; }
            float ss = 0.f;
#pragma unroll
            for (int i = 0; i < 8; ++i) { y[i] = silu(y[i]); ss += y[i] * y[i]; }
            ss = dpp_sum8(ss);
            const float sc = which == 2 ? 1.0f : frsq(ss + EPS) * (which == 0 ? 0.125f : 1.0f);
#pragma unroll
            for (int i = 0; i < 8; ++i) y[i] *= sc;
            LAS float* dst = (which == 0 ? qf : (which == 1 ? kf : vf)) + t * 65 + d0;
#pragma unroll
            for (int i = 0; i < 8; ++i) dst[i] = y[i];
            const float bt = sigm(bf2f((h & 1) ? (bd[k] >> 16) : (bd[k] & 0xffffu)));
            if (which == 0) *(LAS v4u*)(Qb + t * 72 + d0) = pack8(y);
            if (which == 1) { *(LAS v4u*)(Kb + t * 72 + d0) = pack8(y);
#pragma unroll
                for (int i = 0; i < 8; ++i) y[i] *= bt;
                *(LAS v4u*)(KBb + t * 72 + d0) = pack8(y); }
            if (which == 2 && d0 == 0) betav[t] = bt;
        }
        for (int i = tid; i < 128 * 72 / 2; i += NTHR) ((LAS unsigned*)Xt)[i] = 0u;
        if (tid < 64) gv[tid] = hpar[2 * h] * softplus(bf2f((h & 1) ? (bd[3] >> 16) : (bd[3] & 0xffffu)) + hpar[2 * h + 1]);
        SYNC();
        if (X.wave == 0) { float v = gv[lane];
#pragma unroll
            for (int o = 1; o < 64; o <<= 1) { const float up = bperm_f(lane - o, v); if (lane >= o) v += up; }
            const float gl = bperm_f(63, v);
            gcv[lane] = v; egv[lane] = fexp(v); ekv[lane] = fexp(gl - v);
            if (lane == 63) ((float*)(ws + WS_DNDEC))[u] = fexp(gl); }
        const int tr = X.wave >> 1, r = lane & 15, q = lane >> 4, tc0 = (X.wave & 1) * 2;
        f32x4 akk0, akk1, aqk0, aqk1;
        { const f32x4 z = (f32x4){0.f, 0.f, 0.f, 0.f};
            const LAS bf16* pa = KBb + (16 * tr + r) * 72 + q * 8; const LAS bf16* pq = Qb + (16 * tr + r) * 72 + q * 8; const LAS bf16* pb = Kb + (16 * tc0 + r) * 72 + q * 8;
            const bf16x8 a0 = LDF(pa), a1 = LDF(pa + 32), q0 = LDF(pq), q1 = LDF(pq + 32), b00 = LDF(pb), b01 = LDF(pb + 32), b10 = LDF(pb + 16 * 72), b11 = LDF(pb + 16 * 72 + 32);
            akk0 = MFMA16(a0, b00, z); akk1 = MFMA16(a0, b10, z); aqk0 = MFMA16(q0, b00, z); aqk1 = MFMA16(q0, b10, z);
            akk0 = MFMA16(a1, b01, akk0); akk1 = MFMA16(a1, b11, akk1); aqk0 = MFMA16(q1, b01, aqk0); aqk1 = MFMA16(q1, b11, aqk1); }
        SYNC();
#pragma unroll
        for (int e = 0; e < 2; ++e) { const int tc = tc0 + e; const f32x4 akk = e == 0 ? akk0 : akk1, aqk = e == 0 ? aqk0 : aqk1;
            const int j = 16 * tc + r; const float gj = gcv[j];
#pragma unroll
            for (int ii = 0; ii < 4; ++ii) { const int i = 16 * tr + q * 4 + ii; const float dec = fexp(fminf(gcv[i] - gj, 0.f));
                const float lv = (j < i) ? akk[ii] * dec : 0.f;
                Lb[i * 72 + j] = (bf16)f2bf(lv);
                if (tr == tc) Ld[tr * 320 + (q * 4 + ii) * 20 + r] = lv;
                ub[4 * 4096 + i * 64 + j] = (bf16)f2bf((j <= i) ? aqk[ii] * dec : 0.f); } }
        if ((tr >> 1) == (X.wave & 1)) {
            asm volatile("s_waitcnt lgkmcnt(0)" ::: "memory");
            if (lane < 16) { const int c = lane; const LAS float* Lp = Ld + tr * 320;
                f32x4 Lr[16][4];
#define DNP_LROWS(m0_, m1_) _Pragma("unroll") for (int m = (m0_); m <= (m1_); ++m) _Pragma("unroll") for (int v = 0; v <= (m - 1) / 4; ++v) Lr[m][v] = *(const LAS f32x4*)(Lp + m * 20 + 4 * v)
#define DNP_TROWS(m0_, m1_) _Pragma("unroll") for (int m = (m0_); m <= (m1_); ++m) { float s = fmaxf(0.f, 1.0f - fabsf(cf - (float)m));   \
                    _Pragma("unroll") for (int k = 0; k < m; ++k) s -= Lr[m][k >> 2][k & 3] * tcol[k]; tcol[m] = s; }
                float cf = (float)c; asm volatile("" : "+v"(cf));
                float tcol[16];
                DNP_LROWS(1, 8); DNP_LROWS(9, 12);
                asm volatile("" ::: "memory");
                DNP_TROWS(0, 8);
                asm volatile("" ::: "memory");
                DNP_LROWS(13, 15);
                asm volatile("" ::: "memory");
                DNP_TROWS(9, 12);
                DNP_TROWS(13, 15);
#undef DNP_LROWS
#undef DNP_TROWS
#pragma unroll
                for (int m = 0; m < 16; ++m) Tinv[tr * 320 + m * 20 + c] = tcol[m]; }
        }
        for (int it = tid; it < 1024; it += NTHR) {
            float f[8];
            if (it < 512) { const int d = it >> 3, t0 = (it & 7) * 8;
#pragma unroll
                for (int i = 0; i < 8; ++i) f[i] = kf[(t0 + i) * 65 + d] * ekv[t0 + i];
                *(v4u*)(ub + 2 * 4096 + d * 64 + t0) = pack8(f);
            } else { const int i2 = it - 512, t = i2 >> 3, d0 = (i2 & 7) * 8; const float e = egv[t];
#pragma unroll
                for (int i = 0; i < 8; ++i) f[i] = qf[t * 65 + d0 + i] * e;
                *(v4u*)(ub + 3 * 4096 + t * 64 + d0) = pack8(f); }
        }
        SYNC();
        DNP_LOAD(u + X.G, xr, bd);
        { const int r = lane & 15, q = lane >> 4, c = 16 * X.wave + r; const bool isW = X.wave >= 4; const int cc = c & 63;
            f32x4 rhs[4], tfv[4];
            { const LAS float* src = (isW ? kf : vf) + cc;
#pragma unroll
                for (int i = 0; i < 4; ++i) { const int row = 16 * i + q * 4; f32x4 sc = *(const LAS f32x4*)(betav + row); if (isW) sc = sc * *(const LAS f32x4*)(egv + row);
                    rhs[i] = (f32x4){src[row * 65] * sc.x, src[(row + 1) * 65] * sc.y, src[(row + 2) * 65] * sc.z, src[(row + 3) * 65] * sc.w};
                    tfv[i] = *(const LAS f32x4*)(Tinv + i * 320 + r * 20 + 4 * q); } }
#pragma unroll
            for (int i = 0; i < 4; ++i) {
                f32x4 acc = (f32x4){0.f, 0.f, 0.f, 0.f};
                if (i > 0) { if (i < 3) acc = mm16<32>(Lb + 16 * i * 72, 72, Xt + 16 * X.wave * 72, 72, acc, lane); else acc = mm16<64>(Lb + 16 * i * 72, 72, Xt + 16 * X.wave * 72, 72, acc, lane); }
                const f32x4 tf = tfv[i];
                const f32x4 y = rhs[i] - acc;
                f32x4 xo = (f32x4){0.f, 0.f, 0.f, 0.f};
                xo = __builtin_amdgcn_mfma_f32_16x16x4f32(tf[0], y[0], xo, 0, 0, 0);
                xo = __builtin_amdgcn_mfma_f32_16x16x4f32(tf[1], y[1], xo, 0, 0, 0);
                xo = __builtin_amdgcn_mfma_f32_16x16x4f32(tf[2], y[2], xo, 0, 0, 0);
                xo = __builtin_amdgcn_mfma_f32_16x16x4f32(tf[3], y[3], xo, 0, 0, 0);
                const u32x2 pk = pack4(xo[0], xo[1], xo[2], xo[3]);
                *(LAS u32x2*)(Xt + c * 72 + 16 * i + q * 4) = pk;
                if (!isW) *(u32x2*)(ub + 1 * 4096 + cc * 64 + 16 * i + q * 4) = pk;
                else {
#pragma unroll
                    for (int ii = 0; ii < 4; ++ii) ub[(16 * i + q * 4 + ii) * 64 + cc] = (bf16)f2bf(xo[ii]); }
                asm volatile("s_waitcnt lgkmcnt(0)" ::: "memory");
            }
        }
        if (tid < 192) *(LAS f32x4*)(cwb + tid * 4) = cwq;
        SYNC();
    }
#undef DNP_LOAD
}

DI void dn_chain(const Ctx& X, int bh, const bf16* proj, const float* normw, const unsigned char* ws, const bf16* dnb, bf16* merged) {
    LAS bf16* Wl = (LAS bf16*)(X.lds + 0); LAS bf16* Utl = (LAS bf16*)(X.lds + 9216); LAS bf16* KEl = (LAS bf16*)(X.lds + 18432); LAS bf16* QDl = (LAS bf16*)(X.lds + 27648); LAS bf16* QKl = (LAS bf16*)(X.lds + 36864);
    LAS bf16* St0 = (LAS bf16*)(X.lds + 46080); LAS bf16* Vtl = (LAS bf16*)(X.lds + 64512); LAS float* Of = (LAS float*)(X.lds + 73728);
    const int tid = X.tid, lane = X.lane, b = bh / 6, h = bh % 6;
    const int prow = tid >> 3, pseg = (tid & 7) * 8;
    const int tr = X.wave >> 1, tc0 = (X.wave & 1) * 2, r = lane & 15, q = lane >> 4;
    const bf16* ubase = dnb + (size_t)bh * NCHUNK * 5 * 4096 + prow * 64 + pseg;
    const bf16* zbase = proj + ((size_t)b * SEQ + prow) * DINP + C_DZ + h * 64 + pseg;
    const float decl = ((const float*)(ws + WS_DNDEC))[bh * NCHUNK + lane];
    float nwv[8];
#pragma unroll
    for (int i = 0; i < 8; ++i) nwv[i] = normw[pseg + i];
    for (int i = tid; i < 2 * 64 * 72 / 2; i += NTHR) ((LAS unsigned*)St0)[i] = 0u;
    v4u pfE[5], pfO[5], dzE, dzO;
#pragma unroll
    for (int k = 0; k < 5; ++k) { pfE[k] = *(const v4u*)(ubase + k * 4096); pfO[k] = *(const v4u*)(ubase + (size_t)5 * 4096 + k * 4096); }
    dzE = *(const v4u*)zbase; dzO = *(const v4u*)(zbase + (size_t)64 * DINP);
#pragma unroll
    for (int k = 0; k < 5; ++k) *(LAS v4u*)(Wl + k * 4608 + prow * 72 + pseg) = pfE[k];
    f32x4 sreg0 = (f32x4){0.f, 0.f, 0.f, 0.f}, sreg1 = sreg0;
    const LAS bf16* aW = Wl + (16 * tr + r) * 72 + q * 8; const LAS bf16* aKE = KEl + (16 * tr + r) * 72 + q * 8; const LAS bf16* aQD = QDl + (16 * tr + r) * 72 + q * 8; const LAS bf16* aQK = QKl + (16 * tr + r) * 72 + q * 8;
    const int bo0 = (16 * tc0 + r) * 72 + q * 8, bo1 = bo0 + 16 * 72;
    const int co0 = (16 * tc0 + r) * 72 + 16 * tr + q * 4, co1 = co0 + 16 * 72;
    SYNC();
#define DN_OUT(nn, OFB, DZV) do { float o[8]; const f32x4 oa = *(const LAS f32x4*)((OFB) + prow * 68 + pseg), ob = *(const LAS f32x4*)((OFB) + prow * 68 + pseg + 4); \
          o[0] = oa.x; o[1] = oa.y; o[2] = oa.z; o[3] = oa.w; o[4] = ob.x; o[5] = ob.y; o[6] = ob.z; o[7] = ob.w; \
          float ss = 0.f; _Pragma("unroll") for (int i = 0; i < 8; ++i) ss += o[i] * o[i]; \
          ss = dpp_sum8(ss); const float rstd = frsq(ss * (1.0f / 64.0f) + EPS); \
          float zf[8]; unpack8(DZV, zf); _Pragma("unroll") for (int i = 0; i < 8; ++i) o[i] = o[i] * rstd * nwv[i] * silu(zf[i]); \
          *(v4u*)(merged + ((size_t)b * SEQ + (size_t)(nn) * 64 + prow) * D + 640 + h * 64 + pseg) = pack8(o); } while (0)
#define DN_ITER(n, DZC, PFF, DZF, PFS) do { \
        const v4u dzv = DZC; \
        { const int n2 = (n) + 2 < NCHUNK ? (n) + 2 : NCHUNK - 1; const bf16* up = ubase + (size_t)n2 * 5 * 4096; \
          _Pragma("unroll") for (int k = 0; k < 5; ++k) PFF[k] = *(const v4u*)(up + k * 4096); \
          DZF = *(const v4u*)(zbase + (size_t)n2 * 64 * DINP); } \
        const float dec = __builtin_bit_cast(float, __builtin_amdgcn_readlane(__builtin_bit_cast(int, decl), (n))); \
        LAS bf16* Sc = St0 + cur * 4608; LAS bf16* Sn = St0 + (cur ^ 1) * 4608; LAS float* Ofc = Of + cur * 4352; LAS float* Ofp = Of + (cur ^ 1) * 4352; \
        const f32x4 z = (f32x4){0.f, 0.f, 0.f, 0.f}; \
          \
        const bf16x8 w0 = LDF(aW), w1 = LDF(aW + 32), s00 = LDF(Sc + bo0), s01 = LDF(Sc + bo0 + 32), s10 = LDF(Sc + bo1), s11 = LDF(Sc + bo1 + 32); \
        const u32x2 ut0 = *(const LAS u32x2*)(Utl + co0), ut1 = *(const LAS u32x2*)(Utl + co1); \
        f32x4 a0 = MFMA16(w0, s00, z), a1 = MFMA16(w0, s10, z); a0 = MFMA16(w1, s01, a0); a1 = MFMA16(w1, s11, a1); \
        { float u0[4], u1[4]; unpack4(ut0, u0); unpack4(ut1, u1); \
          *(LAS u32x2*)(Vtl + co0) = pack4(u0[0] - a0[0], u0[1] - a0[1], u0[2] - a0[2], u0[3] - a0[3]); \
          *(LAS u32x2*)(Vtl + co1) = pack4(u1[0] - a1[0], u1[1] - a1[1], u1[2] - a1[2], u1[3] - a1[3]); } \
        const bf16x8 ke0 = LDF(aKE), ke1 = LDF(aKE + 32), qd0 = LDF(aQD), qd1 = LDF(aQD + 32), qk0 = LDF(aQK), qk1 = LDF(aQK + 32); \
        SYNC(); \
          \
        const bf16x8 v00 = LDF(Vtl + bo0), v01 = LDF(Vtl + bo0 + 32), v10 = LDF(Vtl + bo1), v11 = LDF(Vtl + bo1 + 32); \
        f32x4 o0 = MFMA16(qd0, s00, z), o1 = MFMA16(qd0, s10, z); o0 = MFMA16(qd1, s01, o0); o1 = MFMA16(qd1, s11, o1); \
        f32x4 n0 = MFMA16(ke0, v00, z), n1 = MFMA16(ke0, v10, z); \
        o0 = MFMA16(qk0, v00, o0); o1 = MFMA16(qk0, v10, o1); \
        n0 = MFMA16(ke1, v01, n0); n1 = MFMA16(ke1, v11, n1); \
        o0 = MFMA16(qk1, v01, o0); o1 = MFMA16(qk1, v11, o1); \
        if ((n) > 0) DN_OUT((n) - 1, Ofp, dzp);     \
        sreg0 = sreg0 * dec + n0; sreg1 = sreg1 * dec + n1; \
        *(LAS u32x2*)(Sn + co0) = pack4(sreg0[0], sreg0[1], sreg0[2], sreg0[3]); *(LAS u32x2*)(Sn + co1) = pack4(sreg1[0], sreg1[1], sreg1[2], sreg1[3]); \
        _Pragma("unroll") for (int i = 0; i < 4; ++i) { Ofc[(16 * tr + q * 4 + i) * 68 + 16 * tc0 + r] = o0[i]; Ofc[(16 * tr + q * 4 + i) * 68 + 16 * tc0 + 16 + r] = o1[i]; } \
        _Pragma("unroll") for (int k = 0; k < 5; ++k) *(LAS v4u*)(Wl + k * 4608 + prow * 72 + pseg) = PFS[k]; \
        SYNC(); dzp = dzv; cur ^= 1; } while (0)
    int cur = 0; v4u dzp = dzE;
    for (int n = 0; n < NCHUNK; n += 2) {
        DN_ITER(n, dzE, pfE, dzE, pfO);
        DN_ITER(n + 1, dzO, pfO, dzO, pfE);
    }
    DN_OUT(NCHUNK - 1, Of + (cur ^ 1) * 4352, dzp);
    SYNC();
#undef DN_ITER
#undef DN_OUT
}

DI void gla_prep_phase(const Ctx& X, const bf16* proj, const float* w2, const float* b2, unsigned char* ws) {
    LAS float* W2s = (LAS float*)(X.lds + 0); LAS float* b2s = (LAS float*)(X.lds + 2048);
    LAS float* la = (LAS float*)(X.lds + 2304);
    LAS float* tot = (LAS float*)(X.lds + 10752);
    LAS bf16* QDl = (LAS bf16*)(X.lds + 12800); LAS bf16* KDl = (LAS bf16*)(X.lds + 17920);
    LAS bf16* KEl = (LAS bf16*)(X.lds + 23040);
    LAS bf16* Vtl = (LAS bf16*)(X.lds + 27648); LAS bf16* Pl = (LAS bf16*)(X.lds + 36864);
    const int tid = X.tid, lane = X.lane, t = tid >> 3, part = tid & 7, r = lane & 15, q = lane >> 4;
#define GLAP_LOAD(u_, Q4, K4, V8, G0, G1, WV, BV) do { const int uu = (u_) < NBATCH * 6 * NCHUNK ? (u_) : X.vcu; const int b_ = uu / (6 * NCHUNK), h_ = (uu / NCHUNK) % 6, n_ = uu % NCHUNK; \
        const bf16* pr_ = proj + ((size_t)b_ * SEQ + (size_t)n_ * 64 + t) * DINP; \
        Q4 = *(const u32x2*)(pr_ + C_GQ + h_ * 32 + part * 4); K4 = *(const u32x2*)(pr_ + C_GK + h_ * 32 + part * 4); V8 = *(const v4u*)(pr_ + C_GV + h_ * 64 + part * 8); \
        G0 = *(const v4u*)(pr_ + C_GLR); G1 = *(const v4u*)(pr_ + C_GLR + 8); WV = w2[(tid >> 5) * 192 + h_ * 32 + (tid & 31)]; BV = b2[h_ * 32 + (tid & 31)]; } while (0)
    u32x2 q4, k4, q4n, k4n; v4u v8, g0, g1, v8n, g0n, g1n; float wv, bv, wvn, bvn;
    GLAP_LOAD(X.vcu, q4, k4, v8, g0, g1, wv, bv);
    for (int u = X.vcu; u < NBATCH * 6 * NCHUNK; u += X.G) {
        const int b = u / (6 * NCHUNK), h = (u / NCHUNK) % 6, n = u % NCHUNK;
        bf16* ub = (bf16*)(ws + WS_GLA) + (size_t)u * 8192;
        W2s[tid] = wv;
        if (tid < 32) b2s[tid] = bv;
        GLAP_LOAD(u + X.G, q4n, k4n, v8n, g0n, g1n, wvn, bvn);
        SYNC();
        { float gl[16]; { float t0[8], t1[8]; unpack8(g0, t0); unpack8(g1, t1);
#pragma unroll
                for (int i = 0; i < 8; ++i) { gl[i] = t0[i]; gl[8 + i] = t1[i]; } }
            f32x4 zz = *(const LAS f32x4*)(b2s + part * 4);
#pragma unroll
            for (int rr = 0; rr < 16; ++rr) zz += *(const LAS f32x4*)(W2s + rr * 32 + part * 4) * gl[rr];
#pragma unroll
            for (int cc = 0; cc < 4; ++cc) la[t * 33 + part * 4 + cc] = -softplus(-zz[cc]) * (1.0f / 16.0f); }
        SYNC();
        const int cc2 = tid & 31, seg = tid >> 5;
        const float l0 = la[(seg * 4 + 0) * 33 + cc2], l1 = l0 + la[(seg * 4 + 1) * 33 + cc2], l2 = l1 + la[(seg * 4 + 2) * 33 + cc2], l3 = l2 + la[(seg * 4 + 3) * 33 + cc2];
        tot[seg * 32 + cc2] = l3;
        SYNC();
        { float off = 0.f;
#pragma unroll
            for (int s2 = 0; s2 < 15; ++s2) off += (s2 < seg) ? tot[s2 * 32 + cc2] : 0.f;
            la[(seg * 4 + 0) * 33 + cc2] = off + l0; la[(seg * 4 + 1) * 33 + cc2] = off + l1; la[(seg * 4 + 2) * 33 + cc2] = off + l2; la[(seg * 4 + 3) * 33 + cc2] = off + l3; }
        SYNC();
        { float qf[4], kf[4]; unpack4(q4, qf); unpack4(k4, kf); float qd[4], kd[4];
#pragma unroll
            for (int cc = 0; cc < 4; ++cc) { const int c = part * 4 + cc; const float bc = la[t * 33 + c], bl = la[63 * 33 + c];
                qd[cc] = qf[cc] * 0.17677669529663687f * fexp(bc); kd[cc] = kf[cc] * fexp(-bc);
                KEl[c * 72 + t] = (bf16)f2bf(kf[cc] * fexp(bl - bc)); }
            const u32x2 qp = pack4(qd[0], qd[1], qd[2], qd[3]);
            *(LAS u32x2*)(QDl + t * 40 + part * 4) = qp; *(u32x2*)(ub + t * 32 + part * 4) = qp;
            *(LAS u32x2*)(KDl + t * 40 + part * 4) = pack4(kd[0], kd[1], kd[2], kd[3]);
            const unsigned vw[4] = {v8.x, v8.y, v8.z, v8.w};
#pragma unroll
            for (int i = 0; i < 4; ++i) { Vtl[(part * 8 + 2 * i) * 72 + t] = (bf16)(vw[i] & 0xffffu); Vtl[(part * 8 + 2 * i + 1) * 72 + t] = (bf16)(vw[i] >> 16); }
            if (tid < 32) ((float*)(ws + WS_GLADEC))[(size_t)u * 32 + tid] = fexp(la[63 * 33 + tid]); }
        SYNC();
        { const f32x4 z = (f32x4){0.f, 0.f, 0.f, 0.f}; const int trs = X.wave >> 1;
#pragma unroll
            for (int e = 0; e < 2; ++e) { const int tct = (X.wave & 1) * 2 + e;
                const f32x4 a = mm16<32>(KDl + 16 * trs * 40, 40, QDl + 16 * tct * 40, 40, z, lane);
                const int tq = 16 * tct + r, s0 = 16 * trs + q * 4;
                *(LAS u32x2*)(Pl + tq * 72 + s0) = pack4(s0 <= tq ? a[0] : 0.f, s0 + 1 <= tq ? a[1] : 0.f, s0 + 2 <= tq ? a[2] : 0.f, s0 + 3 <= tq ? a[3] : 0.f); }
            const int trS = X.wave >> 2, tcS = X.wave & 3;
            const f32x4 a = mm16<64>(KEl + 16 * trS * 72, 72, Vtl + 16 * tcS * 72, 72, z, lane);
            *(u32x2*)(ub + 6144 + ((trS * 4 + tcS) * 64 + lane) * 4) = pack4(a[0], a[1], a[2], a[3]); }
        SYNC();
        { const f32x4 z = (f32x4){0.f, 0.f, 0.f, 0.f}; const int tr = X.wave >> 1;
#pragma unroll
            for (int e = 0; e < 2; ++e) { const int tc = (X.wave & 1) * 2 + e;
                const f32x4 o = mm16<64>(Pl + 16 * tr * 72, 72, Vtl + 16 * tc * 72, 72, z, lane);
                *(u32x2*)(ub + 2048 + ((tr * 4 + tc) * 64 + lane) * 4) = pack4(o[0], o[1], o[2], o[3]); } }
        q4 = q4n; k4 = k4n; v8 = v8n; g0 = g0n; g1 = g1n; wv = wvn; bv = bvn;
        SYNC();
    }
#undef GLAP_LOAD
}
DI void gla_chain(const Ctx& X, int bh, const bf16* proj, const float* normw, const unsigned char* ws, bf16* merged) {
    LAS bf16* St0 = (LAS bf16*)(X.lds + 0);
    LAS float* Of0 = (LAS float*)(X.lds + 10240);
    const int tid = X.tid, lane = X.lane, b = bh / 6, h = bh % 6;
    const int t = tid >> 3, part = tid & 7, r = lane & 15, q = lane >> 4;
    const int tr = X.wave >> 1, tc0 = (X.wave & 1) * 2, trS = X.wave >> 2, tcS = X.wave & 3;
    for (int i = tid; i < 2 * 64 * 40 / 2; i += NTHR) ((LAS unsigned*)St0)[i] = 0u;
    float nwv[8];
#pragma unroll
    for (int i = 0; i < 8; ++i) nwv[i] = normw[part * 8 + i];
    const bf16* ub0 = (const bf16*)(ws + WS_GLA) + (size_t)bh * NCHUNK * 8192;
    const float* dp0 = (const float*)(ws + WS_GLADEC) + (size_t)bh * NCHUNK * 32;
    const bf16* zp0 = proj + ((size_t)b * SEQ + t) * DINP + C_GZ + h * 64 + part * 8;
    f32x4 sreg = (f32x4){0.f, 0.f, 0.f, 0.f};
#define GLA_LOAD(n, QD, OI0, OI1, KV, DC, Z) do { const int n4 = (n) < NCHUNK ? (n) : NCHUNK - 1; const bf16* ubn = ub0 + (size_t)n4 * 8192; \
        QD = *(const v4u*)(ubn + (16 * tr + r) * 32 + q * 8); \
        OI0 = *(const u32x2*)(ubn + 2048 + ((tr * 4 + tc0) * 64 + lane) * 4); OI1 = *(const u32x2*)(ubn + 2048 + ((tr * 4 + tc0 + 1) * 64 + lane) * 4); \
        KV = *(const u32x2*)(ubn + 6144 + ((trS * 4 + tcS) * 64 + lane) * 4); \
        DC = *(const f32x4*)(dp0 + (size_t)n4 * 32 + 16 * trS + 4 * q); \
        Z = *(const v4u*)(zp0 + (size_t)n4 * 64 * DINP); } while (0)
    v4u qdA, qdB, qdC, qdD, zA, zB, zC, zD; u32x2 o0A, o1A, kvA, o0B, o1B, kvB, o0C, o1C, kvC, o0D, o1D, kvD; f32x4 dcA, dcB, dcC, dcD;
    GLA_LOAD(0, qdA, o0A, o1A, kvA, dcA, zA); GLA_LOAD(1, qdB, o0B, o1B, kvB, dcB, zB); GLA_LOAD(2, qdC, o0C, o1C, kvC, dcC, zC); GLA_LOAD(3, qdD, o0D, o1D, kvD, dcD, zD);
    SYNC();
    int cur = 0;
#define GLA_ITER(n, QD, OI0, OI1, KV, DC, Z) do { \
        LAS bf16* Sc = St0 + cur * 2560; LAS bf16* Sn = St0 + (cur ^ 1) * 2560; LAS float* Of = Of0 + cur * 4352; \
        const bf16x8 qa = __builtin_bit_cast(bf16x8, QD); \
        const bf16x8 sb0 = LDF(Sc + (16 * tc0 + r) * 40 + q * 8), sb1 = LDF(Sc + (16 * tc0 + 16 + r) * 40 + q * 8); \
        const f32x4 z = (f32x4){0.f, 0.f, 0.f, 0.f}; \
        const f32x4 oa = MFMA16(qa, sb0, z), ob = MFMA16(qa, sb1, z); \
        { float f0[4], f1[4]; unpack4(OI0, f0); unpack4(OI1, f1); \
          _Pragma("unroll") for (int i = 0; i < 4; ++i) { Of[(16 * tr + q * 4 + i) * 68 + 16 * tc0 + r] = oa[i] + f0[i]; Of[(16 * tr + q * 4 + i) * 68 + 16 * tc0 + 16 + r] = ob[i] + f1[i]; } } \
        { float kf[4]; unpack4(KV, kf); _Pragma("unroll") for (int i = 0; i < 4; ++i) sreg[i] = DC[i] * sreg[i] + kf[i]; \
          *(LAS u32x2*)(Sn + (16 * tcS + r) * 40 + 16 * trS + q * 4) = pack4(sreg[0], sreg[1], sreg[2], sreg[3]); } \
        SYNC(); \
        { float o[8]; const f32x4 p0 = *(const LAS f32x4*)(Of + t * 68 + part * 8), p1 = *(const LAS f32x4*)(Of + t * 68 + part * 8 + 4); \
          o[0] = p0.x; o[1] = p0.y; o[2] = p0.z; o[3] = p0.w; o[4] = p1.x; o[5] = p1.y; o[6] = p1.z; o[7] = p1.w; \
          float ss = 0.f; _Pragma("unroll") for (int i = 0; i < 8; ++i) ss += o[i] * o[i]; \
          ss = dpp_sum8(ss); const float rstd = frsq(ss * (1.0f / 64.0f) + EPS); \
          float zf[8]; unpack8(Z, zf); _Pragma("unroll") for (int i = 0; i < 8; ++i) o[i] = o[i] * rstd * nwv[i] * silu(zf[i]); \
          *(v4u*)(merged + ((size_t)b * SEQ + (size_t)(n) * 64 + t) * D + h * 64 + part * 8) = pack8(o); } \
        GLA_LOAD((n) + 4, QD, OI0, OI1, KV, DC, Z); \
        cur ^= 1; } while (0)
    for (int n = 0; n < NCHUNK; n += 4) {
        GLA_ITER(n, qdA, o0A, o1A, kvA, dcA, zA); GLA_ITER(n + 1, qdB, o0B, o1B, kvB, dcB, zB); GLA_ITER(n + 2, qdC, o0C, o1C, kvC, dcC, zC); GLA_ITER(n + 3, qdD, o0D, o1D, kvD, dcD, zD);
    }
#undef GLA_ITER
#undef GLA_LOAD
    SYNC();
}

template <bool PASSB> DI void lru_units(const Ctx& X, int first, int stride, const bf16* proj, const float* convw, const float* convb, const float* wa, const float* ba, const float* wx, const float* bx, const float* lam, unsigned char* ws, bf16* merged) {
    LAS bf16* WAt = (LAS bf16*)(X.lds + 0); LAS bf16* WXt = (LAS bf16*)(X.lds + 9216); LAS bf16* xrb = (LAS bf16*)(X.lds + 18432);
    LAS float* xrf = (LAS float*)(X.lds + 27648); LAS float* af = (LAS float*)(X.lds + 44288); LAS float* uf = (LAS float*)(X.lds + 60928);
    LAS float* cws = (LAS float*)(X.lds + 77568);
    const int tid = X.tid, lane = X.lane, nb = first & 3;
    const int t = tid >> 3, part = tid & 7, r = lane & 15, q = lane >> 4, tr = X.wave >> 1;
    if (first >= NBATCH * NCHUNK * 4) return;
    for (int i = tid; i < 4096; i += NTHR) { const int j = i >> 6, k = i & 63; WAt[k * 72 + j] = (bf16)f2bf(wa[(size_t)nb * 4096 + i]); WXt[k * 72 + j] = (bf16)f2bf(wx[(size_t)nb * 4096 + i]); }
    if (tid < 320) cws[tid] = tid < 256 ? convw[(tid >> 6) * 256 + nb * 64 + (tid & 63)] : convb[nb * 64 + (tid & 63)];
    float bav[2], bxv[2], spv[2];
#pragma unroll
    for (int e = 0; e < 2; ++e) { const int ch = nb * 64 + 16 * ((X.wave & 1) * 2 + e) + r; bav[e] = ba[ch]; bxv[e] = bx[ch]; spv[e] = softplus(-lam[ch]); }
    float* carry = (float*)(ws + WS_LRUC);
    LAS float* segA = (LAS float*)(X.lds + 78848); LAS float* segH = segA + 512;
#define LRU_LOAD(u_, XV, LG) do { const int uu = (u_) < NBATCH * NCHUNK * 4 ? (u_) : first; const int b_ = uu >> 8, n_ = (uu >> 2) & 63; \
        _Pragma("unroll") for (int j = 0; j < 4; ++j) { const int tt = n_ * 64 + t - 3 + j; XV[j] = *(const v4u*)(proj + ((size_t)b_ * SEQ + (tt < 0 ? 0 : tt)) * DINP + C_LX + nb * 64 + part * 8); } \
        if (PASSB) LG = *(const v4u*)(proj + ((size_t)b_ * SEQ + n_ * 64 + t) * DINP + C_LG + nb * 64 + part * 8); } while (0)
    v4u xv[4], xn[4], lg8 = (v4u){0u, 0u, 0u, 0u}, lgn = (v4u){0u, 0u, 0u, 0u};
    LRU_LOAD(first, xv, lg8);
    SYNC();
    for (int u = first; u < NBATCH * NCHUNK * 4; u += stride) {
        const int b = u >> 8, n = (u >> 2) & 63;
        const size_t row = (size_t)b * SEQ + (size_t)n * 64 + t;
        LRU_LOAD(u + stride, xn, lgn);
        float hreg = 0.f;
        if (PASSB) {
            const float* cp = carry + ((size_t)(b * 64) * 4 + nb) * 128 + lane; float ca[8], ch[8];
#pragma unroll
            for (int j = 0; j < 8; ++j) { const int m = 8 * X.wave + j; const bool ok = m < n; ca[j] = ok ? cp[(size_t)m * 512] : 1.0f; ch[j] = ok ? cp[(size_t)m * 512 + 64] : 0.0f; }
            float fa = 1.f, fh = 0.f;
#pragma unroll
            for (int j = 0; j < 8; ++j) { fh = ca[j] * fh + ch[j]; fa *= ca[j]; }
            segA[X.wave * 64 + lane] = fa; segH[X.wave * 64 + lane] = fh;
        }
        { float y[8];
#pragma unroll
            for (int i = 0; i < 8; ++i) y[i] = cws[256 + part * 8 + i];
#pragma unroll
            for (int j = 0; j < 4; ++j) { const int tt = n * 64 + t - 3 + j; const float msk = tt >= 0 ? 1.0f : 0.0f; float xf[8]; unpack8(xv[j], xf);
#pragma unroll
                for (int i = 0; i < 8; ++i) y[i] += cws[j * 64 + part * 8 + i] * (xf[i] * msk); }
#pragma unroll
            for (int i = 0; i < 8; ++i) xrf[t * 65 + part * 8 + i] = y[i];
            *(LAS v4u*)(xrb + t * 72 + part * 8) = pack8(y); }
        SYNC();
        { const f32x4 z = (f32x4){0.f, 0.f, 0.f, 0.f};
#pragma unroll
            for (int e = 0; e < 2; ++e) { const int tc = (X.wave & 1) * 2 + e, ch = 16 * tc + r;
                const f32x4 ar = mm16<64>(xrb + 16 * tr * 72, 72, WAt + 16 * tc * 72, 72, z, lane);
                const f32x4 ai = mm16<64>(xrb + 16 * tr * 72, 72, WXt + 16 * tc * 72, 72, z, lane);
#pragma unroll
                for (int i = 0; i < 4; ++i) { const int tt = 16 * tr + q * 4 + i;
                    const float rr = sigm(ar[i] + bav[e]), ig = sigm(ai[i] + bxv[e]), lga = -8.0f * rr * spv[e];
                    af[tt * 65 + ch] = fexp(lga); uf[tt * 65 + ch] = __builtin_amdgcn_sqrtf(1.0f - fexp(2.0f * lga)) * ig * xrf[tt * 65 + ch]; } } }
        SYNC();
        if (X.wave == 7) {
            if (PASSB) {
#pragma unroll
                for (int g = 0; g < 8; ++g) hreg = segA[g * 64 + lane] * hreg + segH[g * 64 + lane];
#pragma unroll 8
                for (int tt = 0; tt < 64; ++tt) { hreg = af[tt * 65 + lane] * hreg + uf[tt * 65 + lane]; uf[tt * 65 + lane] = hreg; }
            } else { float pa = 1.f;
#pragma unroll 8
                for (int tt = 0; tt < 64; ++tt) { const float a = af[tt * 65 + lane]; hreg = a * hreg + uf[tt * 65 + lane]; pa *= a; }
                carry[(size_t)u * 128 + lane] = pa; carry[(size_t)u * 128 + 64 + lane] = hreg; }
        }
        SYNC();
        if (PASSB) { float gf[8], o[8]; unpack8(lg8, gf);
#pragma unroll
            for (int i = 0; i < 8; ++i) o[i] = uf[t * 65 + part * 8 + i] * gelu_tanh(gf[i]);
            *(v4u*)(merged + row * D + 384 + nb * 64 + part * 8) = pack8(o); }
#pragma unroll
        for (int j = 0; j < 4; ++j) xv[j] = xn[j];
        lg8 = lgn;
    }
#undef LRU_LOAD
    SYNC();
}
constexpr int TAIL_SLICES = MOE_DOWN_F8 ? 2 : 4;

constexpr int N_PHASES = 19;
constexpr int MOE_ITEMS = 3 * NEXP * 1792;
#ifndef REP_PROL
#define REP_PROL 1
#endif
#ifndef REP_NORM
#define REP_NORM 1
#endif
#ifndef REP_INPROJ
#define REP_INPROJ 1
#endif
#ifndef REP_PREP
#define REP_PREP 1
#endif
#ifndef REP_CHAIN
#define REP_CHAIN 1
#endif
#ifndef REP_FFNGU
#define REP_FFNGU 1
#endif
#ifndef REP_MOEGU
#define REP_MOEGU 1
#endif
#ifndef REP_MOEDN
#define REP_MOEDN 1
#endif
#ifndef STAGGER_TICKS
#define STAGGER_TICKS 0
#endif
#ifndef REP_OUTPROJ
#define REP_OUTPROJ 1
#endif
#ifndef REP_FFNDN
#define REP_FFNDN 1
#endif
#ifndef REP_COMBINE
#define REP_COMBINE 1
#endif
#ifndef REP_MOEDN_TAIL
#define REP_MOEDN_TAIL 1
#endif
#ifndef REP_DNP
#define REP_DNP 1
#endif
#ifndef REP_GLAP
#define REP_GLAP 1
#endif
#ifndef REP_LRUA
#define REP_LRUA 1
#endif
#ifndef REP_DNC
#define REP_DNC 1
#endif
#ifndef REP_GLAC
#define REP_GLAC 1
#endif
#ifndef REP_LRUB
#define REP_LRUB 1
#endif
#define REPEAT(n) for (int rep_ = 0; rep_ < (n); ++rep_)
struct Args { In in; float* out; unsigned char* ws; int ph_lo, ph_hi; };
__global__ void __launch_bounds__(NTHR, 2) hybrid_fwd(Args args) {
    extern __shared__ __attribute__((aligned(16))) unsigned char lds_raw[];
    Ctx X;
    const int wave_id = __builtin_amdgcn_readfirstlane((int)threadIdx.x >> 6);
#define MKCTX() do { int l_; asm volatile("v_mbcnt_lo_u32_b32 %0, -1, 0\n\tv_mbcnt_hi_u32_b32 %0, -1, %0" : "=v"(l_)); { GAS unsigned char* wsg_ = (GAS unsigned char*)args.ws; asm volatile("" : "+s"(wsg_)); ws = (unsigned char*)wsg_; } X.lds = (LAS unsigned char*)lds_raw; X.lane = l_; X.wave = wave_id; X.tid = wave_id * 64 + l_; \
        X.G = gridDim.x; { const int bx = blockIdx.x; X.vcu = (X.G % 8 == 0) ? (bx % 8) * (X.G / 8) + bx / 8 : bx; } X.gw = X.vcu * NWAVES + X.wave; X.NGW = X.G * NWAVES; } while (0)
    unsigned char* ws = args.ws;
    MKCTX();
    InT I; I.p.t = (const LAS unsigned long long*)(X.lds + PTR_OFF);
    gu32* ctl = (gu32*)(ws + WS_CTL);
    volatile LAS unsigned* MISC = (volatile LAS unsigned*)(X.lds + MISC_OFF);
    for (int u = X.tid; u < (LDS_BYTES - RING_BYTES) / 4; u += NTHR) ((LAS unsigned*)(X.lds + RING_BYTES))[u] = 0u;
#pragma unroll
    for (int k = 0; k < 30; ++k) if (X.tid == k) ((LAS unsigned long long*)(X.lds + PTR_OFF))[k] = (unsigned long long)args.in.p[k];
    __syncthreads();
#if MK_ONE_LAUNCH
    XcdBarrier bar = xcd_barrier_post((unsigned*)(ctl + CW_BAR), MISC + 8);
#define GRID_BAR() do { XcdBarrier b_ = bar; asm volatile("" : "+s"(b_.bar), "+s"(b_.x)); xcd_barrier(b_); } while (0)
#else
#define GRID_BAR() do {} while (0)
#endif
#if MK_ONE_LAUNCH
#define IN(k) true
#define SEAM(k) GRID_BAR()
#else
    const int lo = args.ph_lo, hi = args.ph_hi;
#define IN(k) (lo <= (k) && (k) < hi)
#define SEAM(k) do { if (IN(k) && IN((k) + 1)) GRID_BAR(); } while (0)
#endif
#define x_in (I.p[0])
#define xres ((bf16*)(ws + WS_XRES))
#define MOD ((float*)(ws + WS_MOD))
#define Hb ((bf16*)(ws + WS_H))
#define PROJ ((bf16*)(ws + WS_PROJ))
#define ring (X.lds)

    if (IN(0)) { MKCTX(); prologue_phase(X, I, ws); }
#if MK_ONE_LAUNCH
    { MKCTX(); mod_wait(X, ws); }
#endif
    if (IN(1)) { MKCTX(); REPEAT(REP_NORM) norm_phase<false, false>(X, x_in, I.p[18], MOD, 0, D, Hb, nullptr, ws); } SEAM(1);

    for (int L = 0; L < 2; ++L) {
        const int pb = 2 + 8 * L;
        const float* modL = MOD + (size_t)L * 8 * MODW;
        if (IN(pb)) { MKCTX();
#define CV_SPLIT() ((L * 22000) + (int)((blockIdx.x / 8) % 8) * ((int)gridDim.x - 128) * NWAVES)
#pragma nounroll
            for (int part = 0; part < 2; ++part) {
                if (blockIdx.x >= 128) { MKCTX(); moe_convert(X, I, ws, part == 0 ? L * 22000 : CV_SPLIT(), part == 0 ? CV_SPLIT() : L * 22000 + 8000, (int)blockIdx.x - 128, (int)X.G - 128); }
                if (part == 0) { __syncthreads(); MKCTX();
                    pg8::Gemm g{Hb, (const bf16*)(ws + WS_WIN) + (size_t)L * DINP * D, T, DINP, D}; pg8::StaticOrder S; S.init(T, DINP, X.G, (int)blockIdx.x);
                    pg8::EpiStoreBf16 E{PROJ, DINP};
                    pg8::gemm_phase<pg8::EpiStoreBf16, pg8::StaticOrder, true>(ring, g, S, E, wave_id); }
            }
#undef CV_SPLIT
        } SEAM(pb);
        if (IN(pb + 1)) { MKCTX();
            {
                REPEAT(REP_DNP) dn_prep_phase(X, PROJ, I.p[13] + (size_t)L * 4 * 1152, I.p[14] + L * 6, I.p[15] + L * 6, ws, (bf16*)args.out);
                REPEAT(REP_GLAP) gla_prep_phase(X, PROJ, I.p[3] + (size_t)L * 16 * 192, I.p[4] + L * 192, ws);
                REPEAT(REP_LRUA) lru_units<false>(X, X.vcu, X.G, PROJ, I.p[6] + (size_t)L * 4 * 256, I.p[7] + L * 256, I.p[8] + (size_t)L * 4 * 4096, I.p[9] + L * 256, I.p[10] + (size_t)L * 4 * 4096, I.p[11] + L * 256, I.p[12] + L * 256, ws, Hb);
            }
        } SEAM(pb + 1);
        if (IN(pb + 2)) { MKCTX();
            REPEAT(REP_CHAIN) for (int ru = (int)blockIdx.x; ru < 256; ru += X.G) {
                if (ru < 48) { MKCTX(); REPEAT(REP_DNC) dn_chain(X, ru, PROJ, I.p[16] + L * 64, ws, (const bf16*)args.out, Hb); }
                else if (ru < 96) { MKCTX(); REPEAT(REP_GLAC) gla_chain(X, ru - 48, PROJ, I.p[5] + L * 64, ws, Hb); }
                else { MKCTX(); REPEAT(REP_LRUB) lru_units<true>(X, ru - 96, 160, PROJ, I.p[6] + (size_t)L * 4 * 256, I.p[7] + L * 256, I.p[8] + (size_t)L * 4 * 4096, I.p[9] + L * 256, I.p[10] + (size_t)L * 4 * 4096, I.p[11] + L * 256, I.p[12] + L * 256, ws, Hb);
                       MKCTX(); moe_convert(X, I, ws, L * 22000 + 8000, L == 0 ? 22000 : MOE_ITEMS, ru - 96, 160); }
            }
        } SEAM(pb + 2);
        if (IN(pb + 3)) { MKCTX();
            pg8::Gemm g{Hb, (const bf16*)(ws + WS_WOUT) + (size_t)L * D * D, T, D, D}; pg8::StaticOrder S; S.init(T, D, X.G, (int)blockIdx.x);
            if (L == 0) { pg8::EpiRes32 E{x_in, xres, xres, modL + 2 * D}; pg8::gemm_phase<pg8::EpiRes32, pg8::StaticOrder, true>(ring, g, S, E, wave_id); }
            else { pg8::EpiRes E{nullptr, xres, xres, modL + 2 * D}; pg8::gemm_phase<pg8::EpiRes, pg8::StaticOrder, true>(ring, g, S, E, wave_id); }
        } SEAM(pb + 3);
        if (L == 0) {
            if (IN(6)) { MKCTX(); REPEAT(REP_NORM) norm_phase<false, true, DENSE_GU_F8 != 0>(X, xres, I.p[19], modL, 3 * D, 4 * D, Hb, nullptr, ws); } SEAM(6);
            if (IN(7)) { MKCTX();
#if DENSE_GU_F8
                pg8::Gemm g{Hb, (const bf16*)(ws + WS_WGU), T, 2 * DFF, D / 2, 0, 127 - 5, 127 - 10}; pg8::MoeOrder<true> S; S.init(T / 256, 2 * DFF, X.G, (int)blockIdx.x);
                S.tile_e = (LAS int*)(X.lds + TAB_OFF); S.list = nullptr; S.eB = 0;
#if DENSE_DN_F8
                pg8::EpiSwiglu8 E{PROJ, DFF};
                REPEAT(REP_FFNGU) pg8::gemm_phase<pg8::EpiSwiglu8, pg8::MoeOrder<true>, true>(ring, g, S, E, wave_id);
#else
                pg8::EpiSwigluB E{{PROJ, DFF}};
                REPEAT(REP_FFNGU) pg8::gemm_phase<pg8::EpiSwigluB, pg8::MoeOrder<true>, true>(ring, g, S, E, wave_id);
#endif
#else
                pg8::Gemm g{Hb, (const bf16*)(ws + WS_WGU), T, 2 * DFF, D}; pg8::StaticOrder S; S.init(T, 2 * DFF, X.G, (int)blockIdx.x);
#if DENSE_DN_F8
                pg8::EpiSwigluTo8 E{PROJ, DFF};
                REPEAT(REP_FFNGU) pg8::gemm_phase<pg8::EpiSwigluTo8, pg8::StaticOrder, true>(ring, g, S, E, wave_id);
#else
                pg8::EpiSwiglu E{PROJ, DFF};
                REPEAT(REP_FFNGU) pg8::gemm_phase<pg8::EpiSwiglu, pg8::StaticOrder, true>(ring, g, S, E, wave_id);
#endif
#endif
            } SEAM(7);
            if (IN(8)) { MKCTX();
#if DENSE_DN_F8
                pg8::Gemm g{PROJ, (const bf16*)(ws + WS_WDN), T, D, DFF / 2, 0, 127 - 3, 127 - 11}; pg8::MoeOrder<true> S; S.init(T / 256, D, X.G, (int)blockIdx.x);
                S.tile_e = (LAS int*)(X.lds + TAB_OFF); S.list = nullptr; S.eB = 0;
                pg8::EpiRes8 E{nullptr, xres, xres, modL + 5 * D};
                pg8::gemm_phase<pg8::EpiRes8, pg8::MoeOrder<true>, true>(ring, g, S, E, wave_id);
#else
                pg8::Gemm g{PROJ, (const bf16*)(ws + WS_WDN), T, D, DFF}; pg8::StaticOrder S; S.init(T, D, X.G, (int)blockIdx.x);
                pg8::EpiRes E{nullptr, xres, xres, modL + 5 * D};
                pg8::gemm_phase<pg8::EpiRes, pg8::StaticOrder, true>(ring, g, S, E, wave_id);
#endif
            } SEAM(8);
            if (IN(9)) { MKCTX(); REPEAT(REP_NORM) norm_phase<false, true, INPROJ1_F8 != 0>(X, xres, I.p[18] + D, MOD + (size_t)8 * MODW, 0, D, Hb, nullptr, ws); } SEAM(9);
        }
    }
    if (IN(14)) { MKCTX(); REPEAT(REP_NORM) norm_phase<true, true>(X, xres, I.p[19] + D, MOD + (size_t)8 * MODW, 3 * D, 4 * D, Hb, I.p[25], ws); } SEAM(14);
    if (IN(15)) { MKCTX(); moe_list_phase(X, ws); } SEAM(15);
    {
        LAS int* tab = (LAS int*)(X.lds + TAB_OFF);
        if (IN(16) || IN(17)) { __syncthreads(); if (X.tid < TILE_TAB) tab[X.tid] = ((const int*)(ws + WS_TILES))[X.tid]; __syncthreads(); }
        const int nM0 = __builtin_amdgcn_readfirstlane(tab[TILE_TAB - 2]), nM = __builtin_amdgcn_readfirstlane(tab[TILE_TAB - 1]);
        const int* list = (const int*)(ws + WS_LIST); const float* roww = (const float*)(ws + WS_ROWW);
        if (IN(16)) { MKCTX();
            pg8::Gemm g{Hb, (const bf16*)(ws + WS_MOEGU), 2 * MOE_ROWS, 2 * DFFE, D / 2, 0, 127 - 5, 127 - 10}; pg8::MoeOrder<true> S; S.init(nM, 2 * DFFE, X.G, (int)blockIdx.x);
            S.tile_e = tab; S.list = list; S.eB = (size_t)2 * DFFE * D; S.rowtab = (LAS int*)(X.lds + ROWTAB_OFF);
            pg8::EpiSwiglu8 E{PROJ, DFFE};
            REPEAT(REP_MOEGU) pg8::gemm_phase<pg8::EpiSwiglu8, pg8::MoeOrder<true>, true>(ring, g, S, E, wave_id);
        } SEAM(16);
        if (IN(17)) { MKCTX();
            pg8::MoeOrder<true> S; S.init(nM, D, X.G, (int)blockIdx.x);
            S.tile_e = tab; S.list = nullptr; S.eB = (size_t)D * DFFE;
            pg8::Gemm g{PROJ, (const bf16*)(ws + WS_MOEDN), 2 * MOE_ROWS, D, DFFE / 2, 0, 127 - 3, 127 - 11};
            pg8::EpiMoeDown E{(bf16*)(ws + WS_Y0), Hb, nM0 * 256, list, roww};
            pg8::gemm_phase<pg8::EpiMoeDown, pg8::MoeOrder<true>, true>(ring, g, S, E, wave_id);
        } SEAM(17);
    }
    if (IN(18)) { MKCTX(); final_norm_phase(X, xres, (const bf16*)(ws + WS_Y0), Hb, MOD + (size_t)8 * MODW + 5 * D, I.p[29], args.out); }
#undef IN
#undef SEAM
#undef x_in
#undef xres
#undef MOD
#undef Hb
#undef PROJ
#undef ring
}

extern "C" void kernel_launch(void* const* d_in, const int* in_sizes, int n_in, void* d_out, int out_size, void* d_ws, size_t ws_size, hipStream_t stream) {
    static int grid = 0;
    if (grid == 0) {
        if (n_in != 30 || in_sizes[0] != T * D || out_size != T * D || ws_size < WS_END) { fprintf(stderr, "kernel_launch: unexpected shapes (n_in %d, in0 %d, out %d, ws %zu); nothing launched\n", n_in, n_in > 0 ? in_sizes[0] : -1, out_size, ws_size); grid = -1; return; }
        int dev = 0, cus = 0;
        if (hipGetDevice(&dev) != hipSuccess || hipDeviceGetAttribute(&cus, hipDeviceAttributeMultiprocessorCount, dev) != hipSuccess) { fprintf(stderr, "kernel_launch: device query failed\n"); grid = -1; return; }
        if (hipFuncSetAttribute((const void*)hybrid_fwd, hipFuncAttributeMaxDynamicSharedMemorySize, LDS_BYTES) != hipSuccess) { fprintf(stderr, "kernel_launch: hipFuncSetAttribute failed\n"); grid = -1; return; }
        int per_cu = 0;
        if (hipOccupancyMaxActiveBlocksPerMultiprocessor(&per_cu, (const void*)hybrid_fwd, NTHR, LDS_BYTES) != hipSuccess || per_cu < 1) fprintf(stderr, "kernel_launch: note: occupancy query reports %d workgroups per CU\n", per_cu);
        (void)hipGetLastError();
        grid = cus;
    }
    if (grid < 0) return;
    if (hipMemsetAsync((char*)d_ws + WS_CTL, 0, CTL_ZERO_BYTES, stream) != hipSuccess) { fprintf(stderr, "kernel_launch: memset failed\n"); return; }
    Args a{};
    for (int i = 0; i < 30; ++i) a.in.p[i] = (const float*)d_in[i];
    a.out = (float*)d_out; a.ws = (unsigned char*)d_ws;
#if MK_ONE_LAUNCH
    a.ph_lo = 0; a.ph_hi = N_PHASES;
    hipLaunchKernelGGL(hybrid_fwd, dim3(grid), dim3(NTHR), LDS_BYTES, stream, a);
#else
    for (int k = 0; k < N_PHASES; ++k) { a.ph_lo = k; a.ph_hi = k + 1; hipLaunchKernelGGL(hybrid_fwd, dim3(grid), dim3(NTHR), LDS_BYTES, stream, a); }
#endif
    const hipError_t le = hipPeekAtLastError();
    if (le != hipSuccess) fprintf(stderr, "kernel_launch: launch failed: %s\n", hipGetErrorName(le));
}
```

```cpp
#include <hip/hip_runtime.h>
#include <cstdio>
#include <cstdint>
#include <type_traits>

#ifndef MK_ONE_LAUNCH
#define MK_ONE_LAUNCH 1
#endif

namespace pg8 {
#define PG8_LAS __attribute__((address_space(3)))
typedef unsigned short bf16_t;
typedef short bf16x8 __attribute__((ext_vector_type(8)));
typedef float f32x4 __attribute__((ext_vector_type(4)));
typedef unsigned u32x4 __attribute__((ext_vector_type(4)));
typedef int i32x4 __attribute__((ext_vector_type(4)));
constexpr int BM = 256, BK = 64, HALF = 128, HTB = HALF * BK * 2  , STAGE_BYTES = 8 * HTB, NXCD = 8, WGM = 8;

__host__ __device__ __forceinline__ int lds_byte(int r, int c) { const int st = (r >> 4) * 2 + (c >> 5), rr = r & 15, cc = c & 31, ob = rr * 64 + cc * 2; return st * 1024 + (ob ^ (((ob >> 9) & 1) << 5)); }
__host__ __device__ __forceinline__ void stage_rc(int b, int& R, int& C) { const int st = b / 1024, sb = b % 1024, swz = sb ^ (((sb >> 9) & 1) << 5); R = (st >> 1) * 16 + swz / 64; C = (st & 1) * 32 + (swz % 64) / 2; }
__host__ __device__ __forceinline__ int perm32(int rho) { const int n = rho >> 4, i = rho & 15; return 8 * (i >> 2) + 4 * n + (i & 3); }

struct Unit { int pm, pn, ks, sub; };
struct Gemm { const bf16_t* A; const bf16_t* Bt; int M, N, K; int ld = 0; int scA = 127, scB = 127; };

struct StaticOrder {
    static constexpr bool GATHER = false;
    int nM, nN, nwg, G, c;
    __host__ __device__ void init(int M, int N, int G_, int c_) { nM = M / BM; nN = N / BM; nwg = nM * nN; G = G_; c = c_; }
    __host__ __device__ bool next(int i, Unit& u) const {
        const long L = (long)i * G + c; if (L >= nwg) return false;
        int wgid = (int)L; { const int q = nwg / NXCD, r = nwg % NXCD, xcd = wgid % NXCD, off = wgid / NXCD; wgid = (xcd < r ? xcd * (q + 1) : r * (q + 1) + (xcd - r) * q) + off; }
        const int nig = WGM * nN, gid = wgid / nig, fm = gid * WGM, gsz = (nM - fm) < WGM ? (nM - fm) : WGM;
        u.pm = fm + ((wgid % nig) % gsz); u.pn = (wgid % nig) / gsz; u.ks = 0; u.sub = 0; return true;
    }
    __device__ __forceinline__ const char* b_base(const Gemm& g, const Unit& u, size_t tstep) const { return (const char*)g.Bt + (size_t)u.pn * tstep; }
    __device__ __forceinline__ int row_of(const Unit&, int r) const { return r; }
    __device__ __forceinline__ bool rowtab_ok() const { return false; }
    __device__ __forceinline__ const int* rows_ptr(const Unit&) const { return nullptr; }
    PG8_LAS int* rowtab;
};

typedef float cv_f32x2_t __attribute__((ext_vector_type(2)));
typedef __bf16 cv_bf16x2_t __attribute__((ext_vector_type(2)));
__device__ __forceinline__ unsigned cvt_pk_bf16(float lo, float hi) { const cv_f32x2_t v = {lo, hi}; const cv_bf16x2_t b = __builtin_convertvector(v, cv_bf16x2_t); return __builtin_bit_cast(unsigned, b); }

template <class Epi, class Sched, bool ALIGN_EPI>
__device__ __forceinline__ void gemm_phase(PG8_LAS unsigned char* lds, const Gemm g, const Sched& S, const Epi& E, const int wid_in) {
    constexpr bool GA = Sched::GATHER;
    int lane_; asm volatile("v_mbcnt_lo_u32_b32 %0, -1, 0\n\tv_mbcnt_hi_u32_b32 %0, -1, %0" : "=v"(lane_));
    int wid_ = wid_in; asm volatile("" : "+s"(wid_));
    const int wid = wid_, lane = lane_, tid = wid * 64 + lane, wr = wid >> 2, wc = wid & 3, fr = lane & 15, fq = lane >> 4;
    const int K = g.ld ? g.ld : g.K, nt = g.K / BK;
    unsigned voffA, voffB;
    { int R, C; stage_rc(tid * 16, R, C); const int Rb = Epi::PERM ? ((R & ~31) + perm32(R & 31)) : R; voffA = (unsigned)(R * K + C) * 2u; voffB = (unsigned)(Rb * K + C) * 2u; }
    const size_t rstep = (size_t)64 * K * 2;
    const int scA = g.scA, scB = g.scB;
    unsigned vAc[2][2];
#define PG8_GATHER_ROWS(U) do { _Pragma("unroll") for (int _h = 0; _h < 2; ++_h) _Pragma("unroll") for (int _i = 0; _i < 2; ++_i) { int _R, _C; stage_rc(tid * 16 + _i * 8192, _R, _C); \
        vAc[_h][_i] = (unsigned)(S.row_of(U, _h * HALF + _R) * K + _C) * 2u; } } while (0)
    const size_t kstep = (size_t)(BK * 2);
    const size_t hstep = (size_t)HALF * K * 2;
    const size_t tstep = 2 * hstep;
    const unsigned ldsw = (unsigned)wid * 1024u;
    const int aoff = lds_byte(wr * 64 + fr, fq * 8), boff = lds_byte(wc * 32 + fr, fq * 8);
#define PG8_SA(b, h) (((b) * 2 + (h)) * HTB)
#define PG8_SB(b, h) ((4 + (b) * 2 + (h)) * HTB)
#define PG8_STAGE(bufoff, gbase, voff) do { _Pragma("unroll") for (int _i = 0; _i < 2; ++_i) \
        __builtin_amdgcn_global_load_lds((const unsigned*)((const char*)(gbase) + _i * rstep + (voff)), (PG8_LAS unsigned*)(lds + (bufoff) + ldsw + _i * 8192), 16, 0, 0); } while (0)
#define PG8_STA(bufoff, kb, h, nx) do { if constexpr (GA) { _Pragma("unroll") for (int _i = 0; _i < 2; ++_i) \
        __builtin_amdgcn_global_load_lds((const unsigned*)((const char*)(kb) + vAc[h][_i]), (PG8_LAS unsigned*)(lds + (bufoff) + ldsw + _i * 8192), 16, 0, 0); } \
        else { PG8_STAGE(bufoff, (kb) + (h) * hstep, voffA); } } while (0)
#define PG8_LDA(dst, b, h) do { _Pragma("unroll") for (int m = 0; m < 4; ++m) _Pragma("unroll") for (int k = 0; k < 2; ++k) dst[m][k] = *(const PG8_LAS bf16x8*)(lds + PG8_SA(b, h) + aoff + m * 2048 + k * 1024); } while (0)
#define PG8_LDB(dst, b, h) do { _Pragma("unroll") for (int n = 0; n < 2; ++n) _Pragma("unroll") for (int k = 0; k < 2; ++k) dst[n][k] = *(const PG8_LAS bf16x8*)(lds + PG8_SB(b, h) + boff + n * 2048 + k * 1024); } while (0)
#define PG8_CAT8(lo, hi) __builtin_shufflevector(__builtin_bit_cast(i32x4, lo), __builtin_bit_cast(i32x4, hi), 0, 1, 2, 3, 4, 5, 6, 7)
#define PG8_MMA(ai, bj, At, Bt, Z) do { __builtin_amdgcn_s_setprio(1); _Pragma("unroll") for (int m = 0; m < 4; ++m) _Pragma("unroll") for (int n = 0; n < 2; ++n) { \
        if constexpr (Epi::F8) acc[ai][bj][m][n] = __builtin_amdgcn_mfma_scale_f32_16x16x128_f8f6f4(PG8_CAT8(Bt[n][0], Bt[n][1]), PG8_CAT8(At[m][0], At[m][1]), (Z) ? (f32x4){0.f, 0.f, 0.f, 0.f} : acc[ai][bj][m][n], 0, 0, 0, scB, 0, scA); \
        else { _Pragma("unroll") for (int k = 0; k < 2; ++k) acc[ai][bj][m][n] = __builtin_amdgcn_mfma_f32_16x16x32_bf16(Bt[n][k], At[m][k], ((Z) && k == 0) ? (f32x4){0.f, 0.f, 0.f, 0.f} : acc[ai][bj][m][n], 0, 0, 0); } } __builtin_amdgcn_s_setprio(0); } while (0)
#define PG8_WAIT_V(n) asm volatile("s_waitcnt vmcnt(" #n ")" ::: "memory")
#define PG8_WAIT_L(n) asm volatile("s_waitcnt lgkmcnt(" #n ")" ::: "memory")
#define PG8_BAR __builtin_amdgcn_s_barrier()
#define PG8_SCHED __builtin_amdgcn_sched_barrier(0)
#define PG8_KITER(T_, Z_) do { \
            const bool last = ((T_) == nt - 2); \
            const char* a1 = cA + (size_t)((T_) + 1) * kstep; \
            const char* a2 = last ? nA : cA + (size_t)((T_) + 2) * kstep; const char* b2 = last ? nB : cB + (size_t)((T_) + 2) * kstep; \
            const char* a3 = a2 + kstep; const char* b3 = b2 + kstep; \
            PG8_LDB(B0, 0, 0); PG8_LDB(B1, 0, 1); PG8_SCHED; PG8_LDA(At, 0, 0); PG8_STA(PG8_SA(1, 1), a1, 1, false); \
            if constexpr (GA) { if (last && has_next) { \
            if (S.rowtab_ok()) { \
            _Pragma("unroll") \
            for (int _h = 0; _h < 2; ++_h) \
            _Pragma("unroll") \
            for (int _i = 0; _i < 2; ++_i) { int _R, _C; stage_rc(tid * 16 + _i * 8192, _R, _C); const int tok_ = ((volatile PG8_LAS int*)S.rowtab)[_h * HALF + _R]; \
            vAc[_h][_i] = (unsigned)((tok_ < 0 ? 0 : tok_) * K + _C) * 2u; } \
            } else PG8_GATHER_ROWS(nxt); } } \
            PG8_WAIT_V(8); PG8_WAIT_L(0); PG8_BAR; PG8_MMA(0, 0, At, B0, Z_); PG8_MMA(0, 1, At, B1, Z_); PG8_BAR; PG8_SCHED; \
            PG8_LDA(At, 0, 1); PG8_STAGE(PG8_SB(0, 0), b2, voffB); PG8_STAGE(PG8_SB(0, 1), b2 + hstep, voffB); PG8_STA(PG8_SA(0, 0), a2, 0, last); \
            PG8_WAIT_V(8); PG8_WAIT_L(0); PG8_BAR; PG8_MMA(1, 0, At, B0, Z_); PG8_MMA(1, 1, At, B1, Z_); PG8_BAR; PG8_SCHED; \
            PG8_LDB(B0, 1, 0); PG8_LDB(B1, 1, 1); PG8_SCHED; PG8_LDA(At, 1, 0); PG8_STA(PG8_SA(0, 1), a2, 1, last); \
            PG8_WAIT_V(8); PG8_WAIT_L(0); PG8_BAR; PG8_MMA(0, 0, At, B0, false); PG8_MMA(0, 1, At, B1, false); PG8_BAR; PG8_SCHED; \
            PG8_LDA(At, 1, 1); PG8_STAGE(PG8_SB(1, 0), b3, voffB); PG8_STAGE(PG8_SB(1, 1), b3 + hstep, voffB); PG8_STA(PG8_SA(1, 0), a3, 0, last); \
            PG8_WAIT_V(8); PG8_WAIT_L(0); PG8_BAR; PG8_MMA(1, 0, At, B0, false); PG8_MMA(1, 1, At, B1, false); PG8_BAR; PG8_SCHED; \
        } while (0)
    Unit cur, nxt; int ui = 0;
    if (!S.next(0, cur)) return;
    constexpr bool PEEL = !Epi::F8;
    f32x4 acc[2][2][4][2];
#define PG8_ZERO_ACC() do { _Pragma("unroll") for (int a = 0; a < 2; ++a) _Pragma("unroll") for (int b = 0; b < 2; ++b) _Pragma("unroll") for (int m = 0; m < 4; ++m) _Pragma("unroll") for (int n = 0; n < 2; ++n) acc[a][b][m][n] = (f32x4){0.f, 0.f, 0.f, 0.f}; } while (0)
    if constexpr (!PEEL) PG8_ZERO_ACC();
    bf16x8 At[4][2], B0[2][2], B1[2][2];
    const char* cA = (GA ? (const char*)g.A : (const char*)g.A + (size_t)cur.pm * tstep) + (size_t)cur.ks * 2; const char* cB = S.b_base(g, cur, tstep) + (size_t)cur.ks * 2;
    if constexpr (GA) PG8_GATHER_ROWS(cur);
    PG8_STAGE(PG8_SB(0, 0), cB, voffB); PG8_STAGE(PG8_SB(0, 1), cB + hstep, voffB); PG8_STA(PG8_SA(0, 0), cA, 0, false); PG8_STA(PG8_SA(0, 1), cA, 1, false);
    if (wr == 1) PG8_BAR;
    PG8_WAIT_V(2); PG8_BAR;
    PG8_STAGE(PG8_SB(1, 0), cB + kstep, voffB); PG8_STA(PG8_SA(1, 0), cA + kstep, 0, false); PG8_STAGE(PG8_SB(1, 1), cB + hstep + kstep, voffB);
    PG8_WAIT_V(6); PG8_BAR;
    for (;;) {
        const bool has_next = S.next(ui + 1, nxt);
        if constexpr (GA) { if (has_next && S.rowtab_ok() && wid == 0)
            __builtin_amdgcn_global_load_lds((const unsigned*)(S.rows_ptr(nxt) + lane * 4), (PG8_LAS unsigned*)S.rowtab, 16, 0, 0); }
        const char* nA = has_next ? (GA ? (const char*)g.A : (const char*)g.A + (size_t)nxt.pm * tstep) + (size_t)nxt.ks * 2 : cA; const char* nB = has_next ? S.b_base(g, nxt, tstep) + (size_t)nxt.ks * 2 : cB;
        if constexpr (PEEL) { PG8_KITER(0, true); for (int t = 2; t < nt; t += 2) PG8_KITER(t, false); }
        else { for (int t = 0; t < nt; t += 2) PG8_KITER(t, false); }
        if constexpr (ALIGN_EPI) { if (wr == 0) PG8_BAR; }
        { int le_; asm volatile("v_mbcnt_lo_u32_b32 %0, -1, 0\n\tv_mbcnt_hi_u32_b32 %0, -1, %0" : "=v"(le_));
          E(acc, cur, wr, wc, le_ & 15, le_ >> 4); }
        if (!has_next) break;
        if constexpr (!PEEL) PG8_ZERO_ACC();
        cur = nxt; cA = nA; cB = nB; ++ui;
        if constexpr (ALIGN_EPI) { if (wr == 1) PG8_BAR; }
    }
    PG8_WAIT_V(0);
    if constexpr (!ALIGN_EPI) { if (wr == 0) PG8_BAR; }
    PG8_BAR;
#undef PG8_SA
#undef PG8_SB
#undef PG8_STAGE
#undef PG8_STA
#undef PG8_GATHER_ROWS
#undef PG8_LDA
#undef PG8_LDB
#undef PG8_MMA
#undef PG8_KITER
#undef PG8_ZERO_ACC
#undef PG8_CAT8
#undef PG8_WAIT_V
#undef PG8_WAIT_L
#undef PG8_BAR
#undef PG8_SCHED
}
}
#define GAS __attribute__((address_space(1)))
#define LAS __attribute__((address_space(3)))
typedef unsigned short bf16;
typedef unsigned v4u __attribute__((ext_vector_type(4)));
typedef float f32x4 __attribute__((ext_vector_type(4)));
typedef short bf16x8 __attribute__((ext_vector_type(8)));
typedef GAS unsigned gu32;
typedef GAS unsigned long long gu64;
#define RLX_AGENT __ATOMIC_RELAXED, __HIP_MEMORY_SCOPE_AGENT
#define LDS_WAIT() asm volatile("s_waitcnt lgkmcnt(0)" ::: "memory")
#define VM_WAIT() asm volatile("s_waitcnt vmcnt(0)" ::: "memory")
__device__ __forceinline__ unsigned long long rt() { return __builtin_amdgcn_s_memrealtime(); }
__device__ __forceinline__ unsigned f2bf(float f) { return (unsigned)__builtin_bit_cast(unsigned short, (__bf16)f); }
typedef float pk_f32x2_t __attribute__((ext_vector_type(2)));
typedef __bf16 pk_bf16x2_t __attribute__((ext_vector_type(2)));
__device__ __forceinline__ unsigned pk2(float lo, float hi) { const pk_f32x2_t v = {lo, hi}; const pk_bf16x2_t b = __builtin_convertvector(v, pk_bf16x2_t); return __builtin_bit_cast(unsigned, b); }
#define XB_TMO      128
#define XB_XCNT(j)  (256  + 64 * (j))
#define XB_XSUB(j)  (1280 + 64 * (j))
#define XB_XGEN(j)  (2304 + 64 * (j))
#define XB_TOP      3328
#define XB_TOPGEN   3392
#define XCD_BAR_WORDS 3456
#define XB_SPIN_CAP (1u << 18)

__device__ __forceinline__ unsigned xb_ld(unsigned* p)              { return __hip_atomic_load(p, __ATOMIC_RELAXED, __HIP_MEMORY_SCOPE_AGENT); }
__device__ __forceinline__ unsigned xb_add(unsigned* p, unsigned v) { return __hip_atomic_fetch_add(p, v, __ATOMIC_RELAXED, __HIP_MEMORY_SCOPE_AGENT); }
__device__ __forceinline__ unsigned xb_xcc_id() { return (unsigned)__builtin_amdgcn_s_getreg((3 << 11) | 20) & 0xFu; }
#define XB_SPIN(cond, bar) do { unsigned _sp = 0; while (cond) { __builtin_amdgcn_s_sleep(1); \
    if ((++_sp & 255u) == 0u) { if (xb_ld(&(bar)[XB_TMO])) break; if (_sp > XB_SPIN_CAP) { atomicAdd(&(bar)[XB_TMO], 1u); break; } } } } while (0)

struct XcdBarrier {
    unsigned* bar; unsigned x;
    volatile LAS unsigned* st;
};

__device__ __forceinline__ XcdBarrier xcd_barrier_post(unsigned* bar, volatile LAS unsigned* st) {
    XcdBarrier b; b.bar = bar; b.x = xb_xcc_id(); b.st = st;
    if (threadIdx.x == 0) (void)xb_add(&bar[XB_XCNT(b.x)], 1u);
    return b;
}
__device__ __forceinline__ void xcd_barrier_complete(unsigned* bar, unsigned x, unsigned& nloc, unsigned& nx) {
    const unsigned G = gridDim.x * gridDim.y * gridDim.z;
    unsigned sum, cnt, mine, sp = 0u;
    for (;;) {
        sum = 0u; cnt = 0u; mine = 0u;
#pragma unroll
        for (unsigned j = 0; j < 16; ++j) { const unsigned c = xb_ld(&bar[XB_XCNT(j)]); sum += c; cnt += (c > 0u) ? 1u : 0u; mine = (j == x) ? c : mine; }
        if (sum == G) break;
        __builtin_amdgcn_s_sleep(1);
        if ((++sp & 255u) == 0u) { if (xb_ld(&bar[XB_TMO])) break; if (sp > XB_SPIN_CAP) { atomicAdd(&bar[XB_TMO], 1u); break; } }
    }
    nloc = mine > 0u ? mine : 1u; nx = cnt > 0u ? cnt : 1u;
}

__device__ __forceinline__ void xcd_barrier(const XcdBarrier& b) {
    asm volatile("s_waitcnt vmcnt(0)" ::: "memory");
    __syncthreads();
    if (threadIdx.x == 0) {
        unsigned* bar = b.bar;
        __builtin_amdgcn_s_waitcnt(0);
        unsigned nloc = b.st[0], nx = b.st[1];
        if (nloc == 0u) { xcd_barrier_complete(bar, b.x, nloc, nx); b.st[0] = nloc; b.st[1] = nx; }
        const unsigned old = xb_add(&bar[XB_XSUB(b.x)], 1u);
        const unsigned gen = old / nloc;
        if (old + 1u == (gen + 1u) * nloc) {
            __builtin_amdgcn_fence(__ATOMIC_RELEASE, "agent");
            asm volatile("s_waitcnt vmcnt(0)" ::: "memory");
            const unsigned og = xb_add(&bar[XB_TOP], 1u);
            const unsigned tg = og / nx;
            if (og + 1u == (tg + 1u) * nx) xb_add(&bar[XB_TOPGEN], 1u);
            else XB_SPIN(xb_ld(&bar[XB_TOPGEN]) == tg, bar);
            __builtin_amdgcn_fence(__ATOMIC_ACQUIRE, "agent");
            xb_add(&bar[XB_XGEN(b.x)], 1u);
            asm volatile("s_waitcnt vmcnt(0)" ::: "memory");
        } else {
            XB_SPIN(xb_ld(&bar[XB_XGEN(b.x)]) == gen, bar);
            __builtin_amdgcn_fence(__ATOMIC_ACQUIRE, "agent");
            asm volatile("s_waitcnt vmcnt(0)" ::: "memory");
        }
    }
    __syncthreads();
}

#ifndef INPROJ1_F8
#define INPROJ1_F8 0
#endif
#ifndef DENSE_GU_F8
#define DENSE_GU_F8 1
#endif
#ifndef DENSE_DN_F8
#define DENSE_DN_F8 1
#endif
#ifndef MOE_DOWN_F8
#define MOE_DOWN_F8 1
#endif
constexpr int D = 1024, NBATCH = 8, SEQ = 4096, T = NBATCH * SEQ, DIN = 3228, DINP = 3328, DFF = 2816, NEXP = 8, DFFE = 3584, NCHUNK = 64;
constexpr int C_GQ = 0, C_GK = 192, C_GV = 384, C_GZ = 768, C_GLR = 1152, C_LX = 1168, C_LG = 1424, C_DQ = 1680, C_DK = 2064, C_DV = 2448, C_DZ = 2832, C_DB = 3216, C_DA = 3222;
constexpr int MODW = 6 * D;
constexpr float EPS = 1e-6f;
constexpr int NWAVES = 8, NTHR = 512;
constexpr int MOE_ROWS = T + NEXP * 256;
constexpr int MOE_TILES = MOE_ROWS / 256;
constexpr int TILE_TAB = 320;

constexpr size_t MiB = 1u << 20;
constexpr size_t WS_CTL = 0, CTL_ZERO_BYTES = 1 * MiB;
constexpr size_t WS_MOD = 1 * MiB;
constexpr size_t WS_ROUTE_E = 2 * MiB;
constexpr size_t WS_ROUTE_W = 3 * MiB;
constexpr size_t WS_WCNT = 4 * MiB;
constexpr size_t WS_LIST = 5 * MiB;
constexpr size_t WS_ROWW = 6 * MiB;
constexpr size_t WS_TILES = 7 * MiB;
constexpr size_t WS_DNDEC = 7 * MiB + 65536;
constexpr size_t WS_WIN = 8 * MiB;
constexpr size_t WS_WOUT = 21 * MiB;
constexpr size_t WS_WGU = 25 * MiB;
constexpr size_t WS_WDN = 36 * MiB;
constexpr size_t WS_H = 42 * MiB;
constexpr size_t WS_PROJ = 106 * MiB;
constexpr size_t DN_BYTES = (size_t)3072 * 5 * 8192;
constexpr size_t WS_MOEGU = 344 * MiB;
constexpr size_t WS_MOEDN = 400 * MiB;
constexpr size_t WS_GLA = 464 * MiB;
constexpr size_t WS_GLADEC = 6 * MiB;
constexpr size_t WS_LRUC = 5 * MiB;
constexpr size_t WS_PART = 8 * MiB;
constexpr size_t WS_Y0 = 432 * MiB;
constexpr size_t WS_XRES = 512 * MiB;
constexpr size_t WS_END = 576 * MiB;
static_assert(WS_PROJ + (size_t)T * DINP * 2 <= WS_MOEGU && WS_PROJ + (size_t)2 * MOE_ROWS * DFFE <= WS_MOEGU && DN_BYTES <= (size_t)T * D * 4 && WS_MOEGU + (size_t)8 * 7168 * 1024 <= WS_MOEDN && WS_MOEDN + (size_t)8 * 1024 * 3584 * 2 <= WS_GLA, "d_ws map");
static_assert(MOE_DOWN_F8 && WS_MOEDN + (size_t)8 * 1024 * 3584 <= WS_Y0 && WS_Y0 + (size_t)T * D * 2 <= WS_XRES, "d_ws map");
static_assert(WS_H + (size_t)T * D * 2 <= WS_PROJ && WS_WDN + (size_t)1024 * 2816 * 2 <= WS_H, "d_ws map");
constexpr int CW_TMO = 0, CW_CODE = 1, CW_BAR = 4096, CW_MODCNT = 8192;

constexpr int RING_BYTES = 131072;
constexpr int MISC_OFF = RING_BYTES + 320;
constexpr int PTR_OFF = RING_BYTES + 512;
constexpr int TAB_OFF = RING_BYTES + 1024;
constexpr int ROWTAB_OFF = RING_BYTES + 3072;
constexpr int LDS_BYTES = 147456;

#define DI __device__ __forceinline__
typedef float f32x2 __attribute__((ext_vector_type(2)));
typedef unsigned u32x2 __attribute__((ext_vector_type(2)));

DI float bf2f(unsigned b) { return __uint_as_float(b << 16); }
DI void unpack8(const v4u w, float (&f)[8]) {
    f[0] = __uint_as_float(w.x << 16); f[1] = __uint_as_float(w.x & 0xffff0000u); f[2] = __uint_as_float(w.y << 16); f[3] = __uint_as_float(w.y & 0xffff0000u);
    f[4] = __uint_as_float(w.z << 16); f[5] = __uint_as_float(w.z & 0xffff0000u); f[6] = __uint_as_float(w.w << 16); f[7] = __uint_as_float(w.w & 0xffff0000u); }
DI void unpack4(const u32x2 w, float (&f)[4]) { f[0] = __uint_as_float(w.x << 16); f[1] = __uint_as_float(w.x & 0xffff0000u); f[2] = __uint_as_float(w.y << 16); f[3] = __uint_as_float(w.y & 0xffff0000u); }
DI v4u pack8(const float (&f)[8]) { v4u w; w.x = pk2(f[0], f[1]); w.y = pk2(f[2], f[3]); w.z = pk2(f[4], f[5]); w.w = pk2(f[6], f[7]); return w; }
DI u32x2 pack4(float a, float b, float c, float d) { u32x2 w; w.x = pk2(a, b); w.y = pk2(c, d); return w; }
DI float fexp(float x) { return __builtin_amdgcn_exp2f(x * 1.4426950408889634f); }
DI float frcp(float x) { return __builtin_amdgcn_rcpf(x); }
DI float frsq(float x) { return __builtin_amdgcn_rsqf(x); }
DI float sigm(float x) { return frcp(1.0f + fexp(-x)); }
DI float silu(float x) { return x * frcp(1.0f + fexp(-x)); }
DI float softplus(float x) { return fmaxf(x, 0.0f) + 0.6931471805599453f * __builtin_amdgcn_logf(1.0f + fexp(-fabsf(x))); }
DI float gelu_tanh(float x) { const float u = 1.5957691216057308f * (x + 0.044715f * x * x * x); return x * frcp(1.0f + fexp(-u)); }
DI int bperm_i(int srclane, int v) { return __builtin_amdgcn_ds_bpermute(srclane << 2, v); }
DI float bperm_f(int srclane, float v) { return __builtin_bit_cast(float, __builtin_amdgcn_ds_bpermute(srclane << 2, __builtin_bit_cast(int, v))); }
DI float wave_sum(float v, int lane) {
    (void)lane;
    v += __builtin_bit_cast(float, __builtin_amdgcn_update_dpp(0, __builtin_bit_cast(int, v), 0xB1, 0xF, 0xF, true));
    v += __builtin_bit_cast(float, __builtin_amdgcn_update_dpp(0, __builtin_bit_cast(int, v), 0x4E, 0xF, 0xF, true));
    v += __builtin_bit_cast(float, __builtin_amdgcn_update_dpp(0, __builtin_bit_cast(int, v), 0x141, 0xF, 0xF, true));
    v += __builtin_bit_cast(float, __builtin_amdgcn_update_dpp(0, __builtin_bit_cast(int, v), 0x140, 0xF, 0xF, true));
    const int vi = __builtin_bit_cast(int, v);
    const float r0 = __builtin_bit_cast(float, __builtin_amdgcn_readlane(vi, 0)), r1 = __builtin_bit_cast(float, __builtin_amdgcn_readlane(vi, 16));
    const float r2 = __builtin_bit_cast(float, __builtin_amdgcn_readlane(vi, 32)), r3 = __builtin_bit_cast(float, __builtin_amdgcn_readlane(vi, 48));
    return (r0 + r1) + (r2 + r3);
}
template <int K> DI f32x4 mm16(const LAS bf16* A, int lda, const LAS bf16* Bt, int ldb, f32x4 acc, int lane) {
    const int r = lane & 15, q = lane >> 4;
#pragma unroll
    for (int k0 = 0; k0 < K; k0 += 32) {
        const bf16x8 a = *(const LAS bf16x8*)(A + r * lda + k0 + q * 8);
        const bf16x8 b = *(const LAS bf16x8*)(Bt + r * ldb + k0 + q * 8);
        acc = __builtin_amdgcn_mfma_f32_16x16x32_bf16(a, b, acc, 0, 0, 0);
    }
    return acc;
}
DI float dpp_sum8(float x) {
    x += __builtin_bit_cast(float, __builtin_amdgcn_update_dpp(0, __builtin_bit_cast(int, x), 0xB1, 0xF, 0xF, true));
    x += __builtin_bit_cast(float, __builtin_amdgcn_update_dpp(0, __builtin_bit_cast(int, x), 0x4E, 0xF, 0xF, true));
    x += __builtin_bit_cast(float, __builtin_amdgcn_update_dpp(0, __builtin_bit_cast(int, x), 0x141, 0xF, 0xF, true));
    return x;
}
#define MFMA16(a, b, c) __builtin_amdgcn_mfma_f32_16x16x32_bf16((a), (b), (c), 0, 0, 0)
#define LDF(p) (*(const LAS bf16x8*)(p))
#define SYNC() asm volatile("s_waitcnt lgkmcnt(0)\n\ts_barrier" ::: "memory")

namespace pg8 {
struct EpiStoreBf16 {
    static constexpr bool PERM = true, F8 = false;
    bf16_t* O; int ldc;
    DI void operator()(const f32x4 (&acc)[2][2][4][2], const Unit& u, int wr, int wc, int fr, int fq) const {
        const int row0 = u.pm * BM + wr * 64 + fr, col0 = u.pn * BM + wc * 32 + 8 * fq;
#pragma unroll
        for (int ai = 0; ai < 2; ++ai)
#pragma unroll
            for (int m = 0; m < 4; ++m) { bf16_t* rowp = O + (size_t)(row0 + ai * HALF + m * 16) * ldc + col0;
#pragma unroll
                for (int bj = 0; bj < 2; ++bj) { const f32x4 v0 = acc[ai][bj][m][0], v1 = acc[ai][bj][m][1];
                    u32x4 w; w.x = cvt_pk_bf16(v0[0], v0[1]); w.y = cvt_pk_bf16(v0[2], v0[3]); w.z = cvt_pk_bf16(v1[0], v1[1]); w.w = cvt_pk_bf16(v1[2], v1[3]);
                    *(u32x4*)(rowp + bj * HALF) = w; } }
    }
};
template <bool B32_, bool F8_> struct EpiResT {
    static constexpr bool PERM = true, F8 = F8_;
    const float* base32; const bf16_t* base16; bf16_t* out; const float* gate;
    DI void operator()(const f32x4 (&acc)[2][2][4][2], const Unit& u, int wr, int wc, int fr, int fq) const {
        const int row0 = u.pm * BM + wr * 64 + fr, col0 = u.pn * BM + wc * 32 + 8 * fq;
        const float* gp = gate + (size_t)((u.pm * BM) / SEQ) * MODW + col0;
        f32x4 gv[2][2];
#pragma unroll
        for (int bj = 0; bj < 2; ++bj)
#pragma unroll
            for (int n = 0; n < 2; ++n) gv[bj][n] = *(const f32x4*)(gp + bj * HALF + n * 4);
#pragma unroll
        for (int ai = 0; ai < 2; ++ai) {
            f32x4 bs[4][2][2]; u32x4 br[4][2];
#pragma unroll
            for (int m = 0; m < 4; ++m) { const size_t off = (size_t)(row0 + ai * HALF + m * 16) * D + col0;
#pragma unroll
                for (int bj = 0; bj < 2; ++bj) {
                    if constexpr (B32_) { bs[m][bj][0] = *(const f32x4*)(base32 + off + bj * HALF); bs[m][bj][1] = *(const f32x4*)(base32 + off + bj * HALF + 4); }
                    else br[m][bj] = *(const u32x4*)(base16 + off + bj * HALF); } }
#pragma unroll
            for (int m = 0; m < 4; ++m) { const size_t off = (size_t)(row0 + ai * HALF + m * 16) * D + col0;
#pragma unroll
                for (int bj = 0; bj < 2; ++bj) {
                    if constexpr (!B32_) { const u32x4 w = br[m][bj];
                        bs[m][bj][0] = (f32x4){__uint_as_float(w.x << 16), __uint_as_float(w.x & 0xffff0000u), __uint_as_float(w.y << 16), __uint_as_float(w.y & 0xffff0000u)};
                        bs[m][bj][1] = (f32x4){__uint_as_float(w.z << 16), __uint_as_float(w.z & 0xffff0000u), __uint_as_float(w.w << 16), __uint_as_float(w.w & 0xffff0000u)}; }
                    const f32x4 v0 = bs[m][bj][0] + gv[bj][0] * acc[ai][bj][m][0], v1 = bs[m][bj][1] + gv[bj][1] * acc[ai][bj][m][1];
                    u32x4 w; w.x = cvt_pk_bf16(v0[0], v0[1]); w.y = cvt_pk_bf16(v0[2], v0[3]); w.z = cvt_pk_bf16(v1[0], v1[1]); w.w = cvt_pk_bf16(v1[2], v1[3]);
                    *(u32x4*)(out + off + bj * HALF) = w; } }
            asm volatile("" ::: "memory"); }
    }
};
typedef EpiResT<true, false> EpiRes32;
typedef EpiResT<false, false> EpiRes;
typedef EpiResT<false, true> EpiRes8;
struct EpiStoreBf16F8 : EpiStoreBf16 { static constexpr bool F8 = true; };
struct EpiSwiglu {
    static constexpr bool PERM = true, F8 = false;
    bf16_t* O; int ldc;
    DI void operator()(const f32x4 (&acc)[2][2][4][2], const Unit& u, int wr, int wc, int fr, int fq) const {
        const int row0 = u.pm * BM + wr * 64 + fr, col0 = u.pn * HALF + wc * 32 + 8 * fq;
#pragma unroll
        for (int ai = 0; ai < 2; ++ai)
#pragma unroll
            for (int m = 0; m < 4; ++m) { bf16_t* rowp = O + (size_t)(row0 + ai * HALF + m * 16) * ldc + col0;
                float v[8];
#pragma unroll
                for (int n = 0; n < 2; ++n)
#pragma unroll
                    for (int j = 0; j < 4; j += 2) {
                        const f32x2 g = {acc[ai][0][m][n][j], acc[ai][0][m][n][j + 1]}, up = {acc[ai][1][m][n][j], acc[ai][1][m][n][j + 1]};
                        const f32x2 t = g * -1.4426950408889634f;
                        const f32x2 e = {__builtin_amdgcn_exp2f(t.x), __builtin_amdgcn_exp2f(t.y)};
                        const f32x2 d = e + 1.0f;
                        const f32x2 rc = {__builtin_amdgcn_rcpf(d.x), __builtin_amdgcn_rcpf(d.y)};
                        const f32x2 o = (g * up) * rc;
                        v[n * 4 + j] = o.x; v[n * 4 + j + 1] = o.y; }
                u32x4 w; w.x = cvt_pk_bf16(v[0], v[1]); w.y = cvt_pk_bf16(v[2], v[3]); w.z = cvt_pk_bf16(v[4], v[5]); w.w = cvt_pk_bf16(v[6], v[7]);
                *(u32x4*)rowp = w; }
    }
};
struct EpiSwigluB : EpiSwiglu { static constexpr bool F8 = true; };
#if MOE_DOWN_F8
template <bool F8_> struct EpiSwiglu8T {
    static constexpr bool PERM = true, F8 = F8_;
    bf16_t* Ob; int ldc;
    DI void operator()(const f32x4 (&acc)[2][2][4][2], const Unit& u, int wr, int wc, int fr, int fq) const {
        unsigned char* O = (unsigned char*)Ob;
        const int row0 = u.pm * BM + wr * 64 + fr, col0 = u.pn * HALF + wc * 32 + 8 * fq;
#pragma unroll
        for (int ai = 0; ai < 2; ++ai)
#pragma unroll
            for (int m = 0; m < 4; ++m) { unsigned char* rowp = O + (size_t)(row0 + ai * HALF + m * 16) * ldc + col0;
                float v[8];
#pragma unroll
                for (int n = 0; n < 2; ++n)
#pragma unroll
                    for (int j = 0; j < 4; j += 2) {
                        const f32x2 g = {acc[ai][0][m][n][j], acc[ai][0][m][n][j + 1]}, up = {acc[ai][1][m][n][j], acc[ai][1][m][n][j + 1]};
                        const f32x2 t = g * -1.4426950408889634f;
                        const f32x2 e = {__builtin_amdgcn_exp2f(t.x), __builtin_amdgcn_exp2f(t.y)};
                        const f32x2 d = e * 0.125f + 0.125f;
                        const f32x2 rc = {__builtin_amdgcn_rcpf(d.x), __builtin_amdgcn_rcpf(d.y)};
                        const f32x2 o = (g * up) * rc;
                        v[n * 4 + j] = __builtin_amdgcn_fmed3f(o.x, -448.0f, 448.0f); v[n * 4 + j + 1] = __builtin_amdgcn_fmed3f(o.y, -448.0f, 448.0f); }
                int w0 = 0, w1 = 0;
                w0 = __builtin_amdgcn_cvt_pk_fp8_f32(v[0], v[1], w0, false); w0 = __builtin_amdgcn_cvt_pk_fp8_f32(v[2], v[3], w0, true);
                w1 = __builtin_amdgcn_cvt_pk_fp8_f32(v[4], v[5], w1, false); w1 = __builtin_amdgcn_cvt_pk_fp8_f32(v[6], v[7], w1, true);
                *(u32x2*)rowp = (u32x2){(unsigned)w0, (unsigned)w1}; }
    }
};
typedef EpiSwiglu8T<true> EpiSwiglu8;
typedef EpiSwiglu8T<false> EpiSwigluTo8;
#else
struct EpiSwiglu8 : EpiSwiglu { static constexpr bool F8 = true; };
#endif
struct EpiMoeDown {
    static constexpr bool PERM = true, F8 = (MOE_DOWN_F8 != 0);
    bf16_t* y0; bf16_t* y1; int split; const int* list; const float* roww;
    DI void operator()(const f32x4 (&acc)[2][2][4][2], const Unit& u, int wr, int wc, int fr, int fq) const {
        const int row0 = u.pm * BM + wr * 64 + fr, col0 = u.pn * BM + wc * 32 + 8 * fq;
        bf16_t* dst = (u.pm * BM >= split) ? y1 : y0;
        int tok[8]; float rw[8];
#pragma unroll
        for (int g = 0; g < 8; ++g) { const int r = row0 + (g >> 2) * HALF + (g & 3) * 16; tok[g] = list[r]; rw[g] = roww[r]; }
#pragma unroll
        for (int g = 0; g < 8; ++g) if (tok[g] >= 0) { bf16_t* op = dst + (size_t)tok[g] * D + col0; const int ai = g >> 2, m = g & 3;
#pragma unroll
            for (int bj = 0; bj < 2; ++bj) { const f32x4 v0 = acc[ai][bj][m][0] * rw[g], v1 = acc[ai][bj][m][1] * rw[g];
                u32x4 o; o.x = cvt_pk_bf16(v0[0], v0[1]); o.y = cvt_pk_bf16(v0[2], v0[3]); o.z = cvt_pk_bf16(v1[0], v1[1]); o.w = cvt_pk_bf16(v1[2], v1[3]);
                *(u32x4*)(op + bj * HALF) = o; } }
    }
};
template <bool GATHER_> struct MoeOrder {
    static constexpr bool GATHER = GATHER_;
    int nM, nN, nwg, G, c; const LAS int* tile_e; const int* list; size_t eB;
    int lo, hi, slices, kslice;
    DI void init(int nM_, int N, int G_, int c_) { nM = nM_; nN = N / BM; nwg = nM * nN; G = G_; c = c_; lo = 0; hi = nwg; slices = 1; kslice = 0; }
    DI void tile_of(int L, Unit& u) const {
        int wgid = L; { const int q = nwg / NXCD, r = nwg % NXCD, xcd = wgid % NXCD, off = wgid / NXCD; wgid = (xcd < r ? xcd * (q + 1) : r * (q + 1) + (xcd - r) * q) + off; }
        const int nig = WGM * nN, gid = wgid / nig, fm = gid * WGM, gsz = (nM - fm) < WGM ? (nM - fm) : WGM;
        u.pm = fm + ((wgid % nig) % gsz); u.pn = (wgid % nig) / gsz; }
    DI bool next(int i, Unit& u) const {
        const long S0 = (long)i * G + c; if (S0 >= (long)(hi - lo) * slices) return false;
        u.sub = (int)S0; u.ks = (int)(S0 % slices) * kslice; tile_of(lo + (int)(S0 / slices), u); return true;
    }
    DI const char* b_base(const Gemm& g, const Unit& u, size_t tstep) const { return (const char*)g.Bt + (size_t)__builtin_amdgcn_readfirstlane(tile_e[u.pm]) * eB + (size_t)u.pn * tstep; }
    LAS int* rowtab = nullptr;
    DI bool rowtab_ok() const { return list != nullptr && rowtab != nullptr; }
    DI const int* rows_ptr(const Unit& u) const { return list + u.pm * BM; }
    DI int row_of(const Unit& u, int r) const { if (list == nullptr) return u.pm * BM + r; const int tok = list[u.pm * BM + r]; return tok < 0 ? 0 : tok; }
};
struct EpiPartial {
    static constexpr bool PERM = false, F8 = (MOE_DOWN_F8 != 0);
    float* part;
    DI void operator()(const f32x4 (&acc)[2][2][4][2], const Unit& u, int wr, int wc, int fr, int fq) const {
        float* p = part + (size_t)u.sub * 65536 + (size_t)(((wr * 4 + wc) * 64) + fq * 16 + fr) * 128;
#pragma unroll
        for (int ai = 0; ai < 2; ++ai)
#pragma unroll
            for (int bj = 0; bj < 2; ++bj)
#pragma unroll
                for (int m = 0; m < 4; ++m)
#pragma unroll
                    for (int n = 0; n < 2; ++n) *(f32x4*)(p + (((ai * 2 + bj) * 4 + m) * 2 + n) * 4) = acc[ai][bj][m][n];
    }
};
}

struct Ctx { LAS unsigned char* lds; int tid, lane, wave, vcu, G, gw, NGW; };

struct XpItem { const float* src; bf16* dst; int K, N, k0, n0, drow0; float f8scale; };
DI void xp_load(const XpItem& I, f32x4 (&v)[8], int lane) {
    const int kr = lane >> 3, c4 = (lane & 7) * 4;
#pragma unroll
    for (int i = 0; i < 8; ++i) { const int kk = i * 8 + kr; v[i] = (f32x4){0.f, 0.f, 0.f, 0.f};
        if (I.n0 + c4 < I.N) v[i] = *(const f32x4*)(I.src + (size_t)(I.k0 + kk) * I.N + I.n0 + c4); }
}
DI void xp_finish(const XpItem& I, const f32x4 (&v)[8], LAS float* scr, int lane) {
    const int kr = lane >> 3, c4 = (lane & 7) * 4;
#pragma unroll
    for (int i = 0; i < 8; ++i) { const int kk = i * 8 + kr; scr[kk * 33 + c4 + 0] = v[i].x; scr[kk * 33 + c4 + 1] = v[i].y; scr[kk * 33 + c4 + 2] = v[i].z; scr[kk * 33 + c4 + 3] = v[i].w; }
    LDS_WAIT(); asm volatile("" ::: "memory");
    const int c = lane & 7;
    if (I.f8scale != 0.0f) { const float sc = I.f8scale; unsigned char* d8 = (unsigned char*)I.dst;
#pragma unroll
        for (int j = 0; j < 4; ++j) { const int n = (lane >> 3) + 8 * j; const LAS float* s = scr + (8 * c) * 33 + n;
            int w0 = 0, w1 = 0;
            w0 = __builtin_amdgcn_cvt_pk_fp8_f32(__builtin_amdgcn_fmed3f(s[0 * 33] * sc, -448.f, 448.f), __builtin_amdgcn_fmed3f(s[1 * 33] * sc, -448.f, 448.f), w0, false);
            w0 = __builtin_amdgcn_cvt_pk_fp8_f32(__builtin_amdgcn_fmed3f(s[2 * 33] * sc, -448.f, 448.f), __builtin_amdgcn_fmed3f(s[3 * 33] * sc, -448.f, 448.f), w0, true);
            w1 = __builtin_amdgcn_cvt_pk_fp8_f32(__builtin_amdgcn_fmed3f(s[4 * 33] * sc, -448.f, 448.f), __builtin_amdgcn_fmed3f(s[5 * 33] * sc, -448.f, 448.f), w1, false);
            w1 = __builtin_amdgcn_cvt_pk_fp8_f32(__builtin_amdgcn_fmed3f(s[6 * 33] * sc, -448.f, 448.f), __builtin_amdgcn_fmed3f(s[7 * 33] * sc, -448.f, 448.f), w1, true);
            *(u32x2*)(d8 + (size_t)(I.drow0 + n) * I.K + I.k0 + 8 * c) = (u32x2){(unsigned)w0, (unsigned)w1}; }
    } else {
#pragma unroll
    for (int j = 0; j < 4; ++j) { const int n = (lane >> 3) + 8 * j; const LAS float* s = scr + (8 * c) * 33 + n;
        v4u o; o.x = pk2(s[0 * 33], s[1 * 33]); o.y = pk2(s[2 * 33], s[3 * 33]); o.z = pk2(s[4 * 33], s[5 * 33]); o.w = pk2(s[6 * 33], s[7 * 33]);
        *(v4u*)(I.dst + (size_t)(I.drow0 + n) * I.K + I.k0 + 8 * c) = o; }
    }
    LDS_WAIT(); asm volatile("" ::: "memory");
}
DI bool xp_try(int& r, const float* W, int K, int N, int Npad, bf16* WT, int mode, XpItem& o, float f8scale = 0.0f) {
    const int nblk = Npad / 32, items = (K / 64) * nblk;
    if (r >= items) { r -= items; return false; }
    const int kb = r / nblk, n0 = (r % nblk) * 32;
    o.src = W; o.dst = WT; o.K = K; o.N = N; o.k0 = kb * 64; o.n0 = n0; o.f8scale = f8scale; o.drow0 = mode == 0 ? n0 : ((n0 >> 7) * 256 + (n0 & 127) + (mode == 2 ? 128 : 0));
    return true;
}
struct In { const float* p[30]; };
struct PtrTab { const LAS unsigned long long* t;
    DI const float* operator[](int k) const { const unsigned long long v = t[k]; const unsigned lo = __builtin_amdgcn_readfirstlane((unsigned)v), hi = __builtin_amdgcn_readfirstlane((unsigned)(v >> 32));
        return (const float*)(const GAS float*)(((unsigned long long)hi << 32) | lo); } };
struct InT { PtrTab p; };
DI void prologue_phase(const Ctx& X, const InT& I, unsigned char* ws) {
    LAS float* sct = (LAS float*)(X.lds + 98304);
    if (X.vcu < 2 * (MODW / 64)) {
        const float* cc = I.p[1];
        for (int i = X.tid; i < NBATCH * D; i += NTHR) { const int b = i / D, k = i % D; sct[k * 8 + b] = silu(cc[i]); }
        SYNC();
    }
    for (int it = X.vcu; it < 2 * (MODW / 64); it += X.G) {
        const int L = it / (MODW / 64), n = (it % (MODW / 64)) * 64 + X.lane;
        const float* aw = I.p[20] + (size_t)L * D * MODW + n;
        float acc[8];
#pragma unroll
        for (int b = 0; b < 8; ++b) acc[b] = 0.f;
        const int kb = X.wave * 128;
#pragma unroll 16
        for (int k = kb; k < kb + 128; ++k) { const float w = aw[(size_t)k * MODW]; const f32x4 s0 = *(const LAS f32x4*)(sct + k * 8), s1 = *(const LAS f32x4*)(sct + k * 8 + 4);
            acc[0] += s0.x * w; acc[1] += s0.y * w; acc[2] += s0.z * w; acc[3] += s0.w * w; acc[4] += s1.x * w; acc[5] += s1.y * w; acc[6] += s1.z * w; acc[7] += s1.w * w; }
        LAS float* red = (LAS float*)(X.lds + 81920);
#pragma unroll
        for (int b = 0; b < 8; ++b) red[(X.wave * 8 + b) * 64 + X.lane] = acc[b];
        SYNC();
        float s = I.p[21][(size_t)L * MODW + n];
#pragma unroll
        for (int w = 0; w < 8; ++w) s += red[(w * 8 + X.wave) * 64 + X.lane];
        ((float*)(ws + WS_MOD))[((size_t)L * 8 + X.wave) * MODW + n] = s;
        SYNC();
    }
    if (X.vcu < 2 * (MODW / 64)) {
        asm volatile("s_waitcnt vmcnt(0)" ::: "memory");
        __syncthreads();
        if (X.tid == 0) { __builtin_amdgcn_fence(__ATOMIC_RELEASE, "agent"); asm volatile("s_waitcnt vmcnt(0)" ::: "memory"); (void)xb_add((unsigned*)(ws + WS_CTL) + CW_MODCNT, 1u); }
    }
    LAS float* scr = (LAS float*)(X.lds + X.wave * 8704);
    constexpr int I_IN = 16 * (DINP / 32), I_OUT = 16 * 32, I_G = 16 * (DFF / 32), I_D = (DFF / 64) * 32;
    constexpr int NITEMS = 2 * I_IN + 2 * I_OUT + 2 * I_G + I_D;
    const float* w_in = I.p[2]; const float* w_out = I.p[17]; const float* wg = I.p[22]; const float* wu = I.p[23]; const float* wd = I.p[24];
#define PRO_DECODE(it_, o_) do { int r = (it_); \
        if (xp_try(r, w_in, D, DIN, DINP, (bf16*)(ws + WS_WIN), 0, o_)) break; \
        if (xp_try(r, w_in + (size_t)D * DIN, D, DIN, DINP, (bf16*)(ws + WS_WIN) + (size_t)DINP * D, 0, o_, INPROJ1_F8 ? 1024.0f : 0.0f)) break; \
        if (xp_try(r, w_out, D, D, D, (bf16*)(ws + WS_WOUT), 0, o_)) break; \
        if (xp_try(r, w_out + (size_t)D * D, D, D, D, (bf16*)(ws + WS_WOUT) + (size_t)D * D, 0, o_)) break; \
        if (xp_try(r, wg, D, DFF, DFF, (bf16*)(ws + WS_WGU), 1, o_, DENSE_GU_F8 ? 1024.0f : 0.0f)) break; \
        if (xp_try(r, wu, D, DFF, DFF, (bf16*)(ws + WS_WGU), 2, o_, DENSE_GU_F8 ? 1024.0f : 0.0f)) break; \
        xp_try(r, wd, DFF, D, D, (bf16*)(ws + WS_WDN), 0, o_, DENSE_DN_F8 ? 2048.0f : 0.0f); } while (0)
    if (X.gw < NITEMS) {
        XpItem cur, nx; f32x4 v[8], vn[8];
        PRO_DECODE(X.gw, cur); xp_load(cur, v, X.lane);
        for (int it = X.gw; it < NITEMS; it += X.NGW) {
            const bool more = it + X.NGW < NITEMS;
            if (more) { PRO_DECODE(it + X.NGW, nx); xp_load(nx, vn, X.lane); }
            xp_finish(cur, v, scr, X.lane);
            if (more) { cur = nx;
#pragma unroll
                for (int i = 0; i < 8; ++i) v[i] = vn[i]; }
        }
    }
#undef PRO_DECODE
}
DI void mod_wait(const Ctx& X, unsigned char* ws) {
    if (X.tid == 0) { unsigned* bar = (unsigned*)(ws + WS_CTL) + CW_BAR; const unsigned want = (unsigned)(X.G < 2 * (MODW / 64) ? X.G : 2 * (MODW / 64));
        XB_SPIN(xb_ld((unsigned*)(ws + WS_CTL) + CW_MODCNT) < want, bar);
        __builtin_amdgcn_fence(__ATOMIC_ACQUIRE, "agent"); asm volatile("s_waitcnt vmcnt(0)" ::: "memory"); }
    __syncthreads();
}
DI void moe_convert(const Ctx& X, const InT& I, unsigned char* ws, int lo, int hi, int wk, int nwk) {
    LAS float* scr = (LAS float*)(X.lds + 40960 + X.wave * 8704);
    constexpr int PER = 1792;
    const float* mg = I.p[26]; const float* mu = I.p[27]; const float* md = I.p[28];
#define MOE_DECODE(it_, o_) do { const int mat = (it_) / PER; int r = (it_) % PER; const int e = mat / 3, which = mat % 3; \
        if (which == 0) xp_try(r, mg + (size_t)e * D * DFFE, D, DFFE, DFFE, (bf16*)(ws + WS_MOEGU + (size_t)e * 2 * DFFE * D), 1, o_, 1024.0f); \
        else if (which == 1) xp_try(r, mu + (size_t)e * D * DFFE, D, DFFE, DFFE, (bf16*)(ws + WS_MOEGU + (size_t)e * 2 * DFFE * D), 2, o_, 1024.0f); \
        else xp_try(r, md + (size_t)e * DFFE * D, DFFE, D, D, (bf16*)(ws + WS_MOEDN + (size_t)e * D * DFFE * (MOE_DOWN_F8 ? 1 : 2)), 0, o_, MOE_DOWN_F8 ? 2048.0f : 0.0f); } while (0)
    const int first = lo + wk * NWAVES + X.wave, step = nwk * NWAVES;
    if (first < hi) {
        XpItem cur, nx; f32x4 v[8], vn[8];
        MOE_DECODE(first, cur); xp_load(cur, v, X.lane);
        for (int it = first; it < hi; it += step) {
            const bool more = it + step < hi;
            if (more) { MOE_DECODE(it + step, nx); xp_load(nx, vn, X.lane); }
            xp_finish(cur, v, scr, X.lane);
            if (more) { cur = nx;
#pragma unroll
                for (int i = 0; i < 8; ++i) v[i] = vn[i]; }
        }
    }
#undef MOE_DECODE
}

template <bool ROUTER, bool XB, bool F8OUT = ROUTER> DI void norm_phase(const Ctx& X, const void* xin_, const float* nw, const float* modL, int sh_off, int sc_off, bf16* hout, const float* router_w, unsigned char* ws) {
    LAS float* rw = (LAS float*)X.lds;
    if (ROUTER) { for (int i = X.tid; i < D * NEXP / 4; i += NTHR) ((LAS f32x4*)rw)[i] = ((const f32x4*)router_w)[i]; SYNC(); }
    for (int rb = X.gw; rb < T / 16; rb += X.NGW) {
        const int m0 = rb * 16, b = m0 / SEQ;
        f32x4 a[4], s[4];
#pragma unroll
        for (int j = 0; j < 4; ++j) { const int col = 4 * X.lane + 256 * j; const f32x4 w = *(const f32x4*)(nw + col), sc = *(const f32x4*)(modL + (size_t)b * MODW + sc_off + col);
            a[j] = w * (1.0f + sc); s[j] = *(const f32x4*)(modL + (size_t)b * MODW + sh_off + col); }
        unsigned long long cnt0 = 0ull, cnt1 = 0ull;
        typedef typename std::conditional<XB, u32x2, f32x4>::type raw_t;
        raw_t raw[3][4];
#define NORM_LDRAW(m_, dst) do { const raw_t* xr_ = (XB ? (const raw_t*)((const bf16*)xin_ + (size_t)(m_) * D) : (const raw_t*)((const float*)xin_ + (size_t)(m_) * D)) + X.lane; \
            _Pragma("unroll") for (int j = 0; j < 4; ++j) dst[j] = xr_[64 * j]; } while (0)
        NORM_LDRAW(m0, raw[0]); NORM_LDRAW(m0 + 1, raw[1]);
#pragma unroll
        for (int jr = 0; jr < 16; ++jr) {
            const int m = m0 + jr;
            if (jr + 2 < 16) NORM_LDRAW(m0 + jr + 2, raw[(jr + 2) % 3]);
            __builtin_amdgcn_sched_barrier(0);
            f32x4 v[4]; float ss = 0.f;
#pragma unroll
            for (int j = 0; j < 4; ++j) {
                if constexpr (XB) { const u32x2 w_ = raw[jr % 3][j]; v[j] = (f32x4){__uint_as_float(w_.x << 16), __uint_as_float(w_.x & 0xffff0000u), __uint_as_float(w_.y << 16), __uint_as_float(w_.y & 0xffff0000u)}; }
                else v[j] = raw[jr % 3][j]; }
#pragma unroll
            for (int j = 0; j < 4; ++j) ss += (v[j].x * v[j].x + v[j].y * v[j].y) + (v[j].z * v[j].z + v[j].w * v[j].w);
            const float rstd = frsq(wave_sum(ss, X.lane) * (1.0f / D) + EPS);
            unsigned long long* o8 = (unsigned long long*)(hout + (size_t)m * D) + X.lane;
#pragma unroll
            for (int j = 0; j < 4; ++j) { v[j] = v[j] * rstd * a[j] + s[j];
                if (F8OUT) { int w = 0;
                    w = __builtin_amdgcn_cvt_pk_fp8_f32(__builtin_amdgcn_fmed3f(32.0f * v[j].x, -448.f, 448.f), __builtin_amdgcn_fmed3f(32.0f * v[j].y, -448.f, 448.f), w, false);
                    w = __builtin_amdgcn_cvt_pk_fp8_f32(__builtin_amdgcn_fmed3f(32.0f * v[j].z, -448.f, 448.f), __builtin_amdgcn_fmed3f(32.0f * v[j].w, -448.f, 448.f), w, true);
                    ((int*)((unsigned char*)hout + (size_t)m * D))[X.lane + 64 * j] = w; }
                else o8[64 * j] = (unsigned long long)pk2(v[j].x, v[j].y) | ((unsigned long long)pk2(v[j].z, v[j].w) << 32); }
            if (ROUTER) {
                float lg[8];
#pragma unroll
                for (int e = 0; e < 8; ++e) lg[e] = 0.f;
#pragma unroll
                for (int j = 0; j < 4; ++j) { asm volatile("" ::: "memory");
#pragma unroll
                    for (int i = 0; i < 4; ++i) { const int col = 4 * X.lane + 256 * j + i; const f32x4 w0 = *(const LAS f32x4*)(rw + col * 8), w1 = *(const LAS f32x4*)(rw + col * 8 + 4); const float hv = v[j][i];
                        lg[0] += hv * w0.x; lg[1] += hv * w0.y; lg[2] += hv * w0.z; lg[3] += hv * w0.w; lg[4] += hv * w1.x; lg[5] += hv * w1.y; lg[6] += hv * w1.z; lg[7] += hv * w1.w; } }
#pragma unroll
                for (int e = 0; e < 8; ++e) lg[e] = wave_sum(lg[e], X.lane);
                int e0 = 0; float v0 = lg[0];
#pragma unroll
                for (int e = 1; e < 8; ++e) if (lg[e] > v0) { v0 = lg[e]; e0 = e; }
                int e1 = -1; float v1 = -3.0e38f;
#pragma unroll
                for (int e = 0; e < 8; ++e) if (e != e0 && lg[e] > v1) { v1 = lg[e]; e1 = e; }
                const float w1 = frcp(1.0f + fexp(v0 - v1)), w0 = 1.0f - w1;
                cnt0 += 1ull << (8 * e0); cnt1 += 1ull << (8 * e1);
                if (X.lane == 0) { ((int*)(ws + WS_ROUTE_E))[m] = e0 | (e1 << 8); ((f32x2*)(ws + WS_ROUTE_W))[m] = (f32x2){w0, w1}; }
            }
            __builtin_amdgcn_sched_barrier(0);
        }
        if (ROUTER && X.lane == 0) { ((unsigned long long*)(ws + WS_WCNT))[rb * 2] = cnt0; ((unsigned long long*)(ws + WS_WCNT))[rb * 2 + 1] = cnt1; }
    }
}
DI void final_norm_phase(const Ctx& X, const bf16* xin, const bf16* y0, const bf16* y1, const float* gate, const float* nw, float* out) {
    f32x4 a[4];
#pragma unroll
    for (int j = 0; j < 4; ++j) a[j] = *(const f32x4*)(nw + 4 * X.lane + 256 * j);
#define FN_UP(w_) ((f32x4){__uint_as_float((w_).x << 16), __uint_as_float((w_).x & 0xffff0000u), __uint_as_float((w_).y << 16), __uint_as_float((w_).y & 0xffff0000u)})
#define FN_LD(m_, W, P, Q, GV) do { const size_t o_ = (size_t)((m_) < T ? (m_) : T - 1) * D; const u32x2* xr_ = (const u32x2*)(xin + o_) + X.lane; const u32x2* pr_ = (const u32x2*)(y0 + o_) + X.lane; const u32x2* qr_ = (const u32x2*)(y1 + o_) + X.lane; \
        const float* gp_ = gate + (size_t)(((m_) < T ? (m_) : T - 1) / SEQ) * MODW + 4 * X.lane; \
        _Pragma("unroll") for (int j = 0; j < 4; ++j) { W[j] = xr_[64 * j]; P[j] = pr_[64 * j]; Q[j] = qr_[64 * j]; GV[j] = *(const f32x4*)(gp_ + 256 * j); } } while (0)
    for (int m00 = X.gw; m00 < T; m00 += 16 * X.NGW) {
        u32x2 wr[3][4], pr[3][4], qr[3][4]; f32x4 gr[3][4];
        FN_LD(m00, wr[0], pr[0], qr[0], gr[0]); FN_LD(m00 + X.NGW, wr[1], pr[1], qr[1], gr[1]);
#pragma unroll
        for (int k = 0; k < 16; ++k) {
            const int m = m00 + k * X.NGW;
            if (k + 2 < 16) FN_LD(m + 2 * X.NGW, wr[(k + 2) % 3], pr[(k + 2) % 3], qr[(k + 2) % 3], gr[(k + 2) % 3]);
            __builtin_amdgcn_sched_barrier(0);
            f32x4 v[4]; float ss = 0.f;
#pragma unroll
            for (int j = 0; j < 4; ++j) { const u32x2 w = wr[k % 3][j], y = pr[k % 3][j], z = qr[k % 3][j];
                v[j] = FN_UP(w) + gr[k % 3][j] * (FN_UP(y) + FN_UP(z));
                ss += (v[j].x * v[j].x + v[j].y * v[j].y) + (v[j].z * v[j].z + v[j].w * v[j].w); }
            const float rstd = frsq(wave_sum(ss, X.lane) * (1.0f / D) + EPS);
            if (m < T) { f32x4* o = (f32x4*)(out + (size_t)m * D) + X.lane;
#pragma unroll
                for (int j = 0; j < 4; ++j) o[64 * j] = v[j] * rstd * a[j]; }
            __builtin_amdgcn_sched_barrier(0);
        }
    }
#undef FN_LD
#undef FN_UP
}

DI void moe_list_phase(const Ctx& X, unsigned char* ws) {
    const unsigned long long* wc = (const unsigned long long*)(ws + WS_WCNT);
    int* list = (int*)(ws + WS_LIST); float* roww = (float*)(ws + WS_ROWW); int* tiles = (int*)(ws + WS_TILES);
    for (int rb = X.gw; rb < T / 16; rb += X.NGW) {
        int tot[2][8], pre[2][8];
#pragma unroll
        for (int s = 0; s < 2; ++s)
#pragma unroll
            for (int e = 0; e < 8; ++e) { tot[s][e] = 0; pre[s][e] = 0; }
        for (int r2 = X.lane; r2 < T / 16; r2 += 64) {
            const unsigned long long c0 = wc[r2 * 2], c1 = wc[r2 * 2 + 1]; const bool lt = r2 < rb;
#pragma unroll
            for (int e = 0; e < 8; ++e) { const int a0 = (int)((c0 >> (8 * e)) & 0xffull), a1 = (int)((c1 >> (8 * e)) & 0xffull);
                tot[0][e] += a0; tot[1][e] += a1; pre[0][e] += lt ? a0 : 0; pre[1][e] += lt ? a1 : 0; }
        }
#pragma unroll
        for (int s = 0; s < 2; ++s)
#pragma unroll
            for (int e = 0; e < 8; ++e) {
#pragma unroll
                for (int o = 1; o < 64; o <<= 1) { tot[s][e] += bperm_i(X.lane ^ o, tot[s][e]); pre[s][e] += bperm_i(X.lane ^ o, pre[s][e]); } }
        int base[2][8], nt[2];
#pragma unroll
        for (int s = 0; s < 2; ++s) { int acc = 0;
#pragma unroll
            for (int e = 0; e < 8; ++e) { base[s][e] = acc; acc += (tot[s][e] + 255) & ~255; } nt[s] = acc / 256; }
        const int j = X.lane & 15, m = rb * 16 + j;
        const int ee = ((const int*)(ws + WS_ROUTE_E))[m]; const f32x2 ww = ((const f32x2*)(ws + WS_ROUTE_W))[m];
#pragma unroll
        for (int s = 0; s < 2; ++s) {
            const int es = s == 0 ? (ee & 0xff) : ((ee >> 8) & 0xff);
            int pos = 0;
#pragma unroll
            for (int e = 0; e < 8; ++e) pos = (es == e) ? base[s][e] + pre[s][e] : pos;
            int rank = 0;
#pragma unroll
            for (int jj = 0; jj < 16; ++jj) { const int eo = bperm_i(jj, es); rank += (jj < j && eo == es) ? 1 : 0; }
            const int off = s == 0 ? 0 : nt[0] * 256;
            if (X.lane < 16) { list[off + pos + rank] = m; roww[off + pos + rank] = s == 0 ? ww.x : ww.y; }
        }
        if (rb == 0) {
#pragma unroll
            for (int s = 0; s < 2; ++s) { const int off = s == 0 ? 0 : nt[0] * 256;
#pragma unroll
                for (int e = 0; e < 8; ++e) { const int lo = base[s][e] + tot[s][e], hi = base[s][e] + ((tot[s][e] + 255) & ~255);
                    for (int r = lo + X.lane; r < hi; r += 64) { list[off + r] = -1; roww[off + r] = 0.f; }
                    for (int t = base[s][e] / 256 + X.lane; t < hi / 256; t += 64) tiles[off / 256 + t] = e; }
            }
            if (X.lane == 0) { tiles[TILE_TAB - 2] = nt[0]; tiles[TILE_TAB - 1] = nt[0] + nt[1]; }
        }
    }
}

DI void dn_prep_phase(const Ctx& X, const bf16* proj, const float* convw, const float* a_log, const float* dt_bias, unsigned char* ws, bf16* dnb) {
    LAS float* qf = (LAS float*)(X.lds + 0); LAS float* kf = (LAS float*)(X.lds + 16640); LAS float* vf = (LAS float*)(X.lds + 33280);
    LAS float* Ld = (LAS float*)(X.lds + 49920); LAS float* Tinv = (LAS float*)(X.lds + 55040);
    LAS float* cwb = (LAS float*)(X.lds + 60160);
    LAS float* hpar = (LAS float*)(X.lds + 63232);
    LAS bf16* Qb = (LAS bf16*)(X.lds + 67328); LAS bf16* Kb = (LAS bf16*)(X.lds + 76544); LAS bf16* KBb = (LAS bf16*)(X.lds + 85760);
    LAS float* gcv = (LAS float*)(X.lds + 94976); LAS float* betav = gcv + 64; LAS float* egv = gcv + 128; LAS float* ekv = gcv + 192; LAS float* gv = gcv + 256;
    LAS bf16* Lb = (LAS bf16*)(X.lds + 96256);
    LAS bf16* Xt = (LAS bf16*)(X.lds + 105472);
    const int tid = X.tid, lane = X.lane;
#define DNP_LOAD(u_, XR, BD) do { const int uu = (u_) < NBATCH * 6 * NCHUNK ? (u_) : X.vcu; const int b_ = uu / (6 * NCHUNK), h_ = (uu / NCHUNK) % 6, n_ = uu % NCHUNK; \
        _Pragma("unroll") for (int k = 0; k < 3; ++k) { const int it = tid + k * NTHR, t_ = it / 24, g8 = it % 24, which = g8 >> 3, col = (which == 0 ? C_DQ : (which == 1 ? C_DK : C_DV)) + h_ * 64 + (g8 & 7) * 8; \
            _Pragma("unroll") for (int j = 0; j < 4; ++j) { const int tt = n_ * 64 + t_ - 3 + j; XR[k][j] = *(const v4u*)(proj + ((size_t)b_ * SEQ + (tt < 0 ? 0 : tt)) * DINP + col); } \
            BD[k] = *(const unsigned*)(proj + ((size_t)b_ * SEQ + n_ * 64 + t_) * DINP + C_DB + 2 * (h_ >> 1)); } \
        if (tid < 64) BD[3] = *(const unsigned*)(proj + ((size_t)b_ * SEQ + n_ * 64 + tid) * DINP + C_DA + 2 * (h_ >> 1)); \
        if (tid < 192) cwq = *(const f32x4*)(convw + (tid / 48) * 1152 + (((tid % 48) * 4) >> 6) * 384 + h_ * 64 + (((tid % 48) * 4) & 63)); } while (0)
    v4u xr[3][4]; unsigned bd[4] = {0u, 0u, 0u, 0u}; f32x4 cwq = (f32x4){0.f, 0.f, 0.f, 0.f};
    DNP_LOAD(X.vcu, xr, bd);
    if (tid < 192) *(LAS f32x4*)(cwb + tid * 4) = cwq;
    if (tid < 6) { hpar[2 * tid] = -fexp(a_log[tid]); hpar[2 * tid + 1] = dt_bias[tid]; }
    SYNC();
    for (int u = X.vcu; u < NBATCH * 6 * NCHUNK; u += X.G) {
        const int b = u / (6 * NCHUNK), h = (u / NCHUNK) % 6, n = u % NCHUNK;
        bf16* ub = dnb + (size_t)u * 5 * 4096;
#pragma unroll
        for (int k = 0; k < 3; ++k) {
            const int it = tid + k * NTHR, t = it / 24, g8 = it % 24, which = g8 >> 3, d0 = (g8 & 7) * 8, cch = which * 384 + h * 64 + d0;
            float y[8];
#pragma unroll
            for (int i = 0; i < 8; ++i) y[i] = 0.f;
#pragma unroll
            for (int j = 0; j < 4; ++j) { v4u xw = xr[k][j]; if (n * 64 + t - 3 + j < 0) xw = (v4u){0u, 0u, 0u, 0u}; float xf[8]; unpack8(xw, xf);
                const f32x4 w0 = *(const LAS f32x4*)(cwb + j * 192 + which * 64 + d0), w1 = *(const LAS f32x4*)(cwb + j * 192 + which * 64 + d0 + 4);
                y[0] += w0.x * xf[0]; y[1] += w0.y * xf[1]; y[2] += w0.z * xf[2]; y[3] += w0.w * xf[3]; y[4] += w1.x * xf[4]; y[5] += w1.y * xf[5]; y[6] += w1.z * xf[6]; y[7] += w1.w * xf[7]; }
            float ss = 0.f;
#pragma unroll
            for (int i = 0; i < 8; ++i) { y[i] = silu(y[i]); ss += y[i] * y[i]; }
            ss = dpp_sum8(ss);
            const float sc = which == 2 ? 1.0f : frsq(ss + EPS) * (which == 0 ? 0.125f : 1.0f);
#pragma unroll
            for (int i = 0; i < 8; ++i) y[i] *= sc;
            LAS float* dst = (which == 0 ? qf : (which == 1 ? kf : vf)) + t * 65 + d0;
#pragma unroll
            for (int i = 0; i < 8; ++i) dst[i] = y[i];
            const float bt = sigm(bf2f((h & 1) ? (bd[k] >> 16) : (bd[k] & 0xffffu)));
            if (which == 0) *(LAS v4u*)(Qb + t * 72 + d0) = pack8(y);
            if (which == 1) { *(LAS v4u*)(Kb + t * 72 + d0) = pack8(y);
#pragma unroll
                for (int i = 0; i < 8; ++i) y[i] *= bt;
                *(LAS v4u*)(KBb + t * 72 + d0) = pack8(y); }
            if (which == 2 && d0 == 0) betav[t] = bt;
        }
        for (int i = tid; i < 128 * 72 / 2; i += NTHR) ((LAS unsigned*)Xt)[i] = 0u;
        if (tid < 64) gv[tid] = hpar[2 * h] * softplus(bf2f((h & 1) ? (bd[3] >> 16) : (bd[3] & 0xffffu)) + hpar[2 * h + 1]);
        SYNC();
        if (X.wave == 0) { float v = gv[lane];
#pragma unroll
            for (int o = 1; o < 64; o <<= 1) { const float up = bperm_f(lane - o, v); if (lane >= o) v += up; }
            const float gl = bperm_f(63, v);
            gcv[lane] = v; egv[lane] = fexp(v); ekv[lane] = fexp(gl - v);
            if (lane == 63) ((float*)(ws + WS_DNDEC))[u] = fexp(gl); }
        const int tr = X.wave >> 1, r = lane & 15, q = lane >> 4, tc0 = (X.wave & 1) * 2;
        f32x4 akk0, akk1, aqk0, aqk1;
        { const f32x4 z = (f32x4){0.f, 0.f, 0.f, 0.f};
            const LAS bf16* pa = KBb + (16 * tr + r) * 72 + q * 8; const LAS bf16* pq = Qb + (16 * tr + r) * 72 + q * 8; const LAS bf16* pb = Kb + (16 * tc0 + r) * 72 + q * 8;
            const bf16x8 a0 = LDF(pa), a1 = LDF(pa + 32), q0 = LDF(pq), q1 = LDF(pq + 32), b00 = LDF(pb), b01 = LDF(pb + 32), b10 = LDF(pb + 16 * 72), b11 = LDF(pb + 16 * 72 + 32);
            akk0 = MFMA16(a0, b00, z); akk1 = MFMA16(a0, b10, z); aqk0 = MFMA16(q0, b00, z); aqk1 = MFMA16(q0, b10, z);
            akk0 = MFMA16(a1, b01, akk0); akk1 = MFMA16(a1, b11, akk1); aqk0 = MFMA16(q1, b01, aqk0); aqk1 = MFMA16(q1, b11, aqk1); }
        SYNC();
#pragma unroll
        for (int e = 0; e < 2; ++e) { const int tc = tc0 + e; const f32x4 akk = e == 0 ? akk0 : akk1, aqk = e == 0 ? aqk0 : aqk1;
            const int j = 16 * tc + r; const float gj = gcv[j];
#pragma unroll
            for (int ii = 0; ii < 4; ++ii) { const int i = 16 * tr + q * 4 + ii; const float dec = fexp(fminf(gcv[i] - gj, 0.f));
                const float lv = (j < i) ? akk[ii] * dec : 0.f;
                Lb[i * 72 + j] = (bf16)f2bf(lv);
                if (tr == tc) Ld[tr * 320 + (q * 4 + ii) * 20 + r] = lv;
                ub[4 * 4096 + i * 64 + j] = (bf16)f2bf((j <= i) ? aqk[ii] * dec : 0.f); } }
        if ((tr >> 1) == (X.wave & 1)) {
            asm volatile("s_waitcnt lgkmcnt(0)" ::: "memory");
            if (lane < 16) { const int c = lane; const LAS float* Lp = Ld + tr * 320;
                f32x4 Lr[16][4];
#define DNP_LROWS(m0_, m1_) _Pragma("unroll") for (int m = (m0_); m <= (m1_); ++m) _Pragma("unroll") for (int v = 0; v <= (m - 1) / 4; ++v) Lr[m][v] = *(const LAS f32x4*)(Lp + m * 20 + 4 * v)
#define DNP_TROWS(m0_, m1_) _Pragma("unroll") for (int m = (m0_); m <= (m1_); ++m) { float s = fmaxf(0.f, 1.0f - fabsf(cf - (float)m));   \
                    _Pragma("unroll") for (int k = 0; k < m; ++k) s -= Lr[m][k >> 2][k & 3] * tcol[k]; tcol[m] = s; }
                float cf = (float)c; asm volatile("" : "+v"(cf));
                float tcol[16];
                DNP_LROWS(1, 8); DNP_LROWS(9, 12);
                asm volatile("" ::: "memory");
                DNP_TROWS(0, 8);
                asm volatile("" ::: "memory");
                DNP_LROWS(13, 15);
                asm volatile("" ::: "memory");
                DNP_TROWS(9, 12);
                DNP_TROWS(13, 15);
#undef DNP_LROWS
#undef DNP_TROWS
#pragma unroll
                for (int m = 0; m < 16; ++m) Tinv[tr * 320 + m * 20 + c] = tcol[m]; }
        }
        for (int it = tid; it < 1024; it += NTHR) {
            float f[8];
            if (it < 512) { const int d = it >> 3, t0 = (it & 7) * 8;
#pragma unroll
                for (int i = 0; i < 8; ++i) f[i] = kf[(t0 + i) * 65 + d] * ekv[t0 + i];
                *(v4u*)(ub + 2 * 4096 + d * 64 + t0) = pack8(f);
            } else { const int i2 = it - 512, t = i2 >> 3, d0 = (i2 & 7) * 8; const float e = egv[t];
#pragma unroll
                for (int i = 0; i < 8; ++i) f[i] = qf[t * 65 + d0 + i] * e;
                *(v4u*)(ub + 3 * 4096 + t * 64 + d0) = pack8(f); }
        }
        SYNC();
        DNP_LOAD(u + X.G, xr, bd);
        { const int r = lane & 15, q = lane >> 4, c = 16 * X.wave + r; const bool isW = X.wave >= 4; const int cc = c & 63;
            f32x4 rhs[4], tfv[4];
            { const LAS float* src = (isW ? kf : vf) + cc;
#pragma unroll
                for (int i = 0; i < 4; ++i) { const int row = 16 * i + q * 4; f32x4 sc = *(const LAS f32x4*)(betav + row); if (isW) sc = sc * *(const LAS f32x4*)(egv + row);
                    rhs[i] = (f32x4){src[row * 65] * sc.x, src[(row + 1) * 65] * sc.y, src[(row + 2) * 65] * sc.z, src[(row + 3) * 65] * sc.w};
                    tfv[i] = *(const LAS f32x4*)(Tinv + i * 320 + r * 20 + 4 * q); } }
#pragma unroll
            for (int i = 0; i < 4; ++i) {
                f32x4 acc = (f32x4){0.f, 0.f, 0.f, 0.f};
                if (i > 0) { if (i < 3) acc = mm16<32>(Lb + 16 * i * 72, 72, Xt + 16 * X.wave * 72, 72, acc, lane); else acc = mm16<64>(Lb + 16 * i * 72, 72, Xt + 16 * X.wave * 72, 72, acc, lane); }
                const f32x4 tf = tfv[i];
                const f32x4 y = rhs[i] - acc;
                f32x4 xo = (f32x4){0.f, 0.f, 0.f, 0.f};
                xo = __builtin_amdgcn_mfma_f32_16x16x4f32(tf[0], y[0], xo, 0, 0, 0);
                xo = __builtin_amdgcn_mfma_f32_16x16x4f32(tf[1], y[1], xo, 0, 0, 0);
                xo = __builtin_amdgcn_mfma_f32_16x16x4f32(tf[2], y[2], xo, 0, 0, 0);
                xo = __builtin_amdgcn_mfma_f32_16x16x4f32(tf[3], y[3], xo, 0, 0, 0);
                const u32x2 pk = pack4(xo[0], xo[1], xo[2], xo[3]);
                *(LAS u32x2*)(Xt + c * 72 + 16 * i + q * 4) = pk;
                if (!isW) *(u32x2*)(ub + 1 * 4096 + cc * 64 + 16 * i + q * 4) = pk;
                else {
#pragma unroll
                    for (int ii = 0; ii < 4; ++ii) ub[(16 * i + q * 4 + ii) * 64 + cc] = (bf16)f2bf(xo[ii]); }
                asm volatile("s_waitcnt lgkmcnt(0)" ::: "memory");
            }
        }
        if (tid < 192) *(LAS f32x4*)(cwb + tid * 4) = cwq;
        SYNC();
    }
#undef DNP_LOAD
}

DI void dn_chain(const Ctx& X, int bh, const bf16* proj, const float* normw, const unsigned char* ws, const bf16* dnb, bf16* merged) {
    LAS bf16* Wl = (LAS bf16*)(X.lds + 0); LAS bf16* Utl = (LAS bf16*)(X.lds + 9216); LAS bf16* KEl = (LAS bf16*)(X.lds + 18432); LAS bf16* QDl = (LAS bf16*)(X.lds + 27648); LAS bf16* QKl = (LAS bf16*)(X.lds + 36864);
    LAS bf16* St0 = (LAS bf16*)(X.lds + 46080); LAS bf16* Vtl = (LAS bf16*)(X.lds + 64512); LAS float* Of = (LAS float*)(X.lds + 73728);
    const int tid = X.tid, lane = X.lane, b = bh / 6, h = bh % 6;
    const int prow = tid >> 3, pseg = (tid & 7) * 8;
    const int tr = X.wave >> 1, tc0 = (X.wave & 1) * 2, r = lane & 15, q = lane >> 4;
    const bf16* ubase = dnb + (size_t)bh * NCHUNK * 5 * 4096 + prow * 64 + pseg;
    const bf16* zbase = proj + ((size_t)b * SEQ + prow) * DINP + C_DZ + h * 64 + pseg;
    const float decl = ((const float*)(ws + WS_DNDEC))[bh * NCHUNK + lane];
    float nwv[8];
#pragma unroll
    for (int i = 0; i < 8; ++i) nwv[i] = normw[pseg + i];
    for (int i = tid; i < 2 * 64 * 72 / 2; i += NTHR) ((LAS unsigned*)St0)[i] = 0u;
    v4u pfE[5], pfO[5], dzE, dzO;
#pragma unroll
    for (int k = 0; k < 5; ++k) { pfE[k] = *(const v4u*)(ubase + k * 4096); pfO[k] = *(const v4u*)(ubase + (size_t)5 * 4096 + k * 4096); }
    dzE = *(const v4u*)zbase; dzO = *(const v4u*)(zbase + (size_t)64 * DINP);
#pragma unroll
    for (int k = 0; k < 5; ++k) *(LAS v4u*)(Wl + k * 4608 + prow * 72 + pseg) = pfE[k];
    f32x4 sreg0 = (f32x4){0.f, 0.f, 0.f, 0.f}, sreg1 = sreg0;
    const LAS bf16* aW = Wl + (16 * tr + r) * 72 + q * 8; const LAS bf16* aKE = KEl + (16 * tr + r) * 72 + q * 8; const LAS bf16* aQD = QDl + (16 * tr + r) * 72 + q * 8; const LAS bf16* aQK = QKl + (16 * tr + r) * 72 + q * 8;
    const int bo0 = (16 * tc0 + r) * 72 + q * 8, bo1 = bo0 + 16 * 72;
    const int co0 = (16 * tc0 + r) * 72 + 16 * tr + q * 4, co1 = co0 + 16 * 72;
    SYNC();
#define DN_OUT(nn, OFB, DZV) do { float o[8]; const f32x4 oa = *(const LAS f32x4*)((OFB) + prow * 68 + pseg), ob = *(const LAS f32x4*)((OFB) + prow * 68 + pseg + 4); \
          o[0] = oa.x; o[1] = oa.y; o[2] = oa.z; o[3] = oa.w; o[4] = ob.x; o[5] = ob.y; o[6] = ob.z; o[7] = ob.w; \
          float ss = 0.f; _Pragma("unroll") for (int i = 0; i < 8; ++i) ss += o[i] * o[i]; \
          ss = dpp_sum8(ss); const float rstd = frsq(ss * (1.0f / 64.0f) + EPS); \
          float zf[8]; unpack8(DZV, zf); _Pragma("unroll") for (int i = 0; i < 8; ++i) o[i] = o[i] * rstd * nwv[i] * silu(zf[i]); \
          *(v4u*)(merged + ((size_t)b * SEQ + (size_t)(nn) * 64 + prow) * D + 640 + h * 64 + pseg) = pack8(o); } while (0)
#define DN_ITER(n, DZC, PFF, DZF, PFS) do { \
        const v4u dzv = DZC; \
        { const int n2 = (n) + 2 < NCHUNK ? (n) + 2 : NCHUNK - 1; const bf16* up = ubase + (size_t)n2 * 5 * 4096; \
          _Pragma("unroll") for (int k = 0; k < 5; ++k) PFF[k] = *(const v4u*)(up + k * 4096); \
          DZF = *(const v4u*)(zbase + (size_t)n2 * 64 * DINP); } \
        const float dec = __builtin_bit_cast(float, __builtin_amdgcn_readlane(__builtin_bit_cast(int, decl), (n))); \
        LAS bf16* Sc = St0 + cur * 4608; LAS bf16* Sn = St0 + (cur ^ 1) * 4608; LAS float* Ofc = Of + cur * 4352; LAS float* Ofp = Of + (cur ^ 1) * 4352; \
        const f32x4 z = (f32x4){0.f, 0.f, 0.f, 0.f}; \
          \
        const bf16x8 w0 = LDF(aW), w1 = LDF(aW + 32), s00 = LDF(Sc + bo0), s01 = LDF(Sc + bo0 + 32), s10 = LDF(Sc + bo1), s11 = LDF(Sc + bo1 + 32); \
        const u32x2 ut0 = *(const LAS u32x2*)(Utl + co0), ut1 = *(const LAS u32x2*)(Utl + co1); \
        f32x4 a0 = MFMA16(w0, s00, z), a1 = MFMA16(w0, s10, z); a0 = MFMA16(w1, s01, a0); a1 = MFMA16(w1, s11, a1); \
        { float u0[4], u1[4]; unpack4(ut0, u0); unpack4(ut1, u1); \
          *(LAS u32x2*)(Vtl + co0) = pack4(u0[0] - a0[0], u0[1] - a0[1], u0[2] - a0[2], u0[3] - a0[3]); \
          *(LAS u32x2*)(Vtl + co1) = pack4(u1[0] - a1[0], u1[1] - a1[1], u1[2] - a1[2], u1[3] - a1[3]); } \
        const bf16x8 ke0 = LDF(aKE), ke1 = LDF(aKE + 32), qd0 = LDF(aQD), qd1 = LDF(aQD + 32), qk0 = LDF(aQK), qk1 = LDF(aQK + 32); \
        SYNC(); \
          \
        const bf16x8 v00 = LDF(Vtl + bo0), v01 = LDF(Vtl + bo0 + 32), v10 = LDF(Vtl + bo1), v11 = LDF(Vtl + bo1 + 32); \
        f32x4 o0 = MFMA16(qd0, s00, z), o1 = MFMA16(qd0, s10, z); o0 = MFMA16(qd1, s01, o0); o1 = MFMA16(qd1, s11, o1); \
        f32x4 n0 = MFMA16(ke0, v00, z), n1 = MFMA16(ke0, v10, z); \
        o0 = MFMA16(qk0, v00, o0); o1 = MFMA16(qk0, v10, o1); \
        n0 = MFMA16(ke1, v01, n0); n1 = MFMA16(ke1, v11, n1); \
        o0 = MFMA16(qk1, v01, o0); o1 = MFMA16(qk1, v11, o1); \
        if ((n) > 0) DN_OUT((n) - 1, Ofp, dzp);     \
        sreg0 = sreg0 * dec + n0; sreg1 = sreg1 * dec + n1; \
        *(LAS u32x2*)(Sn + co0) = pack4(sreg0[0], sreg0[1], sreg0[2], sreg0[3]); *(LAS u32x2*)(Sn + co1) = pack4(sreg1[0], sreg1[1], sreg1[2], sreg1[3]); \
        _Pragma("unroll") for (int i = 0; i < 4; ++i) { Ofc[(16 * tr + q * 4 + i) * 68 + 16 * tc0 + r] = o0[i]; Ofc[(16 * tr + q * 4 + i) * 68 + 16 * tc0 + 16 + r] = o1[i]; } \
        _Pragma("unroll") for (int k = 0; k < 5; ++k) *(LAS v4u*)(Wl + k * 4608 + prow * 72 + pseg) = PFS[k]; \
        SYNC(); dzp = dzv; cur ^= 1; } while (0)
    int cur = 0; v4u dzp = dzE;
    for (int n = 0; n < NCHUNK; n += 2) {
        DN_ITER(n, dzE, pfE, dzE, pfO);
        DN_ITER(n + 1, dzO, pfO, dzO, pfE);
    }
    DN_OUT(NCHUNK - 1, Of + (cur ^ 1) * 4352, dzp);
    SYNC();
#undef DN_ITER
#undef DN_OUT
}

DI void gla_prep_phase(const Ctx& X, const bf16* proj, const float* w2, const float* b2, unsigned char* ws) {
    LAS float* W2s = (LAS float*)(X.lds + 0); LAS float* b2s = (LAS float*)(X.lds + 2048);
    LAS float* la = (LAS float*)(X.lds + 2304);
    LAS float* tot = (LAS float*)(X.lds + 10752);
    LAS bf16* QDl = (LAS bf16*)(X.lds + 12800); LAS bf16* KDl = (LAS bf16*)(X.lds + 17920);
    LAS bf16* KEl = (LAS bf16*)(X.lds + 23040);
    LAS bf16* Vtl = (LAS bf16*)(X.lds + 27648); LAS bf16* Pl = (LAS bf16*)(X.lds + 36864);
    const int tid = X.tid, lane = X.lane, t = tid >> 3, part = tid & 7, r = lane & 15, q = lane >> 4;
#define GLAP_LOAD(u_, Q4, K4, V8, G0, G1, WV, BV) do { const int uu = (u_) < NBATCH * 6 * NCHUNK ? (u_) : X.vcu; const int b_ = uu / (6 * NCHUNK), h_ = (uu / NCHUNK) % 6, n_ = uu % NCHUNK; \
        const bf16* pr_ = proj + ((size_t)b_ * SEQ + (size_t)n_ * 64 + t) * DINP; \
        Q4 = *(const u32x2*)(pr_ + C_GQ + h_ * 32 + part * 4); K4 = *(const u32x2*)(pr_ + C_GK + h_ * 32 + part * 4); V8 = *(const v4u*)(pr_ + C_GV + h_ * 64 + part * 8); \
        G0 = *(const v4u*)(pr_ + C_GLR); G1 = *(const v4u*)(pr_ + C_GLR + 8); WV = w2[(tid >> 5) * 192 + h_ * 32 + (tid & 31)]; BV = b2[h_ * 32 + (tid & 31)]; } while (0)
    u32x2 q4, k4, q4n, k4n; v4u v8, g0, g1, v8n, g0n, g1n; float wv, bv, wvn, bvn;
    GLAP_LOAD(X.vcu, q4, k4, v8, g0, g1, wv, bv);
    for (int u = X.vcu; u < NBATCH * 6 * NCHUNK; u += X.G) {
        const int b = u / (6 * NCHUNK), h = (u / NCHUNK) % 6, n = u % NCHUNK;
        bf16* ub = (bf16*)(ws + WS_GLA) + (size_t)u * 8192;
        W2s[tid] = wv;
        if (tid < 32) b2s[tid] = bv;
        GLAP_LOAD(u + X.G, q4n, k4n, v8n, g0n, g1n, wvn, bvn);
        SYNC();
        { float gl[16]; { float t0[8], t1[8]; unpack8(g0, t0); unpack8(g1, t1);
#pragma unroll
                for (int i = 0; i < 8; ++i) { gl[i] = t0[i]; gl[8 + i] = t1[i]; } }
            f32x4 zz = *(const LAS f32x4*)(b2s + part * 4);
#pragma unroll
            for (int rr = 0; rr < 16; ++rr) zz += *(const LAS f32x4*)(W2s + rr * 32 + part * 4) * gl[rr];
#pragma unroll
            for (int cc = 0; cc < 4; ++cc) la[t * 33 + part * 4 + cc] = -softplus(-zz[cc]) * (1.0f / 16.0f); }
        SYNC();
        const int cc2 = tid & 31, seg = tid >> 5;
        const float l0 = la[(seg * 4 + 0) * 33 + cc2], l1 = l0 + la[(seg * 4 + 1) * 33 + cc2], l2 = l1 + la[(seg * 4 + 2) * 33 + cc2], l3 = l2 + la[(seg * 4 + 3) * 33 + cc2];
        tot[seg * 32 + cc2] = l3;
        SYNC();
        { float off = 0.f;
#pragma unroll
            for (int s2 = 0; s2 < 15; ++s2) off += (s2 < seg) ? tot[s2 * 32 + cc2] : 0.f;
            la[(seg * 4 + 0) * 33 + cc2] = off + l0; la[(seg * 4 + 1) * 33 + cc2] = off + l1; la[(seg * 4 + 2) * 33 + cc2] = off + l2; la[(seg * 4 + 3) * 33 + cc2] = off + l3; }
        SYNC();
        { float qf[4], kf[4]; unpack4(q4, qf); unpack4(k4, kf); float qd[4], kd[4];
#pragma unroll
            for (int cc = 0; cc < 4; ++cc) { const int c = part * 4 + cc; const float bc = la[t * 33 + c], bl = la[63 * 33 + c];
                qd[cc] = qf[cc] * 0.17677669529663687f * fexp(bc); kd[cc] = kf[cc] * fexp(-bc);
                KEl[c * 72 + t] = (bf16)f2bf(kf[cc] * fexp(bl - bc)); }
            const u32x2 qp = pack4(qd[0], qd[1], qd[2], qd[3]);
            *(LAS u32x2*)(QDl + t * 40 + part * 4) = qp; *(u32x2*)(ub + t * 32 + part * 4) = qp;
            *(LAS u32x2*)(KDl + t * 40 + part * 4) = pack4(kd[0], kd[1], kd[2], kd[3]);
            const unsigned vw[4] = {v8.x, v8.y, v8.z, v8.w};
#pragma unroll
            for (int i = 0; i < 4; ++i) { Vtl[(part * 8 + 2 * i) * 72 + t] = (bf16)(vw[i] & 0xffffu); Vtl[(part * 8 + 2 * i + 1) * 72 + t] = (bf16)(vw[i] >> 16); }
            if (tid < 32) ((float*)(ws + WS_GLADEC))[(size_t)u * 32 + tid] = fexp(la[63 * 33 + tid]); }
        SYNC();
        { const f32x4 z = (f32x4){0.f, 0.f, 0.f, 0.f}; const int trs = X.wave >> 1;
#pragma unroll
            for (int e = 0; e < 2; ++e) { const int tct = (X.wave & 1) * 2 + e;
                const f32x4 a = mm16<32>(KDl + 16 * trs * 40, 40, QDl + 16 * tct * 40, 40, z, lane);
                const int tq = 16 * tct + r, s0 = 16 * trs + q * 4;
                *(LAS u32x2*)(Pl + tq * 72 + s0) = pack4(s0 <= tq ? a[0] : 0.f, s0 + 1 <= tq ? a[1] : 0.f, s0 + 2 <= tq ? a[2] : 0.f, s0 + 3 <= tq ? a[3] : 0.f); }
            const int trS = X.wave >> 2, tcS = X.wave & 3;
            const f32x4 a = mm16<64>(KEl + 16 * trS * 72, 72, Vtl + 16 * tcS * 72, 72, z, lane);
            *(u32x2*)(ub + 6144 + ((trS * 4 + tcS) * 64 + lane) * 4) = pack4(a[0], a[1], a[2], a[3]); }
        SYNC();
        { const f32x4 z = (f32x4){0.f, 0.f, 0.f, 0.f}; const int tr = X.wave >> 1;
#pragma unroll
            for (int e = 0; e < 2; ++e) { const int tc = (X.wave & 1) * 2 + e;
                const f32x4 o = mm16<64>(Pl + 16 * tr * 72, 72, Vtl + 16 * tc * 72, 72, z, lane);
                *(u32x2*)(ub + 2048 + ((tr * 4 + tc) * 64 + lane) * 4) = pack4(o[0], o[1], o[2], o[3]); } }
        q4 = q4n; k4 = k4n; v8 = v8n; g0 = g0n; g1 = g1n; wv = wvn; bv = bvn;
        SYNC();
    }
#undef GLAP_LOAD
}
DI void gla_chain(const Ctx& X, int bh, const bf16* proj, const float* normw, const unsigned char* ws, bf16* merged) {
    LAS bf16* St0 = (LAS bf16*)(X.lds + 0);
    LAS float* Of0 = (LAS float*)(X.lds + 10240);
    const int tid = X.tid, lane = X.lane, b = bh / 6, h = bh % 6;
    const int t = tid >> 3, part = tid & 7, r = lane & 15, q = lane >> 4;
    const int tr = X.wave >> 1, tc0 = (X.wave & 1) * 2, trS = X.wave >> 2, tcS = X.wave & 3;
    for (int i = tid; i < 2 * 64 * 40 / 2; i += NTHR) ((LAS unsigned*)St0)[i] = 0u;
    float nwv[8];
#pragma unroll
    for (int i = 0; i < 8; ++i) nwv[i] = normw[part * 8 + i];
    const bf16* ub0 = (const bf16*)(ws + WS_GLA) + (size_t)bh * NCHUNK * 8192;
    const float* dp0 = (const float*)(ws + WS_GLADEC) + (size_t)bh * NCHUNK * 32;
    const bf16* zp0 = proj + ((size_t)b * SEQ + t) * DINP + C_GZ + h * 64 + part * 8;
    f32x4 sreg = (f32x4){0.f, 0.f, 0.f, 0.f};
#define GLA_LOAD(n, QD, OI0, OI1, KV, DC, Z) do { const int n4 = (n) < NCHUNK ? (n) : NCHUNK - 1; const bf16* ubn = ub0 + (size_t)n4 * 8192; \
        QD = *(const v4u*)(ubn + (16 * tr + r) * 32 + q * 8); \
        OI0 = *(const u32x2*)(ubn + 2048 + ((tr * 4 + tc0) * 64 + lane) * 4); OI1 = *(const u32x2*)(ubn + 2048 + ((tr * 4 + tc0 + 1) * 64 + lane) * 4); \
        KV = *(const u32x2*)(ubn + 6144 + ((trS * 4 + tcS) * 64 + lane) * 4); \
        DC = *(const f32x4*)(dp0 + (size_t)n4 * 32 + 16 * trS + 4 * q); \
        Z = *(const v4u*)(zp0 + (size_t)n4 * 64 * DINP); } while (0)
    v4u qdA, qdB, qdC, qdD, zA, zB, zC, zD; u32x2 o0A, o1A, kvA, o0B, o1B, kvB, o0C, o1C, kvC, o0D, o1D, kvD; f32x4 dcA, dcB, dcC, dcD;
    GLA_LOAD(0, qdA, o0A, o1A, kvA, dcA, zA); GLA_LOAD(1, qdB, o0B, o1B, kvB, dcB, zB); GLA_LOAD(2, qdC, o0C, o1C, kvC, dcC, zC); GLA_LOAD(3, qdD, o0D, o1D, kvD, dcD, zD);
    SYNC();
    int cur = 0;
#define GLA_ITER(n, QD, OI0, OI1, KV, DC, Z) do { \
        LAS bf16* Sc = St0 + cur * 2560; LAS bf16* Sn = St0 + (cur ^ 1) * 2560; LAS float* Of = Of0 + cur * 4352; \
        const bf16x8 qa = __builtin_bit_cast(bf16x8, QD); \
        const bf16x8 sb0 = LDF(Sc + (16 * tc0 + r) * 40 + q * 8), sb1 = LDF(Sc + (16 * tc0 + 16 + r) * 40 + q * 8); \
        const f32x4 z = (f32x4){0.f, 0.f, 0.f, 0.f}; \
        const f32x4 oa = MFMA16(qa, sb0, z), ob = MFMA16(qa, sb1, z); \
        { float f0[4], f1[4]; unpack4(OI0, f0); unpack4(OI1, f1); \
          _Pragma("unroll") for (int i = 0; i < 4; ++i) { Of[(16 * tr + q * 4 + i) * 68 + 16 * tc0 + r] = oa[i] + f0[i]; Of[(16 * tr + q * 4 + i) * 68 + 16 * tc0 + 16 + r] = ob[i] + f1[i]; } } \
        { float kf[4]; unpack4(KV, kf); _Pragma("unroll") for (int i = 0; i < 4; ++i) sreg[i] = DC[i] * sreg[i] + kf[i]; \
          *(LAS u32x2*)(Sn + (16 * tcS + r) * 40 + 16 * trS + q * 4) = pack4(sreg[0], sreg[1], sreg[2], sreg[3]); } \
        SYNC(); \
        { float o[8]; const f32x4 p0 = *(const LAS f32x4*)(Of + t * 68 + part * 8), p1 = *(const LAS f32x4*)(Of + t * 68 + part * 8 + 4); \
          o[0] = p0.x; o[1] = p0.y; o[2] = p0.z; o[3] = p0.w; o[4] = p1.x; o[5] = p1.y; o[6] = p1.z; o[7] = p1.w; \
          float ss = 0.f; _Pragma("unroll") for (int i = 0; i < 8; ++i) ss += o[i] * o[i]; \
          ss = dpp_sum8(ss); const float rstd = frsq(ss * (1.0f / 64.0f) + EPS); \
          float zf[8]; unpack8(Z, zf); _Pragma("unroll") for (int i = 0; i < 8; ++i) o[i] = o[i] * rstd * nwv[i] * silu(zf[i]); \
          *(v4u*)(merged + ((size_t)b * SEQ + (size_t)(n) * 64 + t) * D + h * 64 + part * 8) = pack8(o); } \
        GLA_LOAD((n) + 4, QD, OI0, OI1, KV, DC, Z); \
        cur ^= 1; } while (0)
    for (int n = 0; n < NCHUNK; n += 4) {
        GLA_ITER(n, qdA, o0A, o1A, kvA, dcA, zA); GLA_ITER(n + 1, qdB, o0B, o1B, kvB, dcB, zB); GLA_ITER(n + 2, qdC, o0C, o1C, kvC, dcC, zC); GLA_ITER(n + 3, qdD, o0D, o1D, kvD, dcD, zD);
    }
#undef GLA_ITER
#undef GLA_LOAD
    SYNC();
}

template <bool PASSB> DI void lru_units(const Ctx& X, int first, int stride, const bf16* proj, const float* convw, const float* convb, const float* wa, const float* ba, const float* wx, const float* bx, const float* lam, unsigned char* ws, bf16* merged) {
    LAS bf16* WAt = (LAS bf16*)(X.lds + 0); LAS bf16* WXt = (LAS bf16*)(X.lds + 9216); LAS bf16* xrb = (LAS bf16*)(X.lds + 18432);
    LAS float* xrf = (LAS float*)(X.lds + 27648); LAS float* af = (LAS float*)(X.lds + 44288); LAS float* uf = (LAS float*)(X.lds + 60928);
    LAS float* cws = (LAS float*)(X.lds + 77568);
    const int tid = X.tid, lane = X.lane, nb = first & 3;
    const int t = tid >> 3, part = tid & 7, r = lane & 15, q = lane >> 4, tr = X.wave >> 1;
    if (first >= NBATCH * NCHUNK * 4) return;
    for (int i = tid; i < 4096; i += NTHR) { const int j = i >> 6, k = i & 63; WAt[k * 72 + j] = (bf16)f2bf(wa[(size_t)nb * 4096 + i]); WXt[k * 72 + j] = (bf16)f2bf(wx[(size_t)nb * 4096 + i]); }
    if (tid < 320) cws[tid] = tid < 256 ? convw[(tid >> 6) * 256 + nb * 64 + (tid & 63)] : convb[nb * 64 + (tid & 63)];
    float bav[2], bxv[2], spv[2];
#pragma unroll
    for (int e = 0; e < 2; ++e) { const int ch = nb * 64 + 16 * ((X.wave & 1) * 2 + e) + r; bav[e] = ba[ch]; bxv[e] = bx[ch]; spv[e] = softplus(-lam[ch]); }
    float* carry = (float*)(ws + WS_LRUC);
    LAS float* segA = (LAS float*)(X.lds + 78848); LAS float* segH = segA + 512;
#define LRU_LOAD(u_, XV, LG) do { const int uu = (u_) < NBATCH * NCHUNK * 4 ? (u_) : first; const int b_ = uu >> 8, n_ = (uu >> 2) & 63; \
        _Pragma("unroll") for (int j = 0; j < 4; ++j) { const int tt = n_ * 64 + t - 3 + j; XV[j] = *(const v4u*)(proj + ((size_t)b_ * SEQ + (tt < 0 ? 0 : tt)) * DINP + C_LX + nb * 64 + part * 8); } \
        if (PASSB) LG = *(const v4u*)(proj + ((size_t)b_ * SEQ + n_ * 64 + t) * DINP + C_LG + nb * 64 + part * 8); } while (0)
    v4u xv[4], xn[4], lg8 = (v4u){0u, 0u, 0u, 0u}, lgn = (v4u){0u, 0u, 0u, 0u};
    LRU_LOAD(first, xv, lg8);
    SYNC();
    for (int u = first; u < NBATCH * NCHUNK * 4; u += stride) {
        const int b = u >> 8, n = (u >> 2) & 63;
        const size_t row = (size_t)b * SEQ + (size_t)n * 64 + t;
        LRU_LOAD(u + stride, xn, lgn);
        float hreg = 0.f;
        if (PASSB) {
            const float* cp = carry + ((size_t)(b * 64) * 4 + nb) * 128 + lane; float ca[8], ch[8];
#pragma unroll
            for (int j = 0; j < 8; ++j) { const int m = 8 * X.wave + j; const bool ok = m < n; ca[j] = ok ? cp[(size_t)m * 512] : 1.0f; ch[j] = ok ? cp[(size_t)m * 512 + 64] : 0.0f; }
            float fa = 1.f, fh = 0.f;
#pragma unroll
            for (int j = 0; j < 8; ++j) { fh = ca[j] * fh + ch[j]; fa *= ca[j]; }
            segA[X.wave * 64 + lane] = fa; segH[X.wave * 64 + lane] = fh;
        }
        { float y[8];
#pragma unroll
            for (int i = 0; i < 8; ++i) y[i] = cws[256 + part * 8 + i];
#pragma unroll
            for (int j = 0; j < 4; ++j) { const int tt = n * 64 + t - 3 + j; const float msk = tt >= 0 ? 1.0f : 0.0f; float xf[8]; unpack8(xv[j], xf);
#pragma unroll
                for (int i = 0; i < 8; ++i) y[i] += cws[j * 64 + part * 8 + i] * (xf[i] * msk); }
#pragma unroll
            for (int i = 0; i < 8; ++i) xrf[t * 65 + part * 8 + i] = y[i];
            *(LAS v4u*)(xrb + t * 72 + part * 8) = pack8(y); }
        SYNC();
        { const f32x4 z = (f32x4){0.f, 0.f, 0.f, 0.f};
#pragma unroll
            for (int e = 0; e < 2; ++e) { const int tc = (X.wave & 1) * 2 + e, ch = 16 * tc + r;
                const f32x4 ar = mm16<64>(xrb + 16 * tr * 72, 72, WAt + 16 * tc * 72, 72, z, lane);
                const f32x4 ai = mm16<64>(xrb + 16 * tr * 72, 72, WXt + 16 * tc * 72, 72, z, lane);
#pragma unroll
                for (int i = 0; i < 4; ++i) { const int tt = 16 * tr + q * 4 + i;
                    const float rr = sigm(ar[i] + bav[e]), ig = sigm(ai[i] + bxv[e]), lga = -8.0f * rr * spv[e];
                    af[tt * 65 + ch] = fexp(lga); uf[tt * 65 + ch] = __builtin_amdgcn_sqrtf(1.0f - fexp(2.0f * lga)) * ig * xrf[tt * 65 + ch]; } } }
        SYNC();
        if (X.wave == 7) {
            if (PASSB) {
#pragma unroll
                for (int g = 0; g < 8; ++g) hreg = segA[g * 64 + lane] * hreg + segH[g * 64 + lane];
#pragma unroll 8
                for (int tt = 0; tt < 64; ++tt) { hreg = af[tt * 65 + lane] * hreg + uf[tt * 65 + lane]; uf[tt * 65 + lane] = hreg; }
            } else { float pa = 1.f;
#pragma unroll 8
                for (int tt = 0; tt < 64; ++tt) { const float a = af[tt * 65 + lane]; hreg = a * hreg + uf[tt * 65 + lane]; pa *= a; }
                carry[(size_t)u * 128 + lane] = pa; carry[(size_t)u * 128 + 64 + lane] = hreg; }
        }
        SYNC();
        if (PASSB) { float gf[8], o[8]; unpack8(lg8, gf);
#pragma unroll
            for (int i = 0; i < 8; ++i) o[i] = uf[t * 65 + part * 8 + i] * gelu_tanh(gf[i]);
            *(v4u*)(merged + row * D + 384 + nb * 64 + part * 8) = pack8(o); }
#pragma unroll
        for (int j = 0; j < 4; ++j) xv[j] = xn[j];
        lg8 = lgn;
    }
#undef LRU_LOAD
    SYNC();
}
constexpr int TAIL_SLICES = MOE_DOWN_F8 ? 2 : 4;

constexpr int N_PHASES = 19;
constexpr int MOE_ITEMS = 3 * NEXP * 1792;
#ifndef REP_PROL
#define REP_PROL 1
#endif
#ifndef REP_NORM
#define REP_NORM 1
#endif
#ifndef REP_INPROJ
#define REP_INPROJ 1
#endif
#ifndef REP_PREP
#define REP_PREP 1
#endif
#ifndef REP_CHAIN
#define REP_CHAIN 1
#endif
#ifndef REP_FFNGU
#define REP_FFNGU 1
#endif
#ifndef REP_MOEGU
#define REP_MOEGU 1
#endif
#ifndef REP_MOEDN
#define REP_MOEDN 1
#endif
#ifndef STAGGER_TICKS
#define STAGGER_TICKS 0
#endif
#ifndef REP_OUTPROJ
#define REP_OUTPROJ 1
#endif
#ifndef REP_FFNDN
#define REP_FFNDN 1
#endif
#ifndef REP_COMBINE
#define REP_COMBINE 1
#endif
#ifndef REP_MOEDN_TAIL
#define REP_MOEDN_TAIL 1
#endif
#ifndef REP_DNP
#define REP_DNP 1
#endif
#ifndef REP_GLAP
#define REP_GLAP 1
#endif
#ifndef REP_LRUA
#define REP_LRUA 1
#endif
#ifndef REP_DNC
#define REP_DNC 1
#endif
#ifndef REP_GLAC
#define REP_GLAC 1
#endif
#ifndef REP_LRUB
#define REP_LRUB 1
#endif
#define REPEAT(n) for (int rep_ = 0; rep_ < (n); ++rep_)
struct Args { In in; float* out; unsigned char* ws; int ph_lo, ph_hi; };
__global__ void __launch_bounds__(NTHR, 2) hybrid_fwd(Args args) {
    extern __shared__ __attribute__((aligned(16))) unsigned char lds_raw[];
    Ctx X;
    const int wave_id = __builtin_amdgcn_readfirstlane((int)threadIdx.x >> 6);
#define MKCTX() do { int l_; asm volatile("v_mbcnt_lo_u32_b32 %0, -1, 0\n\tv_mbcnt_hi_u32_b32 %0, -1, %0" : "=v"(l_)); { GAS unsigned char* wsg_ = (GAS unsigned char*)args.ws; asm volatile("" : "+s"(wsg_)); ws = (unsigned char*)wsg_; } X.lds = (LAS unsigned char*)lds_raw; X.lane = l_; X.wave = wave_id; X.tid = wave_id * 64 + l_; \
        X.G = gridDim.x; { const int bx = blockIdx.x; X.vcu = (X.G % 8 == 0) ? (bx % 8) * (X.G / 8) + bx / 8 : bx; } X.gw = X.vcu * NWAVES + X.wave; X.NGW = X.G * NWAVES; } while (0)
    unsigned char* ws = args.ws;
    MKCTX();
    InT I; I.p.t = (const LAS unsigned long long*)(X.lds + PTR_OFF);
    gu32* ctl = (gu32*)(ws + WS_CTL);
    volatile LAS unsigned* MISC = (volatile LAS unsigned*)(X.lds + MISC_OFF);
    for (int u = X.tid; u < (LDS_BYTES - RING_BYTES) / 4; u += NTHR) ((LAS unsigned*)(X.lds + RING_BYTES))[u] = 0u;
#pragma unroll
    for (int k = 0; k < 30; ++k) if (X.tid == k) ((LAS unsigned long long*)(X.lds + PTR_OFF))[k] = (unsigned long long)args.in.p[k];
    __syncthreads();
#if MK_ONE_LAUNCH
    XcdBarrier bar = xcd_barrier_post((unsigned*)(ctl + CW_BAR), MISC + 8);
#define GRID_BAR() do { XcdBarrier b_ = bar; asm volatile("" : "+s"(b_.bar), "+s"(b_.x)); xcd_barrier(b_); } while (0)
#else
#define GRID_BAR() do {} while (0)
#endif
#if MK_ONE_LAUNCH
#define IN(k) true
#define SEAM(k) GRID_BAR()
#else
    const int lo = args.ph_lo, hi = args.ph_hi;
#define IN(k) (lo <= (k) && (k) < hi)
#define SEAM(k) do { if (IN(k) && IN((k) + 1)) GRID_BAR(); } while (0)
#endif
#define x_in (I.p[0])
#define xres ((bf16*)(ws + WS_XRES))
#define MOD ((float*)(ws + WS_MOD))
#define Hb ((bf16*)(ws + WS_H))
#define PROJ ((bf16*)(ws + WS_PROJ))
#define ring (X.lds)

    if (IN(0)) { MKCTX(); prologue_phase(X, I, ws); }
#if MK_ONE_LAUNCH
    { MKCTX(); mod_wait(X, ws); }
#endif
    if (IN(1)) { MKCTX(); REPEAT(REP_NORM) norm_phase<false, false>(X, x_in, I.p[18], MOD, 0, D, Hb, nullptr, ws); } SEAM(1);

    for (int L = 0; L < 2; ++L) {
        const int pb = 2 + 8 * L;
        const float* modL = MOD + (size_t)L * 8 * MODW;
        if (IN(pb)) { MKCTX();
            if (INPROJ1_F8 && L == 1) {
                pg8::Gemm g{Hb, (const bf16*)(ws + WS_WIN) + (size_t)DINP * D, T, DINP, D / 2, 0, 127 - 5, 127 - 10}; pg8::MoeOrder<true> S; S.init(T / 256, DINP, X.G, (int)blockIdx.x);
                S.tile_e = (LAS int*)(X.lds + TAB_OFF); S.list = nullptr; S.eB = 0;
                pg8::EpiStoreBf16F8 E{{PROJ, DINP}};
                pg8::gemm_phase<pg8::EpiStoreBf16F8, pg8::MoeOrder<true>, true>(ring, g, S, E, wave_id);
            } else {
            pg8::Gemm g{Hb, (const bf16*)(ws + WS_WIN) + (size_t)L * DINP * D, T, DINP, D}; pg8::StaticOrder S; S.init(T, DINP, X.G, (int)blockIdx.x);
            pg8::EpiStoreBf16 E{PROJ, DINP};
            REPEAT(REP_INPROJ) pg8::gemm_phase<pg8::EpiStoreBf16, pg8::StaticOrder, true>(ring, g, S, E, wave_id);
            }
            if (blockIdx.x >= 128) { MKCTX(); moe_convert(X, I, ws, L * 22000, L * 22000 + 8000, (int)blockIdx.x - 128, (int)X.G - 128); }
        } SEAM(pb);
        if (IN(pb + 1)) { MKCTX();
            {
                REPEAT(REP_DNP) dn_prep_phase(X, PROJ, I.p[13] + (size_t)L * 4 * 1152, I.p[14] + L * 6, I.p[15] + L * 6, ws, (bf16*)args.out);
                REPEAT(REP_GLAP) gla_prep_phase(X, PROJ, I.p[3] + (size_t)L * 16 * 192, I.p[4] + L * 192, ws);
                REPEAT(REP_LRUA) lru_units<false>(X, X.vcu, X.G, PROJ, I.p[6] + (size_t)L * 4 * 256, I.p[7] + L * 256, I.p[8] + (size_t)L * 4 * 4096, I.p[9] + L * 256, I.p[10] + (size_t)L * 4 * 4096, I.p[11] + L * 256, I.p[12] + L * 256, ws, Hb);
            }
        } SEAM(pb + 1);
        if (IN(pb + 2)) { MKCTX();
            REPEAT(REP_CHAIN) for (int ru = (int)blockIdx.x; ru < 256; ru += X.G) {
                if (ru < 48) { MKCTX(); REPEAT(REP_DNC) dn_chain(X, ru, PROJ, I.p[16] + L * 64, ws, (const bf16*)args.out, Hb); }
                else if (ru < 96) { MKCTX(); REPEAT(REP_GLAC) gla_chain(X, ru - 48, PROJ, I.p[5] + L * 64, ws, Hb); }
                else { MKCTX(); REPEAT(REP_LRUB) lru_units<true>(X, ru - 96, 160, PROJ, I.p[6] + (size_t)L * 4 * 256, I.p[7] + L * 256, I.p[8] + (size_t)L * 4 * 4096, I.p[9] + L * 256, I.p[10] + (size_t)L * 4 * 4096, I.p[11] + L * 256, I.p[12] + L * 256, ws, Hb);
                       MKCTX(); moe_convert(X, I, ws, L * 22000 + 8000, L == 0 ? 22000 : MOE_ITEMS, ru - 96, 160); }
            }
        } SEAM(pb + 2);
        if (IN(pb + 3)) { MKCTX();
            pg8::Gemm g{Hb, (const bf16*)(ws + WS_WOUT) + (size_t)L * D * D, T, D, D}; pg8::StaticOrder S; S.init(T, D, X.G, (int)blockIdx.x);
            if (L == 0) { pg8::EpiRes32 E{x_in, xres, xres, modL + 2 * D}; pg8::gemm_phase<pg8::EpiRes32, pg8::StaticOrder, true>(ring, g, S, E, wave_id); }
            else { pg8::EpiRes E{nullptr, xres, xres, modL + 2 * D}; pg8::gemm_phase<pg8::EpiRes, pg8::StaticOrder, true>(ring, g, S, E, wave_id); }
        } SEAM(pb + 3);
        if (L == 0) {
            if (IN(6)) { MKCTX(); REPEAT(REP_NORM) norm_phase<false, true, DENSE_GU_F8 != 0>(X, xres, I.p[19], modL, 3 * D, 4 * D, Hb, nullptr, ws); } SEAM(6);
            if (IN(7)) { MKCTX();
#if DENSE_GU_F8
                pg8::Gemm g{Hb, (const bf16*)(ws + WS_WGU), T, 2 * DFF, D / 2, 0, 127 - 5, 127 - 10}; pg8::MoeOrder<true> S; S.init(T / 256, 2 * DFF, X.G, (int)blockIdx.x);
                S.tile_e = (LAS int*)(X.lds + TAB_OFF); S.list = nullptr; S.eB = 0;
#if DENSE_DN_F8
                pg8::EpiSwiglu8 E{PROJ, DFF};
                REPEAT(REP_FFNGU) pg8::gemm_phase<pg8::EpiSwiglu8, pg8::MoeOrder<true>, true>(ring, g, S, E, wave_id);
#else
                pg8::EpiSwigluB E{{PROJ, DFF}};
                REPEAT(REP_FFNGU) pg8::gemm_phase<pg8::EpiSwigluB, pg8::MoeOrder<true>, true>(ring, g, S, E, wave_id);
#endif
#else
                pg8::Gemm g{Hb, (const bf16*)(ws + WS_WGU), T, 2 * DFF, D}; pg8::StaticOrder S; S.init(T, 2 * DFF, X.G, (int)blockIdx.x);
#if DENSE_DN_F8
                pg8::EpiSwigluTo8 E{PROJ, DFF};
                REPEAT(REP_FFNGU) pg8::gemm_phase<pg8::EpiSwigluTo8, pg8::StaticOrder, true>(ring, g, S, E, wave_id);
#else
                pg8::EpiSwiglu E{PROJ, DFF};
                REPEAT(REP_FFNGU) pg8::gemm_phase<pg8::EpiSwiglu, pg8::StaticOrder, true>(ring, g, S, E, wave_id);
#endif
#endif
            } SEAM(7);
            if (IN(8)) { MKCTX();
#if DENSE_DN_F8
                pg8::Gemm g{PROJ, (const bf16*)(ws + WS_WDN), T, D, DFF / 2, 0, 127 - 3, 127 - 11}; pg8::MoeOrder<true> S; S.init(T / 256, D, X.G, (int)blockIdx.x);
                S.tile_e = (LAS int*)(X.lds + TAB_OFF); S.list = nullptr; S.eB = 0;
                pg8::EpiRes8 E{nullptr, xres, xres, modL + 5 * D};
                pg8::gemm_phase<pg8::EpiRes8, pg8::MoeOrder<true>, true>(ring, g, S, E, wave_id);
#else
                pg8::Gemm g{PROJ, (const bf16*)(ws + WS_WDN), T, D, DFF}; pg8::StaticOrder S; S.init(T, D, X.G, (int)blockIdx.x);
                pg8::EpiRes E{nullptr, xres, xres, modL + 5 * D};
                pg8::gemm_phase<pg8::EpiRes, pg8::StaticOrder, true>(ring, g, S, E, wave_id);
#endif
            } SEAM(8);
            if (IN(9)) { MKCTX(); REPEAT(REP_NORM) norm_phase<false, true, INPROJ1_F8 != 0>(X, xres, I.p[18] + D, MOD + (size_t)8 * MODW, 0, D, Hb, nullptr, ws); } SEAM(9);
        }
    }
    if (IN(14)) { MKCTX(); REPEAT(REP_NORM) norm_phase<true, true>(X, xres, I.p[19] + D, MOD + (size_t)8 * MODW, 3 * D, 4 * D, Hb, I.p[25], ws); } SEAM(14);
    if (IN(15)) { MKCTX(); moe_list_phase(X, ws); } SEAM(15);
    {
        LAS int* tab = (LAS int*)(X.lds + TAB_OFF);
        if (IN(16) || IN(17)) { __syncthreads(); if (X.tid < TILE_TAB) tab[X.tid] = ((const int*)(ws + WS_TILES))[X.tid]; __syncthreads(); }
        const int nM0 = __builtin_amdgcn_readfirstlane(tab[TILE_TAB - 2]), nM = __builtin_amdgcn_readfirstlane(tab[TILE_TAB - 1]);
        const int* list = (const int*)(ws + WS_LIST); const float* roww = (const float*)(ws + WS_ROWW);
        if (IN(16)) { MKCTX();
            pg8::Gemm g{Hb, (const bf16*)(ws + WS_MOEGU), 2 * MOE_ROWS, 2 * DFFE, D / 2, 0, 127 - 5, 127 - 10}; pg8::MoeOrder<true> S; S.init(nM, 2 * DFFE, X.G, (int)blockIdx.x);
            S.tile_e = tab; S.list = list; S.eB = (size_t)2 * DFFE * D; S.rowtab = (LAS int*)(X.lds + ROWTAB_OFF);
            pg8::EpiSwiglu8 E{PROJ, DFFE};
            REPEAT(REP_MOEGU) pg8::gemm_phase<pg8::EpiSwiglu8, pg8::MoeOrder<true>, true>(ring, g, S, E, wave_id);
        } SEAM(16);
        if (IN(17)) { MKCTX();
            pg8::MoeOrder<true> S; S.init(nM, D, X.G, (int)blockIdx.x);
            S.tile_e = tab; S.list = nullptr; S.eB = (size_t)D * DFFE;
            pg8::Gemm g{PROJ, (const bf16*)(ws + WS_MOEDN), 2 * MOE_ROWS, D, DFFE / 2, 0, 127 - 3, 127 - 11};
            pg8::EpiMoeDown E{(bf16*)(ws + WS_Y0), Hb, nM0 * 256, list, roww};
            pg8::gemm_phase<pg8::EpiMoeDown, pg8::MoeOrder<true>, true>(ring, g, S, E, wave_id);
        } SEAM(17);
    }
    if (IN(18)) { MKCTX(); final_norm_phase(X, xres, (const bf16*)(ws + WS_Y0), Hb, MOD + (size_t)8 * MODW + 5 * D, I.p[29], args.out); }
#undef IN
#undef SEAM
#undef x_in
#undef xres
#undef MOD
#undef Hb
#undef PROJ
#undef ring
}

extern "C" void kernel_launch(void* const* d_in, const int* in_sizes, int n_in, void* d_out, int out_size, void* d_ws, size_t ws_size, hipStream_t stream) {
    static int grid = 0;
    if (grid == 0) {
        if (n_in != 30 || in_sizes[0] != T * D || out_size != T * D || ws_size < WS_END) { fprintf(stderr, "kernel_launch: unexpected shapes (n_in %d, in0 %d, out %d, ws %zu); nothing launched\n", n_in, n_in > 0 ? in_sizes[0] : -1, out_size, ws_size); grid = -1; return; }
        int dev = 0, cus = 0;
        if (hipGetDevice(&dev) != hipSuccess || hipDeviceGetAttribute(&cus, hipDeviceAttributeMultiprocessorCount, dev) != hipSuccess) { fprintf(stderr, "kernel_launch: device query failed\n"); grid = -1; return; }
        if (hipFuncSetAttribute((const void*)hybrid_fwd, hipFuncAttributeMaxDynamicSharedMemorySize, LDS_BYTES) != hipSuccess) { fprintf(stderr, "kernel_launch: hipFuncSetAttribute failed\n"); grid = -1; return; }
        int per_cu = 0;
        if (hipOccupancyMaxActiveBlocksPerMultiprocessor(&per_cu, (const void*)hybrid_fwd, NTHR, LDS_BYTES) != hipSuccess || per_cu < 1) fprintf(stderr, "kernel_launch: note: occupancy query reports %d workgroups per CU\n", per_cu);
        (void)hipGetLastError();
        grid = cus;
    }
    if (grid < 0) return;
    if (hipMemsetAsync((char*)d_ws + WS_CTL, 0, CTL_ZERO_BYTES, stream) != hipSuccess) { fprintf(stderr, "kernel_launch: memset failed\n"); return; }
    Args a{};
    for (int i = 0; i < 30; ++i) a.in.p[i] = (const float*)d_in[i];
    a.out = (float*)d_out; a.ws = (unsigned char*)d_ws;
#if MK_ONE_LAUNCH
    a.ph_lo = 0; a.ph_hi = N_PHASES;
    hipLaunchKernelGGL(hybrid_fwd, dim3(grid), dim3(NTHR), LDS_BYTES, stream, a);
#else
    for (int k = 0; k < N_PHASES; ++k) { a.ph_lo = k; a.ph_hi = k + 1; hipLaunchKernelGGL(hybrid_fwd, dim3(grid), dim3(NTHR), LDS_BYTES, stream, a); }
#endif
    const hipError_t le = hipPeekAtLastError();
    if (le != hipSuccess) fprintf(stderr, "kernel_launch: launch failed: %s\n", hipGetErrorName(le));
}
```
